# Optimizing an MI355X kernel written in HIP

```python
import jax, jax.numpy as jnp
from jax import lax
import numpy as np

D_MODEL = 1024
BATCH = 8
SEQ = 2048
DEPTH = 4

CHUNK = 64
POOL_WINDOWS = (2, 4, 8, 16)
POOL_GROUPS = len(POOL_WINDOWS)
POOL_WIDTH = D_MODEL // 2
POOL_GROUP_DIM = POOL_WIDTH // POOL_GROUPS
POOL_MAX_WIN = max(POOL_WINDOWS)
CONV_WIDTH = D_MODEL // 2
CONV_KERNEL = 31
EVEN_IN = POOL_WIDTH + 2 * CONV_WIDTH
EVEN_MIX = POOL_WIDTH + CONV_WIDTH
SGU_WIDTH = 2 * D_MODEL
SGU_HEADS = 8
SGU_HEAD_DIM = SGU_WIDTH // SGU_HEADS
SGU_CHUNK = 128
N_EXPERTS = 32
TOP_K = 4
D_EXPERT = D_MODEL
SWIGLU_LIMIT = 7.0
SWIGLU_ALPHA = 1.702
MOE_BLOCK = 128
DN_ALPHA = (2 * DEPTH) ** 0.25
DN_BETA = (8 * DEPTH) ** -0.25
LN_EPS = 1e-5
N_EVEN = (DEPTH + 1) // 2
N_ODD = DEPTH // 2

kernel_name = "hybrid_pool_conv_gmlp_moe_deepnorm"


def layer_norm(x, g, b):
    xf = x.astype(jnp.float32)
    mu = xf.mean(-1, keepdims=True)
    var = jnp.square(xf - mu).mean(-1, keepdims=True)
    return ((xf - mu) * lax.rsqrt(var + LN_EPS) * g + b).astype(x.dtype)


def multiscale_pool(p, w, b, scale):
    bsz, s, _ = p.shape
    groups = p.astype(jnp.float32).reshape(bsz, s, POOL_GROUPS, POOL_GROUP_DIM)
    cs = jnp.pad(jnp.cumsum(groups, axis=1), ((0, 0), (POOL_MAX_WIN, 0), (0, 0), (0, 0)))
    pos = jnp.arange(s)
    outs = []
    for g, win in enumerate(POOL_WINDOWS):
        window_sum = (cs[:, POOL_MAX_WIN:POOL_MAX_WIN + s, g]
                      - cs[:, POOL_MAX_WIN - win:POOL_MAX_WIN - win + s, g])
        count = jnp.minimum(pos + 1, win).astype(jnp.float32)[None, :, None]
        outs.append(window_sum / count - groups[:, :, g])
    pooled = jnp.stack(outs, axis=2).astype(p.dtype)
    mixed = jnp.einsum('bsgc,gcd->bsgd', pooled, w) + b
    return mixed.reshape(bsz, s, POOL_WIDTH) * scale


def conformer_conv(a, gate, w_dw, b_dw, ln_g, ln_b):
    glu = a * jax.nn.sigmoid(gate)
    padded = jnp.pad(glu, ((0, 0), (CONV_KERNEL - 1, 0), (0, 0)))
    y = lax.conv_general_dilated(
        padded, w_dw[:, None, :], window_strides=(1,), padding='VALID',
        dimension_numbers=('NWC', 'WIO', 'NWC'), feature_group_count=CONV_WIDTH) + b_dw
    return jax.nn.silu(layer_norm(y, ln_g, ln_b))


def even_mixer(x, w_in, b_in, pool_w, pool_b, pool_scale, conv_w, conv_b,
               conv_ln_g, conv_ln_b, w_out, b_out):
    h = jnp.einsum('bsd,de->bse', x, w_in) + b_in
    p, a, gate = jnp.split(h, [POOL_WIDTH, POOL_WIDTH + CONV_WIDTH], axis=-1)
    y_pool = multiscale_pool(p, pool_w, pool_b, pool_scale)
    y_conv = conformer_conv(a, gate, conv_w, conv_b, conv_ln_g, conv_ln_b)
    y = jnp.concatenate([y_pool, y_conv], axis=-1)
    return jnp.einsum('bse,ed->bsd', y, w_out) + b_out


def odd_mixer(x, w_in, b_in, ln_g, ln_b, w_s, b_s, w_out, b_out):
    bsz, s, _ = x.shape
    h = jax.nn.gelu(jnp.einsum('bsd,de->bse', x, w_in) + b_in, approximate=False)
    u, v = jnp.split(h, 2, axis=-1)
    v = layer_norm(v, ln_g, ln_b)
    v = v.reshape(bsz, s // SGU_CHUNK, SGU_CHUNK, SGU_HEADS, SGU_HEAD_DIM)
    blk = jnp.arange(SGU_CHUNK) // CHUNK
    mask = blk[:, None] >= blk[None, :]
    w_masked = jnp.where(mask[None], w_s, 0.0)
    sv = jnp.einsum('hij,bnjhc->bnihc', w_masked, v) + b_s.T[:, :, None]
    gated = u * sv.reshape(bsz, s, SGU_WIDTH)
    return jnp.einsum('bse,ed->bsd', gated, w_out) + b_out


def moe(x, router_w, router_b, w_up, b_up, w_down, b_down):
    bsz, s, d = x.shape
    tokens = x.reshape(-1, d)
    n_tok = tokens.shape[0]
    logits = (tokens @ router_w + router_b).astype(jnp.float32)
    top_vals, top_idx = lax.top_k(logits, TOP_K)
    gates = jax.nn.softmax(top_vals, axis=-1).astype(x.dtype)
    n_assign = n_tok * TOP_K
    flat_exp = top_idx.reshape(-1).astype(jnp.int32)
    flat_tok = jnp.arange(n_assign, dtype=jnp.int32) // TOP_K
    flat_gate = gates.reshape(-1)
    order = jnp.argsort(flat_exp)
    sorted_exp = flat_exp[order]
    counts = jnp.zeros(N_EXPERTS, jnp.int32).at[flat_exp].add(1)
    padded_counts = (counts + MOE_BLOCK - 1) // MOE_BLOCK * MOE_BLOCK
    start = jnp.cumsum(counts) - counts
    padded_end = jnp.cumsum(padded_counts)
    padded_start = padded_end - padded_counts
    dest = padded_start[sorted_exp] + jnp.arange(n_assign, dtype=jnp.int32) - start[sorted_exp]
    n_blocks = -(-n_assign // MOE_BLOCK) + N_EXPERTS
    n_rows = n_blocks * MOE_BLOCK
    row_tok = jnp.zeros(n_rows, jnp.int32).at[dest].set(flat_tok[order])
    row_gate = jnp.zeros(n_rows, x.dtype).at[dest].set(flat_gate[order])
    block_start = jnp.arange(n_blocks, dtype=jnp.int32) * MOE_BLOCK
    block_exp = jnp.minimum(jnp.searchsorted(padded_end, block_start, side='right'),
                            N_EXPERTS - 1)
    xs = tokens[row_tok].reshape(n_blocks, MOE_BLOCK, d)

    def expert_block(args):
        xb, e = args
        hb = xb @ w_up[e] + b_up[e]
        g, lin = jnp.split(hb, 2, axis=-1)
        g = jnp.minimum(g, SWIGLU_LIMIT)
        lin = jnp.clip(lin, -SWIGLU_LIMIT, SWIGLU_LIMIT)
        act = g * jax.nn.sigmoid(SWIGLU_ALPHA * g) * (lin + 1.0)
        return act @ w_down[e] + b_down[e]

    ys = lax.map(expert_block, (xs, block_exp)).reshape(n_rows, d)
    out = jnp.zeros_like(tokens).at[row_tok].add(ys * row_gate[:, None])
    return out.reshape(bsz, s, d)


def setup_inputs(seed: int = 0) -> dict:
    key = jax.random.key(seed)
    ks = jax.random.split(key, 29)
    f32 = jnp.float32
    nrm = lambda k, shape, sc: jax.random.normal(k, shape, f32) * sc
    ones_n = lambda k, shape: 1.0 + 0.1 * jax.random.normal(k, shape, f32)
    return {
        "x": jax.random.normal(ks[0], (BATCH, SEQ, D_MODEL), f32),
        "ev_w_in": nrm(ks[1], (N_EVEN, D_MODEL, EVEN_IN), D_MODEL ** -0.5),
        "ev_b_in": nrm(ks[2], (N_EVEN, EVEN_IN), 0.02),
        "pool_w": nrm(ks[3], (N_EVEN, POOL_GROUPS, POOL_GROUP_DIM, POOL_GROUP_DIM), POOL_GROUP_DIM ** -0.5),
        "pool_b": nrm(ks[4], (N_EVEN, POOL_GROUPS, POOL_GROUP_DIM), 0.02),
        "pool_scale": ones_n(ks[5], (N_EVEN, POOL_WIDTH)),
        "conv_w": nrm(ks[6], (N_EVEN, CONV_KERNEL, CONV_WIDTH), CONV_KERNEL ** -0.5),
        "conv_b": nrm(ks[7], (N_EVEN, CONV_WIDTH), 0.02),
        "conv_ln_g": ones_n(ks[8], (N_EVEN, CONV_WIDTH)),
        "conv_ln_b": nrm(ks[9], (N_EVEN, CONV_WIDTH), 0.02),
        "ev_w_out": nrm(ks[10], (N_EVEN, EVEN_MIX, D_MODEL), EVEN_MIX ** -0.5 * DN_BETA),
        "ev_b_out": nrm(ks[11], (N_EVEN, D_MODEL), 0.02),
        "od_w_in": nrm(ks[12], (N_ODD, D_MODEL, 2 * SGU_WIDTH), D_MODEL ** -0.5),
        "od_b_in": nrm(ks[13], (N_ODD, 2 * SGU_WIDTH), 0.02),
        "sgu_ln_g": ones_n(ks[14], (N_ODD, SGU_WIDTH)),
        "sgu_ln_b": nrm(ks[15], (N_ODD, SGU_WIDTH), 0.02),
        "sgu_w": nrm(ks[16], (N_ODD, SGU_HEADS, SGU_CHUNK, SGU_CHUNK), SGU_CHUNK ** -0.5),
        "sgu_b": ones_n(ks[17], (N_ODD, SGU_HEADS, SGU_CHUNK)),
        "od_w_out": nrm(ks[18], (N_ODD, SGU_WIDTH, D_MODEL), SGU_WIDTH ** -0.5 * DN_BETA),
        "od_b_out": nrm(ks[19], (N_ODD, D_MODEL), 0.02),
        "router_w": nrm(ks[20], (DEPTH, D_MODEL, N_EXPERTS), D_MODEL ** -0.5),
        "router_b": nrm(ks[21], (DEPTH, N_EXPERTS), 0.01),
        "exp_w_up": nrm(ks[22], (DEPTH, N_EXPERTS, D_MODEL, 2 * D_EXPERT), D_MODEL ** -0.5),
        "exp_b_up": nrm(ks[23], (DEPTH, N_EXPERTS, 2 * D_EXPERT), 0.02),
        "exp_w_down": nrm(ks[24], (DEPTH, N_EXPERTS, D_EXPERT, D_MODEL), D_EXPERT ** -0.5 * DN_BETA),
        "exp_b_down": nrm(ks[25], (DEPTH, N_EXPERTS, D_MODEL), 0.02),
        "ln_g": ones_n(ks[26], (DEPTH, 2, D_MODEL)),
        "ln_b": nrm(ks[27], (DEPTH, 2, D_MODEL), 0.02),
    }


def reference(x, ev_w_in, ev_b_in, pool_w, pool_b, pool_scale, conv_w, conv_b,
              conv_ln_g, conv_ln_b, ev_w_out, ev_b_out, od_w_in, od_b_in,
              sgu_ln_g, sgu_ln_b, sgu_w, sgu_b, od_w_out, od_b_out,
              router_w, router_b, exp_w_up, exp_b_up, exp_w_down, exp_b_down,
              ln_g, ln_b):
    for layer in range(DEPTH):
        i = layer // 2
        if layer % 2 == 0:
            mix = even_mixer(x, ev_w_in[i], ev_b_in[i], pool_w[i], pool_b[i], pool_scale[i],
                             conv_w[i], conv_b[i], conv_ln_g[i], conv_ln_b[i],
                             ev_w_out[i], ev_b_out[i])
        else:
            mix = odd_mixer(x, od_w_in[i], od_b_in[i], sgu_ln_g[i], sgu_ln_b[i],
                            sgu_w[i], sgu_b[i], od_w_out[i], od_b_out[i])
        x = layer_norm(DN_ALPHA * x + mix, ln_g[layer, 0], ln_b[layer, 0])
        ff = moe(x, router_w[layer], router_b[layer], exp_w_up[layer], exp_b_up[layer],
                 exp_w_down[layer], exp_b_down[layer])
        x = layer_norm(DN_ALPHA * x + ff, ln_g[layer, 1], ln_b[layer, 1])
    return x
```

```cpp
#include <hip/hip_runtime.h>
#include <cstdio>
#include <cstdint>

#ifndef PH_MASK
#define PH_MASK 0x7ff
#endif
#define PM(b) ((PH_MASK >> (b)) & 1)
#ifndef PROBE_DUP_MASK
#define PROBE_DUP_MASK 0
#endif
#ifndef MK_SINGLE
#define MK_SINGLE 1
#endif

#define GAS __attribute__((address_space(1)))
#define LAS __attribute__((address_space(3)))
typedef unsigned short bf16;
typedef float f32x4 __attribute__((ext_vector_type(4)));
typedef float f32x2 __attribute__((ext_vector_type(2)));
typedef short bf16x8 __attribute__((ext_vector_type(8)));
typedef unsigned u32x4 __attribute__((ext_vector_type(4)));
typedef unsigned u32x2 __attribute__((ext_vector_type(2)));
typedef int v4i __attribute__((ext_vector_type(4)));
typedef int v8i __attribute__((ext_vector_type(8)));
typedef int v2i __attribute__((ext_vector_type(2)));
typedef unsigned v6u __attribute__((ext_vector_type(6)));
typedef unsigned v16u __attribute__((ext_vector_type(16)));
typedef __bf16 v32bf __attribute__((ext_vector_type(32)));

constexpr int NTOK = 16384, DM = 1024, SEQ = 2048, DEPTH = 4;
constexpr int EVEN_IN = 1536, SGU_W = 2048, NEXP = 32, TOPK = 4;
constexpr float DN_ALPHA = 1.681792830507429f;
constexpr float LN_EPS = 1e-5f;
#ifndef FP6_UP
#define FP6_UP 1
#endif
#define EMU_UP 0
#define EMU_DOWN 0
constexpr float QS_X1 = FP6_UP ? 1.75f : 8.f, QS_WUP = FP6_UP ? 60.f : 32.f, QS_ACT = EMU_DOWN ? 1.5f : 4.f, QS_WDOWN = EMU_DOWN ? 144.f : 64.f, QS_GATED = 8.f, QS_WODOUT = 64.f;
constexpr int NWAVES = 8, NTHR = 512;
constexpr int MAXU = 12;
constexpr int CAPROWS = 16384;
constexpr int HROWS = 65536 + 32 * 256;

constexpr size_t MiB = 1u << 20;
constexpr size_t WS_CTL = 0, CTL_ZERO_BYTES = 128 * 1024;
constexpr size_t WS_WEVIN = 1 * MiB, WS_WEVOUT = 7 * MiB, WS_WODIN = 11 * MiB, WS_WODOUT = 27 * MiB, WS_WPOOL = 35 * MiB, WS_WSGU = 36 * MiB, WS_RWH = 37 * MiB, WS_RWL = 38 * MiB;
constexpr size_t WS_WUP = 64 * MiB, WS_WDOWN = 576 * MiB;
constexpr size_t WS_XF = 832 * MiB, WS_XB = 896 * MiB, WS_HB = 928 * MiB, WS_YB = 1056 * MiB, WS_Z = 1120 * MiB, WS_X1F = 1184 * MiB, WS_X1B = 1248 * MiB;
constexpr size_t WS_XQ = WS_XF, WS_SX = WS_XF + 32 * MiB;
constexpr size_t WS_SWEV = WS_WEVIN + 4 * MiB, WS_SWOD = WS_WODIN + 12 * MiB;
constexpr size_t WS_STATS = 1280 * MiB, WS_EP = 1284 * MiB, WS_GATE = 1285 * MiB, WS_ROWTOK = 1286 * MiB, WS_HACT = 1288 * MiB, WS_YS = 1432 * MiB, WS_END = 1576 * MiB;
constexpr int CW_BAR = 4096;
constexpr int CW_CNT = 8192;
constexpr int CW_CMAX = CW_CNT + DEPTH * NEXP * 64;
constexpr int NCMAX = 2 * EVEN_IN + 2 * 2 * SGU_W;
static_assert((CW_CMAX + NCMAX) * 4 <= (int)CTL_ZERO_BYTES, "ctl");

constexpr int RING_BYTES = 131072;
constexpr int TAB_OFF = RING_BYTES, TAB_BYTES = MAXU * 256 * 4;
constexpr int UT_OFF = TAB_OFF + TAB_BYTES, UT_BYTES = MAXU * 16;
constexpr int BIAS_OFF = UT_OFF + 256, BIAS_BYTES = MAXU * 1024;
constexpr int MISC_OFF = BIAS_OFF + BIAS_BYTES, MISC_BYTES = 1024;
constexpr int LDS_BYTES = 157696;
static_assert(MISC_OFF + MISC_BYTES <= LDS_BYTES, "lds");

__device__ __forceinline__ unsigned f2bf(float f) { unsigned u = __builtin_bit_cast(unsigned, f); return (u + 0x7fffu + ((u >> 16) & 1u)) >> 16; }
__device__ __forceinline__ unsigned pk2(float lo, float hi) { unsigned r; asm("v_cvt_pk_bf16_f32 %0, %1, %2" : "=v"(r) : "v"(lo), "v"(hi)); return r; }
__device__ __forceinline__ float bflo(unsigned w) { return __builtin_bit_cast(float, w << 16); }
__device__ __forceinline__ float bfhi(unsigned w) { return __builtin_bit_cast(float, w & 0xffff0000u); }
__device__ __forceinline__ float bf2f(bf16 b) { return __builtin_bit_cast(float, (unsigned)b << 16); }
__device__ __forceinline__ float shx(float v, int m, int lane) { return __builtin_bit_cast(float, __builtin_amdgcn_ds_bpermute((lane ^ m) << 2, __builtin_bit_cast(int, v))); }
__device__ __forceinline__ float wave_sum(float v, int lane) {
#pragma unroll
    for (int o = 1; o < 64; o <<= 1) v += shx(v, o, lane);
    return v;
}
__device__ __forceinline__ float sigmoidf_(float x) { return __builtin_amdgcn_rcpf(1.0f + __builtin_amdgcn_exp2f(x * -1.44269504089f)); }
__device__ __forceinline__ int phase_tid(int wv) { unsigned z = 0u; asm volatile("" : "+v"(z));
    int t = (wv << 6) | (int)__builtin_amdgcn_mbcnt_hi(~0u, __builtin_amdgcn_mbcnt_lo(~0u, z)); asm volatile("" : "+v"(t)); return t; }
__device__ __forceinline__ float wave_max(float v, int lane) {
#pragma unroll
    for (int o = 1; o < 64; o <<= 1) v = fmaxf(v, shx(v, o, lane));
    return v;
}
__device__ __forceinline__ unsigned pk4_i8(float a, float b, float c, float d, float inv) {
    const int ia = (int)fminf(fmaxf(rintf(a * inv), -127.f), 127.f), ib = (int)fminf(fmaxf(rintf(b * inv), -127.f), 127.f);
    const int ic = (int)fminf(fmaxf(rintf(c * inv), -127.f), 127.f), id = (int)fminf(fmaxf(rintf(d * inv), -127.f), 127.f);
    return (unsigned)(ia & 0xff) | ((unsigned)(ib & 0xff) << 8) | ((unsigned)(ic & 0xff) << 16) | ((unsigned)id << 24);
}
#define LDS_WAIT() asm volatile("s_waitcnt lgkmcnt(0)" ::: "memory")

#define XB_TMO      128
#define XB_XCNT(j)  (256  + 64 * (j))
#define XB_XSUB(j)  (1280 + 64 * (j))
#define XB_XGEN(j)  (2304 + 64 * (j))
#define XB_TOP      3328
#define XB_TOPGEN   3392
#define XCD_BAR_WORDS 3456
#define XB_SPIN_CAP (1u << 18)
__device__ __forceinline__ unsigned xb_ld(unsigned* p)              { return __hip_atomic_load(p, __ATOMIC_RELAXED, __HIP_MEMORY_SCOPE_AGENT); }
__device__ __forceinline__ unsigned xb_add(unsigned* p, unsigned v) { return __hip_atomic_fetch_add(p, v, __ATOMIC_RELAXED, __HIP_MEMORY_SCOPE_AGENT); }
__device__ __forceinline__ unsigned xb_xcc_id() { return (unsigned)__builtin_amdgcn_s_getreg((3 << 11) | 20) & 0xFu; }
#define XB_SPIN(cond, bar) do { unsigned _sp = 0; while (cond) { __builtin_amdgcn_s_sleep(1); \
    if ((++_sp & 255u) == 0u) { if (xb_ld(&(bar)[XB_TMO])) break; if (_sp > XB_SPIN_CAP) { atomicAdd(&(bar)[XB_TMO], 1u); break; } } } } while (0)
struct XcdBarrier { unsigned* bar; unsigned x; volatile LAS unsigned* st; };
__device__ __forceinline__ XcdBarrier xcd_barrier_post(unsigned* bar, volatile LAS unsigned* st, bool t0) {
    XcdBarrier b; b.bar = bar; b.x = xb_xcc_id(); b.st = st;
    if (t0) (void)xb_add(&bar[XB_XCNT(b.x)], 1u);
    return b;
}
__device__ __forceinline__ void xcd_barrier_complete(unsigned* bar, unsigned x, unsigned& nloc, unsigned& nx) {
    const unsigned G = gridDim.x * gridDim.y * gridDim.z;
    unsigned sum, cnt, mine, sp = 0u;
    for (;;) {
        sum = 0u; cnt = 0u; mine = 0u;
#pragma unroll
        for (unsigned j = 0; j < 16; ++j) { const unsigned c = xb_ld(&bar[XB_XCNT(j)]); sum += c; cnt += (c > 0u) ? 1u : 0u; mine = (j == x) ? c : mine; }
        if (sum == G) break;
        __builtin_amdgcn_s_sleep(1);
        if ((++sp & 255u) == 0u) { if (xb_ld(&bar[XB_TMO])) break; if (sp > XB_SPIN_CAP) { atomicAdd(&bar[XB_TMO], 1u); break; } }
    }
    nloc = mine > 0u ? mine : 1u; nx = cnt > 0u ? cnt : 1u;
}
template <bool FIRST> __device__ __forceinline__ void xcd_barrier(const XcdBarrier& b, bool t0) {
    asm volatile("s_waitcnt vmcnt(0)" ::: "memory");
    __syncthreads();
    if (t0) {
        unsigned* bar = b.bar;
        __builtin_amdgcn_s_waitcnt(0);
        unsigned nloc = b.st[0], nx = b.st[1];
        if constexpr (FIRST) { if (nloc == 0u) { xcd_barrier_complete(bar, b.x, nloc, nx); b.st[0] = nloc; b.st[1] = nx; } }
        const unsigned old = xb_add(&bar[XB_XSUB(b.x)], 1u);
        const unsigned gen = old / nloc;
        if (old + 1u == (gen + 1u) * nloc) {
            __builtin_amdgcn_fence(__ATOMIC_RELEASE, "agent");
            asm volatile("s_waitcnt vmcnt(0)" ::: "memory");
            const unsigned og = xb_add(&bar[XB_TOP], 1u);
            const unsigned tg = og / nx;
            if (og + 1u == (tg + 1u) * nx) xb_add(&bar[XB_TOPGEN], 1u);
            else XB_SPIN(xb_ld(&bar[XB_TOPGEN]) == tg, bar);
            __builtin_amdgcn_fence(__ATOMIC_ACQUIRE, "agent");
            xb_add(&bar[XB_XGEN(b.x)], 1u);
            asm volatile("s_waitcnt vmcnt(0)" ::: "memory");
        } else {
            XB_SPIN(xb_ld(&bar[XB_XGEN(b.x)]) == gen, bar);
            __builtin_amdgcn_fence(__ATOMIC_ACQUIRE, "agent");
            asm volatile("s_waitcnt vmcnt(0)" ::: "memory");
        }
    }
    __syncthreads();
}

namespace pg8 {
constexpr int BM = 256, BK = 64, HALF = 128, HTB = HALF * BK * 2, NXCD = 8, WGM = 8;
__device__ __forceinline__ int lds_byte(int r, int c) { const int st = (r >> 4) * 2 + (c >> 5), rr = r & 15, cc = c & 31, ob = rr * 64 + cc * 2; return st * 1024 + (ob ^ (((ob >> 9) & 1) << 5)); }
__device__ __forceinline__ void stage_rc(int b, int& R, int& C) { const int st = b / 1024, sb = b % 1024, swz = sb ^ (((sb >> 9) & 1) << 5); R = (st >> 1) * 16 + swz / 64; C = (st & 1) * 32 + (swz % 64) / 2; }
__device__ __forceinline__ int perm32(int rho) { const int n = rho >> 4, i = rho & 15; return 8 * (i >> 2) + 4 * n + (i & 3); }

struct UnitD { const char* A; const char* B; int r0; int c0; int e; int ui; };

template <int K, bool PERM, bool GATHER, int MODE  , class Sched, class Epi>
__device__ __forceinline__ void gemm_phase(LAS unsigned char* lds, const Sched& S, const Epi& E, const LAS int* gtab, int wv) {
    int tid = phase_tid(wv);
    const int wid = __builtin_amdgcn_readfirstlane(tid >> 6), lane = tid & 63, wr = wid >> 2, wc = wid & 3, fr = lane & 15, fq = lane >> 4;
    constexpr bool F8 = (MODE != 0);
    constexpr int ES = F8 ? 1 : 2;
    constexpr int nt = K * ES / (BK * 2);
    constexpr size_t BH = Sched::BHALF;
    unsigned voffA[2], voffB[2]; unsigned aoffs[2][2];
#pragma unroll
    for (int i = 0; i < 2; ++i) { int R, C; stage_rc(tid * 16 + i * 8192, R, C); const int Rb = PERM ? ((R & ~31) + perm32(R & 31)) : R;
        voffA[i] = GATHER ? 0u : (unsigned)(R * K * ES + C * 2); voffB[i] = (unsigned)(Rb * K * ES + C * 2); aoffs[0][i] = 0u; aoffs[1][i] = 0u; }
    constexpr size_t kstep = (size_t)(BK * 2);
    constexpr size_t hstep = GATHER ? (size_t)0 : (size_t)HALF * K * ES;
    const unsigned ldsw = (unsigned)wid * 1024u;
    const int aoff = lds_byte(wr * 64 + fr, fq * 8), boff = lds_byte(wc * 32 + fr, fq * 8);
    const int hsel = (MODE == 3) ? 8 * ((fr >> 2) & 1) : 0;
#define PG8_SA(b, h) (((b) * 2 + (h)) * HTB)
#define PG8_SB(b, h) ((4 + (b) * 2 + (h)) * HTB)
#define PG8_STAGE_B(bufoff, gbase) do { _Pragma("unroll") for (int _i = 0; _i < 2; ++_i) { unsigned _o = voffB[_i]; asm volatile("" : "+v"(_o)); \
        __builtin_amdgcn_global_load_lds((const unsigned*)((const char*)(gbase) + _o), (LAS unsigned*)(lds + (bufoff) + ldsw + _i * 8192), 16, 0, 0); } } while (0)
#define PG8_STAGE_A(bufoff, gbase, h) do { _Pragma("unroll") for (int _i = 0; _i < 2; ++_i) { unsigned _o = (GATHER ? aoffs[h][_i] : voffA[_i]); asm volatile("" : "+v"(_o)); \
        __builtin_amdgcn_global_load_lds((const unsigned*)((const char*)(gbase) + _o), (LAS unsigned*)(lds + (bufoff) + ldsw + _i * 8192), 16, 0, 0); } } while (0)
#define PG8_GOFFS(u) do { if constexpr (GATHER) { _Pragma("unroll") for (int _i = 0; _i < 2; ++_i) { int _R, _C; stage_rc(tid * 16 + _i * 8192, _R, _C); \
        aoffs[0][_i] = (unsigned)gtab[(u) * 256 + _R] * (unsigned)(K * ES) + (unsigned)(_C * 2); aoffs[1][_i] = (unsigned)gtab[(u) * 256 + 128 + _R] * (unsigned)(K * ES) + (unsigned)(_C * 2); } } } while (0)
#define PG8_LDA(dst, b, h) do { _Pragma("unroll") for (int m = 0; m < 4; ++m) { if constexpr (MODE == 3) { const v4i _l = *(const LAS v4i*)(lds + PG8_SA(b, h) + aoff + m * 2048); const v2i _h = *(const volatile LAS v2i*)(lds + PG8_SA(b, h) + aoff + hsel + m * 2048 + 1024); \
            dst##8[m] = (v8i){_l.x, _l.y, _l.z, _l.w, _h.x, _h.y, 0, 0}; } \
        else if constexpr (F8) { dst##8[m].lo = *(const LAS v4i*)(lds + PG8_SA(b, h) + aoff + m * 2048); dst##8[m].hi = *(const LAS v4i*)(lds + PG8_SA(b, h) + aoff + m * 2048 + 1024); } \
        else { _Pragma("unroll") for (int k = 0; k < 2; ++k) dst[m][k] = *(const LAS bf16x8*)(lds + PG8_SA(b, h) + aoff + m * 2048 + k * 1024); } } } while (0)
#define PG8_LDB(dst, b, h) do { _Pragma("unroll") for (int n = 0; n < 2; ++n) { if constexpr (MODE == 3) { const v4i _l = *(const LAS v4i*)(lds + PG8_SB(b, h) + boff + n * 2048); const v2i _h = *(const volatile LAS v2i*)(lds + PG8_SB(b, h) + boff + hsel + n * 2048 + 1024); \
            dst##8[n] = (v8i){_l.x, _l.y, _l.z, _l.w, _h.x, _h.y, 0, 0}; } \
        else if constexpr (F8) { dst##8[n].lo = *(const LAS v4i*)(lds + PG8_SB(b, h) + boff + n * 2048); dst##8[n].hi = *(const LAS v4i*)(lds + PG8_SB(b, h) + boff + n * 2048 + 1024); } \
        else { _Pragma("unroll") for (int k = 0; k < 2; ++k) dst[n][k] = *(const LAS bf16x8*)(lds + PG8_SB(b, h) + boff + n * 2048 + k * 1024); } } } while (0)
#define PG8_MMA(ai, bj, At, Bt) do { __builtin_amdgcn_s_setprio(1); _Pragma("unroll") for (int m = 0; m < 4; ++m) _Pragma("unroll") for (int n = 0; n < 2; ++n) { \
        if constexpr (MODE == 1) acc[ai][bj][m][n] = __builtin_amdgcn_mfma_scale_f32_16x16x128_f8f6f4(Bt##8[n], At##8[m], acc[ai][bj][m][n], 0, 0, 0, 0, 0, 0); \
        else if constexpr (MODE == 3) acc[ai][bj][m][n] = __builtin_amdgcn_mfma_scale_f32_16x16x128_f8f6f4(Bt##8[n], At##8[m], acc[ai][bj][m][n], 2, 2, 0, 0, 0, 0); \
        else if constexpr (MODE == 2) { v4i _c = __builtin_bit_cast(v4i, acc[ai][bj][m][n]); _c = __builtin_amdgcn_mfma_i32_16x16x64_i8(Bt##8[n].lo, At##8[m].lo, _c, 0, 0, 0); \
            _c = __builtin_amdgcn_mfma_i32_16x16x64_i8(Bt##8[n].hi, At##8[m].hi, _c, 0, 0, 0); acc[ai][bj][m][n] = __builtin_bit_cast(f32x4, _c); } \
        else { _Pragma("unroll") for (int k = 0; k < 2; ++k) acc[ai][bj][m][n] = __builtin_amdgcn_mfma_f32_16x16x32_bf16(Bt[n][k], At[m][k], acc[ai][bj][m][n], 0, 0, 0); } } \
        __builtin_amdgcn_s_setprio(0); } while (0)
#define PG8_WAIT_V(n) asm volatile("s_waitcnt vmcnt(" #n ")" ::: "memory")
#define PG8_WAIT_L(n) asm volatile("s_waitcnt lgkmcnt(" #n ")" ::: "memory")
#define PG8_WAIT_VR(n) do { if (rel) asm volatile("s_waitcnt vmcnt(%0)" :: "n"((n) + Epi::NST) : "memory"); else asm volatile("s_waitcnt vmcnt(%0)" :: "n"(n) : "memory"); } while (0)
#define PG8_BAR __builtin_amdgcn_s_barrier()
#define PG8_SCHED __builtin_amdgcn_sched_barrier(0)
    UnitD cur, nxt; int ui = 0;
    if (!S.next(0, cur)) return;
    f32x4 acc[2][2][4][2];
#pragma unroll
    for (int a = 0; a < 2; ++a)
#pragma unroll
        for (int b = 0; b < 2; ++b)
#pragma unroll
            for (int m = 0; m < 4; ++m)
#pragma unroll
                for (int n = 0; n < 2; ++n) acc[a][b][m][n] = (f32x4){0.f, 0.f, 0.f, 0.f};
    bf16x8 At[4][2], B0[2][2], B1[2][2]; v8i At8[4], B08[2], B18[2];
    const char* cA = cur.A; const char* cB = cur.B;
    PG8_GOFFS(0);
    PG8_STAGE_B(PG8_SB(0, 0), cB); PG8_STAGE_B(PG8_SB(0, 1), cB + BH); PG8_STAGE_A(PG8_SA(0, 0), cA, 0); PG8_STAGE_A(PG8_SA(0, 1), cA + hstep, 1);
    if (wr == 1) PG8_BAR;
    PG8_WAIT_V(2); PG8_BAR;
    PG8_STAGE_B(PG8_SB(1, 0), cB + kstep); PG8_STAGE_A(PG8_SA(1, 0), cA + kstep, 0); PG8_STAGE_B(PG8_SB(1, 1), cB + BH + kstep);
    PG8_WAIT_V(6); PG8_BAR;
    for (;;) {
        const bool has_next = S.next(ui + 1, nxt);
        const char* nA = has_next ? nxt.A : cA; const char* nB = has_next ? nxt.B : cB;
#pragma clang loop unroll(disable)
        for (int t = 0; t < nt; t += 2) {
            const bool last = (t == nt - 2), rel = (t == 0) && (ui > 0);
            const char* a1 = cA + (size_t)(t + 1) * kstep;
            const char* a2 = last ? nA : cA + (size_t)(t + 2) * kstep;
            const char* b2 = last ? nB : cB + (size_t)(t + 2) * kstep;
            const char* a3 = a2 + kstep; const char* b3 = b2 + kstep;
            PG8_LDB(B0, 0, 0); PG8_LDB(B1, 0, 1); PG8_SCHED; PG8_LDA(At, 0, 0); PG8_STAGE_A(PG8_SA(1, 1), a1 + hstep, 1);
            PG8_WAIT_VR(8); PG8_WAIT_L(0); PG8_BAR; PG8_MMA(0, 0, At, B0); PG8_MMA(0, 1, At, B1); PG8_BAR; PG8_SCHED;
            if (last && has_next) PG8_GOFFS(ui + 1);
            PG8_LDA(At, 0, 1); PG8_STAGE_B(PG8_SB(0, 0), b2); PG8_STAGE_B(PG8_SB(0, 1), b2 + BH); PG8_STAGE_A(PG8_SA(0, 0), a2, 0);
            PG8_WAIT_VR(8); PG8_WAIT_L(0); PG8_BAR; PG8_MMA(1, 0, At, B0); PG8_MMA(1, 1, At, B1); PG8_BAR; PG8_SCHED;
            PG8_LDB(B0, 1, 0); PG8_LDB(B1, 1, 1); PG8_SCHED; PG8_LDA(At, 1, 0); PG8_STAGE_A(PG8_SA(0, 1), a2 + hstep, 1);
            PG8_WAIT_V(8); PG8_WAIT_L(0); PG8_BAR; PG8_MMA(0, 0, At, B0); PG8_MMA(0, 1, At, B1); PG8_BAR; PG8_SCHED;
            PG8_LDA(At, 1, 1); PG8_STAGE_B(PG8_SB(1, 0), b3); PG8_STAGE_B(PG8_SB(1, 1), b3 + BH); PG8_STAGE_A(PG8_SA(1, 0), a3, 0);
            PG8_WAIT_V(8); PG8_WAIT_L(0); PG8_BAR; PG8_MMA(1, 0, At, B0); PG8_MMA(1, 1, At, B1); PG8_BAR; PG8_SCHED;
        }
        if (wr == 0) PG8_BAR;
        { int tz = tid; asm volatile("" : "+v"(tz));
          const int wz = tz >> 6, lz = tz & 63; E(acc, cur, wz >> 2, wz & 3, lz & 15, lz >> 4); }
        if (!has_next) break;
#pragma unroll
        for (int a = 0; a < 2; ++a)
#pragma unroll
            for (int b = 0; b < 2; ++b)
#pragma unroll
                for (int m = 0; m < 4; ++m)
#pragma unroll
                    for (int n = 0; n < 2; ++n) acc[a][b][m][n] = (f32x4){0.f, 0.f, 0.f, 0.f};
        cur = nxt; cA = nA; cB = nB; ++ui;
        if (wr == 1) PG8_BAR;
    }
    PG8_WAIT_V(0);
    PG8_BAR;
#undef PG8_SA
#undef PG8_SB
#undef PG8_STAGE_A
#undef PG8_STAGE_B
#undef PG8_GOFFS
#undef PG8_LDA
#undef PG8_LDB
#undef PG8_MMA
#undef PG8_WAIT_V
#undef PG8_WAIT_L
#undef PG8_WAIT_VR
#undef PG8_BAR
#undef PG8_SCHED
}

template <int K, int ES = 2> struct DenseSched {
    static constexpr size_t BHALF = (size_t)128 * K * ES, tstep = (size_t)256 * K * ES;
    const char* A; const char* Bt; int nM, nN, nwg, G, c;
    __device__ __forceinline__ bool next(int i, UnitD& u) const {
        const long L = (long)i * G + c; if (L >= nwg) return false;
        int wgid = (int)L; { const int q = nwg / NXCD, r = nwg % NXCD, xcd = wgid % NXCD, off = wgid / NXCD; wgid = (xcd < r ? xcd * (q + 1) : r * (q + 1) + (xcd - r) * q) + off; }
        const int nig = WGM * nN, gid = wgid / nig, fm = gid * WGM, gsz = (nM - fm) < WGM ? (nM - fm) : WGM;
        const int pm = fm + ((wgid % nig) % gsz), pn = (wgid % nig) / gsz;
        u.A = A + (size_t)pm * tstep; u.B = Bt + (size_t)pn * tstep; u.r0 = pm * 256; u.c0 = pn * 256; u.e = 0; u.ui = i; return true;
    }
};
}

struct Args { const float* in[28]; float* out; unsigned char* ws; int ph_lo, ph_hi; };
typedef const __attribute__((address_space(4))) Args* CArgs;
__device__ __forceinline__ CArgs cargs() { CArgs p = (CArgs)__builtin_amdgcn_kernarg_segment_ptr(); asm volatile("" : "+s"(p)); return p; }
enum { I_X = 0, I_EVWIN, I_EVBIN, I_POOLW, I_POOLB, I_POOLS, I_CONVW, I_CONVB, I_CLNG, I_CLNB, I_EVWOUT, I_EVBOUT, I_ODWIN, I_ODBIN, I_SLNG, I_SLNB, I_SGUW, I_SGUB, I_ODWOUT, I_ODBOUT,
       I_RW, I_RB, I_WUP, I_BUP, I_WDOWN, I_BDOWN, I_LNG, I_LNB };

__device__ __forceinline__ void transpose_item(const float* W, int K, int N, bf16* WT, LAS float* scr, int item, int lane) {
    const int nblk = N / 32, kb = item / nblk, nb = item % nblk, k0 = 64 * kb, n0 = 32 * nb;
#pragma unroll 8
    for (int i = 0; i < 32; ++i) { const int kk = 2 * i + (lane >> 5); scr[kk * 33 + (lane & 31)] = W[(size_t)(k0 + kk) * N + n0 + (lane & 31)]; }
    LDS_WAIT(); asm volatile("" ::: "memory");
    const int c = lane & 7;
#pragma unroll
    for (int j = 0; j < 4; ++j) { const int n = (lane >> 3) + 8 * j; const LAS float* s = scr + (8 * c) * 33 + n;
        u32x4 o; o.x = pk2(s[0 * 33], s[1 * 33]); o.y = pk2(s[2 * 33], s[3 * 33]); o.z = pk2(s[4 * 33], s[5 * 33]); o.w = pk2(s[6 * 33], s[7 * 33]);
        *(u32x4*)(WT + (size_t)(n0 + n) * K + k0 + 8 * c) = o; }
    LDS_WAIT(); asm volatile("" ::: "memory");
}
__device__ __forceinline__ unsigned pk4_fp8(float a, float b, float c, float d) {
    a = fminf(fmaxf(a, -448.f), 448.f); b = fminf(fmaxf(b, -448.f), 448.f); c = fminf(fmaxf(c, -448.f), 448.f); d = fminf(fmaxf(d, -448.f), 448.f);
    int r = 0; r = __builtin_amdgcn_cvt_pk_fp8_f32(a, b, r, false); r = __builtin_amdgcn_cvt_pk_fp8_f32(c, d, r, true); return (unsigned)r;
}
template <bool EMU> __device__ __forceinline__ float e2m3q(float y) { if constexpr (EMU) { y = fminf(fmaxf(y, -7.5f), 7.5f); return fabsf(y) < 1.f ? rintf(y * 8.f) * 0.125f : y; } else return y; }
__device__ __forceinline__ void transpose_item8(const float* W, int K, int N, unsigned char* WT, LAS float* scr, int item, int lane, float qs) {
    const int nblk = N / 32, kb = item / nblk, nb = item % nblk, k0 = 64 * kb, n0 = 32 * nb;
#pragma unroll 8
    for (int i = 0; i < 32; ++i) { const int kk = 2 * i + (lane >> 5); scr[kk * 33 + (lane & 31)] = W[(size_t)(k0 + kk) * N + n0 + (lane & 31)] * qs; }
    LDS_WAIT(); asm volatile("" ::: "memory");
    const int c = lane & 7;
#pragma unroll
    for (int j = 0; j < 4; ++j) { const int n = (lane >> 3) + 8 * j; const LAS float* s = scr + (8 * c) * 33 + n;
        u32x2 o; o.x = pk4_fp8(s[0 * 33], s[1 * 33], s[2 * 33], s[3 * 33]); o.y = pk4_fp8(s[4 * 33], s[5 * 33], s[6 * 33], s[7 * 33]);
        *(u32x2*)(WT + (size_t)(n0 + n) * K + k0 + 8 * c) = o; }
    LDS_WAIT(); asm volatile("" ::: "memory");
}
__device__ __forceinline__ void conv_group8(const float* W, int K, int N, int nmat, unsigned char* WT, LAS float* scr, int gw, int NGW, int lane, float qs) {
    const int per = (K / 64) * (N / 32); const long total = (long)per * nmat;
    for (long it = gw; it < total; it += NGW) { const int mi = (int)(it / per), r = (int)(it % per);
        transpose_item8(W + (size_t)mi * K * N, K, N, WT + (size_t)mi * K * N, scr, r, lane, qs); }
}
__device__ __forceinline__ void conv_issue(const float* W, int K, int N, long it, long per, int nblk, LAS unsigned char* tile, int lane) {
    const int mi = (int)(it / per), r = (int)(it % per), nb = r % nblk, kb = r / nblk, k0 = kb * 128, n0 = nb * 32;
    const float* src = W + (size_t)mi * K * N + (size_t)(k0 + (lane >> 3)) * N + n0;
#pragma unroll
    for (int j = 0; j < 16; ++j)
        __builtin_amdgcn_global_load_lds((const unsigned*)(src + (size_t)(8 * j) * N + 4 * ((lane & 7) ^ (j >> 1))), (LAS unsigned*)(tile + j * 1024), 16, 0, 2);
}
template <bool EMU = false> __device__ __forceinline__ void conv_dma8(const float* W, int K, int N, int nmat, unsigned char* WT, LAS unsigned char* tile, int gw, int NGW, int lane, float qs) {
    const int nblk = N / 32; const long per = (long)(K / 128) * nblk, total = per * nmat;
    long it = gw;
    if (it < total) conv_issue(W, K, N, it, per, nblk, tile, lane);
    const int c = lane & 7, nn = lane >> 3;
#pragma unroll 1
    for (; it < total; it += NGW) {
        if (it == gw) asm volatile("s_waitcnt vmcnt(0)" ::: "memory");
        else asm volatile("s_waitcnt vmcnt(4)" ::: "memory");
        const int mi = (int)(it / per), r = (int)(it % per), nb = r % nblk, kb = r / nblk, k0 = kb * 128, n0 = nb * 32;
        float v[4][16];
#pragma unroll
        for (int jj = 0; jj < 4; ++jj) { const int n = nn + 8 * jj;
#pragma unroll
            for (int i = 0; i < 16; ++i) v[jj][i] = *(const LAS float*)(tile + (16 * c + i) * 128 + (((n >> 2) ^ c) * 16) + (n & 3) * 4); }
        asm volatile("s_waitcnt lgkmcnt(0)" ::: "memory");
        const long nx = it + NGW;
        if (nx < total) conv_issue(W, K, N, nx, per, nblk, tile, lane);
        unsigned char* dst = WT + (size_t)mi * K * N + (size_t)n0 * K + k0 + 16 * c;
#pragma unroll
        for (int jj = 0; jj < 4; ++jj) { const int n = nn + 8 * jj; u32x4 o;
#define QE(x) e2m3q<EMU>((x) * qs)
            o.x = pk4_fp8(QE(v[jj][0]), QE(v[jj][1]), QE(v[jj][2]), QE(v[jj][3])); o.y = pk4_fp8(QE(v[jj][4]), QE(v[jj][5]), QE(v[jj][6]), QE(v[jj][7]));
            o.z = pk4_fp8(QE(v[jj][8]), QE(v[jj][9]), QE(v[jj][10]), QE(v[jj][11])); o.w = pk4_fp8(QE(v[jj][12]), QE(v[jj][13]), QE(v[jj][14]), QE(v[jj][15]));
#undef QE
            __builtin_nontemporal_store(o, (u32x4*)(dst + (size_t)n * K)); }
        if (nx >= total) asm volatile("s_waitcnt vmcnt(0)" ::: "memory");
    }
}
__device__ __forceinline__ v6u pack32_fp6(const v16u w) { return __builtin_amdgcn_cvt_scalef32_pk32_fp6_bf16(__builtin_bit_cast(v32bf, w), 1.0f); }
__device__ __forceinline__ void xpose4(unsigned& r0, unsigned& r1, unsigned& r2, unsigned& r3) {
    u32x2 t;
    t = __builtin_amdgcn_permlane16_swap(r0, r1, false, false); r0 = t.x; r1 = t.y;
    t = __builtin_amdgcn_permlane16_swap(r2, r3, false, false); r2 = t.x; r3 = t.y;
    t = __builtin_amdgcn_permlane32_swap(r0, r2, false, false); r0 = t.x; r2 = t.y;
    t = __builtin_amdgcn_permlane32_swap(r1, r3, false, false); r1 = t.x; r3 = t.y;
}
__device__ __forceinline__ void conv_issue6(const float* W, int K, int N, long it, long per, int nblk, LAS unsigned char* tile, int lane) {
    const int mi = (int)(it / per), r = (int)(it % per), nb = r % nblk, kb = r / nblk, k0 = kb * 128, n0 = nb * 32;
    const float* src = W + (size_t)mi * K * N + (size_t)k0 * N + n0;
#pragma unroll
    for (int j = 0; j < 16; ++j)
        __builtin_amdgcn_global_load_lds((const unsigned*)(src + (size_t)(8 * j + ((lane >> 3) ^ (j >> 3))) * N + 4 * ((lane & 7) ^ (4 * ((j >> 2) & 1)))), (LAS unsigned*)(tile + j * 1024), 16, 0, 2);
}
__device__ __forceinline__ void conv_dma6(const float* W, int K, int N, int nmat, unsigned char* WT, LAS unsigned char* tile, int gw, int NGW, int lane, float qs) {
    const int nblk = N / 32; const long per = (long)(K / 128) * nblk, total = per * nmat;
    long it = gw;
    if (it < total) conv_issue6(W, K, N, it, per, nblk, tile, lane);
    const int c = lane & 3, nn = lane >> 2;
#pragma unroll 1
    for (; it < total; it += NGW) {
        if (it == gw) asm volatile("s_waitcnt vmcnt(0)" ::: "memory");
        else asm volatile("s_waitcnt vmcnt(4)" ::: "memory");
        const int mi = (int)(it / per), r = (int)(it % per), nb = r % nblk, kb = r / nblk, k0 = kb * 128, n0 = nb * 32;
        float v[2][32];
#pragma unroll
        for (int jj = 0; jj < 2; ++jj) { const int n = nn + 16 * jj;
#pragma unroll
            for (int i = 0; i < 32; ++i) v[jj][i] = *(const LAS float*)(tile + ((32 * c + i) ^ (c >> 1)) * 128 + (((n >> 2) ^ (4 * (c & 1))) * 16) + (n & 3) * 4); }
        asm volatile("s_waitcnt lgkmcnt(0)" ::: "memory");
        const long nx = it + NGW;
        if (nx < total) conv_issue6(W, K, N, nx, per, nblk, tile, lane);
        unsigned char* dst = WT + (size_t)mi * K * N + (size_t)n0 * K + k0 + 16 * c;
#pragma unroll
        for (int jj = 0; jj < 2; ++jj) { const int n = nn + 16 * jj; v16u w;
#pragma unroll
            for (int p = 0; p < 16; ++p) w[p] = pk2(v[jj][2 * p] * qs, v[jj][2 * p + 1] * qs);
            const v6u o = pack32_fp6(w);
            __builtin_nontemporal_store((u32x4){o[0], o[1], o[2], o[3]}, (u32x4*)(dst + (size_t)n * K));
            __builtin_nontemporal_store((u32x4){o[4], o[5], o[4], o[5]}, (u32x4*)(dst + (size_t)n * K + 64)); }
        if (nx >= total) asm volatile("s_waitcnt vmcnt(0)" ::: "memory");
    }
}
__device__ __forceinline__ void conv_group(const float* W, int K, int N, int nmat, bf16* WT, LAS float* scr, int gw, int NGW, int lane) {
    const int per = (K / 64) * (N / 32); const long total = (long)per * nmat;
    for (long it = gw; it < total; it += NGW) { const int mi = (int)(it / per), r = (int)(it % per);
        transpose_item(W + (size_t)mi * K * N, K, N, WT + (size_t)mi * K * N, scr, r, lane); }
}
__device__ __forceinline__ void phase_convert(CArgs a, LAS unsigned char* lds, int wv) {
    int tid = phase_tid(wv);
    const int lane = tid & 63, wave = __builtin_amdgcn_readfirstlane(tid >> 6), G = gridDim.x;
    LAS float* scr = (LAS float*)(lds + wave * 16384);
    const int gw = blockIdx.x * NWAVES + wave, NGW = G * NWAVES;
    unsigned char* ws = a->ws;
    conv_group(a->in[I_EVWOUT], DM, DM, 2, (bf16*)(ws + WS_WEVOUT), scr, gw, NGW, lane);
    conv_dma8(a->in[I_ODWOUT], SGU_W, DM, 2, ws + WS_WODOUT, lds + wave * 16384, gw, NGW, lane, QS_WODOUT);
    conv_group(a->in[I_POOLW], 128, 128, 8, (bf16*)(ws + WS_WPOOL), scr, gw, NGW, lane);
    if (FP6_UP) conv_dma6(a->in[I_WUP], DM, 2 * DM, DEPTH * NEXP, ws + WS_WUP, lds + wave * 16384, gw, NGW, lane, QS_WUP);
    else conv_dma8(a->in[I_WUP], DM, 2 * DM, DEPTH * NEXP, ws + WS_WUP, lds + wave * 16384, gw, NGW, lane, QS_WUP);
    conv_dma8<EMU_DOWN != 0>(a->in[I_WDOWN], DM, DM, DEPTH * NEXP, ws + WS_WDOWN, lds + wave * 16384, gw, NGW, lane, QS_WDOWN);
    const long gt = (long)blockIdx.x * NTHR + tid, GT = (long)G * NTHR;
    { bf16* rh = (bf16*)(ws + WS_RWH); bf16* rl = (bf16*)(ws + WS_RWL); const float* rw = a->in[I_RW];
      for (long i = gt; i < (long)DEPTH * DM * NEXP; i += GT) { const int L = (int)(i / (DM * NEXP)), r = (int)(i % (DM * NEXP)), e = r / DM, k = r % DM;
          const float w = rw[(size_t)L * DM * NEXP + (size_t)k * NEXP + e]; const unsigned h = f2bf(w); rh[i] = (bf16)h; rl[i] = (bf16)f2bf(w - bflo(h)); } }
    { bf16* o = (bf16*)(ws + WS_WSGU); const float* w = a->in[I_SGUW];
      for (long i = gt; i < 2L * 8 * 128 * 128; i += GT) { const int ii = (int)((i >> 7) & 127), jj = (int)(i & 127); const float v = ((ii >> 6) >= (jj >> 6)) ? w[i] : 0.f; o[i] = (bf16)f2bf(v); } }
    { const float* x = a->in[I_X]; bf16* XB = (bf16*)(ws + WS_XB); unsigned char* XQ = ws + WS_XQ; float* SX = (float*)(ws + WS_SX);
      for (int tok = gw; tok < NTOK; tok += NGW) { f32x4 v[2][2]; float am = 0.f;
#pragma unroll
          for (int j = 0; j < 2; ++j) { v[j][0] = *(const f32x4*)(x + (size_t)tok * DM + lane * 8 + 512 * j); v[j][1] = *(const f32x4*)(x + (size_t)tok * DM + lane * 8 + 512 * j + 4);
              const f32x4 a0 = __builtin_elementwise_abs(v[j][0]), a1 = __builtin_elementwise_abs(v[j][1]); am = fmaxf(am, fmaxf(fmaxf(fmaxf(a0.x, a0.y), fmaxf(a0.z, a0.w)), fmaxf(fmaxf(a1.x, a1.y), fmaxf(a1.z, a1.w)))); }
          am = fmaxf(wave_max(am, lane), 1e-20f); const float inv = 127.f / am; if (lane == 0) SX[tok] = am * (1.f / 127.f);
#pragma unroll
          for (int j = 0; j < 2; ++j) { const int c0 = lane * 8 + 512 * j;
              u32x4 w; w.x = pk2(v[j][0].x, v[j][0].y); w.y = pk2(v[j][0].z, v[j][0].w); w.z = pk2(v[j][1].x, v[j][1].y); w.w = pk2(v[j][1].z, v[j][1].w); *(u32x4*)(XB + (size_t)tok * DM + c0) = w;
              u32x2 q; q.x = pk4_i8(v[j][0].x, v[j][0].y, v[j][0].z, v[j][0].w, inv); q.y = pk4_i8(v[j][1].x, v[j][1].y, v[j][1].z, v[j][1].w, inv); *(u32x2*)(XQ + (size_t)tok * DM + c0) = q; } } }
    { unsigned* cmax = (unsigned*)(ws + WS_CTL) + CW_CMAX;
      constexpr int IT_EV = 2 * 8 * (EVEN_IN / 64), IT_OD = 2 * 8 * (2 * SGU_W / 64);
      for (int it = gw; it < IT_EV + IT_OD; it += NGW) { const bool od = it >= IT_EV; const int r = od ? it - IT_EV : it, N = od ? 2 * SGU_W : EVEN_IN, nblk = N / 64;
          const int mat = r / (8 * nblk), r2 = r % (8 * nblk), kc = r2 / nblk, nb = r2 % nblk, n = nb * 64 + lane;
          const float* W = (od ? a->in[I_ODWIN] : a->in[I_EVWIN]) + (size_t)mat * DM * N + (size_t)(kc * 128) * N + n; float m = 0.f;
#pragma unroll 16
          for (int i = 0; i < 128; ++i) m = fmaxf(m, fabsf(W[(size_t)i * N]));
          __hip_atomic_fetch_max(cmax + (od ? 2 * EVEN_IN : 0) + mat * N + n, __builtin_bit_cast(unsigned, m), __ATOMIC_RELAXED, __HIP_MEMORY_SCOPE_AGENT); } }
}
__device__ __forceinline__ void transpose_item_i8(const float* W, int K, int N, unsigned char* WT, const unsigned* cmax, float* sw, LAS float* scr, int item, int lane) {
    const int nblk = N / 32, kb = item / nblk, nb = item % nblk, k0 = 64 * kb, n0 = 32 * nb;
#pragma unroll 8
    for (int i = 0; i < 32; ++i) { const int kk = 2 * i + (lane >> 5); scr[kk * 33 + (lane & 31)] = W[(size_t)(k0 + kk) * N + n0 + (lane & 31)]; }
    LDS_WAIT(); asm volatile("" ::: "memory");
    const int c = lane & 7;
#pragma unroll
    for (int j = 0; j < 4; ++j) { const int n = (lane >> 3) + 8 * j; const LAS float* s = scr + (8 * c) * 33 + n;
        const float am = fmaxf(__builtin_bit_cast(float, cmax[n0 + n]), 1e-20f), inv = 127.f / am;
        u32x2 o; o.x = pk4_i8(s[0 * 33], s[1 * 33], s[2 * 33], s[3 * 33], inv); o.y = pk4_i8(s[4 * 33], s[5 * 33], s[6 * 33], s[7 * 33], inv);
        *(u32x2*)(WT + (size_t)(n0 + n) * K + k0 + 8 * c) = o;
        if (k0 == 0 && c == 0) sw[n0 + n] = am * (1.f / 127.f); }
    LDS_WAIT(); asm volatile("" ::: "memory");
}
__device__ __forceinline__ void phase_convert_b(CArgs a, LAS unsigned char* lds, int wv) {
    const int tid = phase_tid(wv), lane = tid & 63, wave = __builtin_amdgcn_readfirstlane(tid >> 6), G = gridDim.x;
    LAS float* scr = (LAS float*)(lds + wave * 16384);
    const int gw = blockIdx.x * NWAVES + wave, NGW = G * NWAVES;
    unsigned char* ws = a->ws; const unsigned* cmax = (const unsigned*)(ws + WS_CTL) + CW_CMAX;
    constexpr int PER_EV = (DM / 64) * (EVEN_IN / 32), PER_OD = (DM / 64) * (2 * SGU_W / 32);
    for (int it = gw; it < 2 * PER_EV + 2 * PER_OD; it += NGW) {
        if (it < 2 * PER_EV) { const int mat = it / PER_EV, r = it % PER_EV;
            transpose_item_i8(a->in[I_EVWIN] + (size_t)mat * DM * EVEN_IN, DM, EVEN_IN, ws + WS_WEVIN + (size_t)mat * DM * EVEN_IN, cmax + mat * EVEN_IN, (float*)(ws + WS_SWEV) + mat * EVEN_IN, scr, r, lane); }
        else { const int it2 = it - 2 * PER_EV, mat = it2 / PER_OD, r = it2 % PER_OD;
            transpose_item_i8(a->in[I_ODWIN] + (size_t)mat * DM * 2 * SGU_W, DM, 2 * SGU_W, ws + WS_WODIN + (size_t)mat * DM * 2 * SGU_W, cmax + 2 * EVEN_IN + mat * 2 * SGU_W, (float*)(ws + WS_SWOD) + mat * 2 * SGU_W, scr, r, lane); }
    }
}

using pg8::UnitD;
struct EpiBiasBf16 {
    static constexpr int NST = 16;
    bf16* O; int ldc; const float* bias; const float* sx; const float* sw;
    __device__ __forceinline__ void operator()(const f32x4 (&acc)[2][2][4][2], const UnitD& u, int wr, int wc, int fr, int fq) const {
        const int row0 = u.r0 + wr * 64 + fr, col0 = u.c0 + wc * 32 + 8 * fq;
#pragma unroll
        for (int bj = 0; bj < 2; ++bj) { const f32x4 bv0 = *(const f32x4*)(bias + col0 + bj * 128), bv1 = *(const f32x4*)(bias + col0 + bj * 128 + 4);
            const f32x4 sw0 = *(const f32x4*)(sw + col0 + bj * 128), sw1 = *(const f32x4*)(sw + col0 + bj * 128 + 4);
#pragma unroll
            for (int ai = 0; ai < 2; ++ai)
#pragma unroll
                for (int m = 0; m < 4; ++m) { const int row = row0 + ai * 128 + m * 16; const float s = sx[row];
                    const v4i i0 = __builtin_bit_cast(v4i, acc[ai][bj][m][0]), i1 = __builtin_bit_cast(v4i, acc[ai][bj][m][1]);
                    const f32x4 v0 = __builtin_convertvector(i0, f32x4) * (sw0 * s) + bv0, v1 = __builtin_convertvector(i1, f32x4) * (sw1 * s) + bv1;
                    u32x4 w; w.x = pk2(v0[0], v0[1]); w.y = pk2(v0[2], v0[3]); w.z = pk2(v1[0], v1[1]); w.w = pk2(v1[2], v1[3]);
                    *(u32x4*)(O + (size_t)row * ldc + col0 + bj * 128) = w; } }
    }
};
__device__ __forceinline__ f32x2 gelu_pk(f32x2 v) {
    f32x2 vc; vc.x = __builtin_amdgcn_fmed3f(v.x, -4.25f, 4.25f); vc.y = __builtin_amdgcn_fmed3f(v.y, -4.25f, 4.25f);
    const f32x2 s = vc * vc;
    f32x2 q = s * (-2.562045892e-12f) + 2.732375520e-10f;
    q = q * s + (-1.309781371e-08f); q = q * s + 3.770278565e-07f; q = q * s + (-7.377925681e-06f); q = q * s + 1.056265650e-04f;
    q = q * s + (-1.158376687e-03f); q = q * s + 9.925602724e-03f; q = q * s + (-6.645352160e-02f); q = q * s + 3.989338899e-01f;
    return v * (vc * q + 0.5f);
}
struct EpiGeluStats {
    static constexpr int NST = 16;
    bf16* O; const float* bias; float* stats; const float* sx; const float* sw;
    __device__ __forceinline__ void operator()(const f32x4 (&acc)[2][2][4][2], const UnitD& u, int wr, int wc, int fr, int fq) const {
        const int row0 = u.r0 + wr * 64 + fr, col0 = u.c0 + wc * 32 + 8 * fq;
        const bool isv = u.c0 >= SGU_W; const int slot = ((u.c0 - SGU_W) >> 8) * 4 + wc;
        f32x4 bv[2][2], sv[2][2];
#pragma unroll
        for (int bj = 0; bj < 2; ++bj)
#pragma unroll
            for (int n = 0; n < 2; ++n) { bv[bj][n] = *(const f32x4*)(bias + col0 + bj * 128 + 4 * n); sv[bj][n] = *(const f32x4*)(sw + col0 + bj * 128 + 4 * n); }
#pragma unroll
        for (int ai = 0; ai < 2; ++ai)
#pragma unroll
            for (int m = 0; m < 4; ++m) { const int row = row0 + ai * 128 + m * 16; bf16* rowp = O + (size_t)row * (2 * SGU_W) + col0; float s = 0.f, q = 0.f; const float sr = sx[row];
#pragma unroll
                for (int bj = 0; bj < 2; ++bj) {
                    f32x4 v0 = __builtin_convertvector(__builtin_bit_cast(v4i, acc[ai][bj][m][0]), f32x4) * (sv[bj][0] * sr) + bv[bj][0];
                    f32x4 v1 = __builtin_convertvector(__builtin_bit_cast(v4i, acc[ai][bj][m][1]), f32x4) * (sv[bj][1] * sr) + bv[bj][1];
                    { const f32x2 ga = gelu_pk((f32x2){v0[0], v0[1]}), gb = gelu_pk((f32x2){v0[2], v0[3]}), gc = gelu_pk((f32x2){v1[0], v1[1]}), gd = gelu_pk((f32x2){v1[2], v1[3]});
                      v0 = (f32x4){ga.x, ga.y, gb.x, gb.y}; v1 = (f32x4){gc.x, gc.y, gd.x, gd.y}; }
#pragma unroll
                    for (int j = 0; j < 4; ++j) { s += v0[j] + v1[j]; q += v0[j] * v0[j] + v1[j] * v1[j]; }
                    u32x4 w; w.x = pk2(v0[0], v0[1]); w.y = pk2(v0[2], v0[3]); w.z = pk2(v1[0], v1[1]); w.w = pk2(v1[2], v1[3]);
                    *(u32x4*)(rowp + bj * 128) = w; }
                if (isv) { const int ln = fq * 16 + fr; s += shx(s, 16, ln); s += shx(s, 32, ln); q += shx(q, 16, ln); q += shx(q, 32, ln);
                    if (fq == 0) *(f32x2*)(stats + (size_t)row * 64 + slot * 2) = (f32x2){s, q}; } }
    }
};
struct EpiZ {
    static constexpr int NST = 32;
    bf16* Z; const float* bias; const bf16* X; float sc;
    __device__ __forceinline__ void operator()(const f32x4 (&acc)[2][2][4][2], const UnitD& u, int wr, int wc, int fr, int fq) const {
        const int row0 = u.r0 + wr * 64 + fr, col0 = u.c0 + wc * 32 + 8 * fq;
#pragma unroll
        for (int bj = 0; bj < 2; ++bj) { const f32x4 bv0 = *(const f32x4*)(bias + col0 + bj * 128), bv1 = *(const f32x4*)(bias + col0 + bj * 128 + 4);
#pragma unroll
            for (int ai = 0; ai < 2; ++ai)
#pragma unroll
                for (int m = 0; m < 4; ++m) { const size_t ro = (size_t)(row0 + ai * 128 + m * 16) * DM + col0 + bj * 128;
                    const u32x4 xr = *(const u32x4*)(X + ro);
                    const f32x4 v0 = acc[ai][bj][m][0] * sc + bv0 + DN_ALPHA * (f32x4){bflo(xr.x), bfhi(xr.x), bflo(xr.y), bfhi(xr.y)};
                    const f32x4 v1 = acc[ai][bj][m][1] * sc + bv1 + DN_ALPHA * (f32x4){bflo(xr.z), bfhi(xr.z), bflo(xr.w), bfhi(xr.w)};
                    u32x4 w; w.x = pk2(v0[0], v0[1]); w.y = pk2(v0[2], v0[3]); w.z = pk2(v1[0], v1[1]); w.w = pk2(v1[2], v1[3]);
                    *(u32x4*)(Z + ro) = w; } }
    }
};
struct EpiUp {
    static constexpr int NST = 8;
    unsigned char* H; const LAS float* bl_lds;
    static __device__ __forceinline__ f32x2 act2(f32x2 g, f32x2 l) {
        g = __builtin_elementwise_min(g, (f32x2){7.f, 7.f}); l = __builtin_elementwise_min(__builtin_elementwise_max(l, (f32x2){-7.f, -7.f}), (f32x2){7.f, 7.f});
        const f32x2 t = g * (-1.702f * 1.44269504089f); f32x2 e; e.x = __builtin_amdgcn_exp2f(t.x); e.y = __builtin_amdgcn_exp2f(t.y);
        const f32x2 d = e + 1.0f; f32x2 r; r.x = __builtin_amdgcn_rcpf(d.x); r.y = __builtin_amdgcn_rcpf(d.y);
        return (g * r) * (l * QS_ACT + QS_ACT);
    }
    __device__ __forceinline__ void operator()(const f32x4 (&acc)[2][2][4][2], const UnitD& u, int wr, int wc, int fr, int fq) const {
        const int row0 = u.r0 + wr * 64 + fr, col0 = u.c0 + wc * 32 + 8 * fq;
        const LAS float* bg = bl_lds + u.ui * 256 + wc * 32 + 8 * fq; const LAS float* bl = bg + 128;
        f32x4 bgv[2], blv[2];
#pragma unroll
        for (int n = 0; n < 2; ++n) { bgv[n] = *(const LAS f32x4*)(bg + 4 * n); blv[n] = *(const LAS f32x4*)(bl + 4 * n); }
        constexpr float SC = 1.f / (QS_X1 * QS_WUP);
#pragma unroll
        for (int ai = 0; ai < 2; ++ai)
#pragma unroll
            for (int m = 0; m < 4; ++m) { unsigned char* rowp = H + (size_t)(row0 + ai * 128 + m * 16) * DM + col0; u32x2 w;
#pragma unroll
                for (int n = 0; n < 2; ++n) { const f32x4 g = acc[ai][0][m][n] * SC + bgv[n], l = acc[ai][1][m][n] * SC + blv[n];
                    const f32x2 o0 = act2((f32x2){g[0], g[1]}, (f32x2){l[0], l[1]}), o1 = act2((f32x2){g[2], g[3]}, (f32x2){l[2], l[3]});
                    int r = 0; r = __builtin_amdgcn_cvt_pk_fp8_f32(e2m3q<EMU_DOWN != 0>(o0.x), e2m3q<EMU_DOWN != 0>(o0.y), r, false); r = __builtin_amdgcn_cvt_pk_fp8_f32(e2m3q<EMU_DOWN != 0>(o1.x), e2m3q<EMU_DOWN != 0>(o1.y), r, true);
                    if (n == 0) w.x = (unsigned)r; else w.y = (unsigned)r; }
                *(u32x2*)rowp = w; }
    }
};
struct EpiDown {
    static constexpr int NST = 16;
    bf16* Y; const LAS float* bl_lds;
    __device__ __forceinline__ void operator()(const f32x4 (&acc)[2][2][4][2], const UnitD& u, int wr, int wc, int fr, int fq) const {
        const int row0 = u.r0 + wr * 64 + fr, col0 = u.c0 + wc * 32 + 8 * fq;
        const LAS float* bias = bl_lds + u.ui * 256 + wc * 32 + 8 * fq;
#pragma unroll
        for (int bj = 0; bj < 2; ++bj) { const f32x4 bv0 = *(const LAS f32x4*)(bias + bj * 128), bv1 = *(const LAS f32x4*)(bias + bj * 128 + 4);
#pragma unroll
            for (int ai = 0; ai < 2; ++ai)
#pragma unroll
                for (int m = 0; m < 4; ++m) { bf16* rowp = Y + (size_t)(row0 + ai * 128 + m * 16) * DM + col0 + bj * 128;
                    const f32x4 v0 = acc[ai][bj][m][0] * (1.f / (QS_ACT * QS_WDOWN)) + bv0, v1 = acc[ai][bj][m][1] * (1.f / (QS_ACT * QS_WDOWN)) + bv1;
                    u32x4 w; w.x = pk2(v0[0], v0[1]); w.y = pk2(v0[2], v0[3]); w.z = pk2(v1[0], v1[1]); w.w = pk2(v1[2], v1[3]);
                    *(u32x4*)rowp = w; } }
    }
};

struct UpSched {
    static constexpr size_t BHALF = (size_t)1024 * DM;
    const LAS int* ut; const char* X1B; const char* W;
    __device__ __forceinline__ bool next(int i, UnitD& u) const {
        if (i >= MAXU) return false;
        const int valid = __builtin_amdgcn_readfirstlane(ut[i * 4 + 3]); if (!valid) return false;
        const int e = __builtin_amdgcn_readfirstlane(ut[i * 4 + 0]), mt = __builtin_amdgcn_readfirstlane(ut[i * 4 + 1]), nt = __builtin_amdgcn_readfirstlane(ut[i * 4 + 2]);
        u.A = X1B; u.B = W + ((size_t)e * 2048 + nt * 128) * DM; u.r0 = mt * 256; u.c0 = nt * 128; u.e = e; u.ui = i; return true;
    }
};
struct DownSched {
    static constexpr size_t BHALF = (size_t)128 * DM;
    const LAS int* ut; const char* H; const char* W;
    __device__ __forceinline__ bool next(int i, UnitD& u) const {
        if (i >= MAXU) return false;
        const int valid = __builtin_amdgcn_readfirstlane(ut[i * 4 + 3]); if (!valid) return false;
        const int e = __builtin_amdgcn_readfirstlane(ut[i * 4 + 0]), mt = __builtin_amdgcn_readfirstlane(ut[i * 4 + 1]), nt = __builtin_amdgcn_readfirstlane(ut[i * 4 + 2]);
        u.A = H + (size_t)mt * 256 * DM; u.B = W + ((size_t)e * 1024 + nt * 256) * DM; u.r0 = mt * 256; u.c0 = nt * 256; u.e = e; u.ui = i; return true;
    }
};
template <int NTN, bool ROWS, bool REUSE = false>
__device__ __forceinline__ void moe_tables(CArgs a, LAS unsigned char* lds, int L, int wv, const float* bias  ) {
    int tid = phase_tid(wv);
    const int G = gridDim.x;
    LAS int* misc = (LAS int*)(lds + MISC_OFF);
    LAS int* ut = (LAS int*)(lds + UT_OFF);
    LAS int* tab = (LAS int*)(lds + TAB_OFF);
    const unsigned* cntw = (const unsigned*)(a->ws + WS_CTL) + CW_CNT + (size_t)L * NEXP * 64;
    __syncthreads();
    if (!(REUSE && MK_SINGLE)) {
        if (tid < 64) { const int ln = tid & 63; int c = 0; if (ln < NEXP) c = (int)__hip_atomic_load(cntw + ln * 64, __ATOMIC_RELAXED, __HIP_MEMORY_SCOPE_AGENT);
            const int n = (c + 255) >> 8; int s = n;
#pragma unroll
            for (int o = 1; o < 32; o <<= 1) { const int t = __builtin_amdgcn_ds_bpermute(((ln - o) & 63) << 2, s); if ((ln & 31) >= o) s += t; }
            if (ln < NEXP) { misc[64 + ln] = c; misc[16 + ln] = s - n; if (ln == NEXP - 1) misc[16 + NEXP] = s; } }
        __syncthreads();
    }
    if (tid < MAXU) {
        const int T = misc[16 + NEXP];
        const int x = blockIdx.x & 7, w = blockIdx.x >> 3, WPX = G >> 3, MPG = WPX / NTN;
        const int mt = (tid * 8 + x) * MPG + w / NTN, nt = w % NTN;
        int e = 0; for (int k = 1; k < NEXP; ++k) if (misc[16 + k] <= mt) e = k;
        const int valid = mt < T ? 1 : 0;
        ut[tid * 4 + 0] = e; ut[tid * 4 + 1] = mt; ut[tid * 4 + 2] = nt; ut[tid * 4 + 3] = valid;
    }
    __syncthreads();
    {
        LAS float* bl = (LAS float*)(lds + BIAS_OFF);
        for (int idx = tid; idx < MAXU * 256; idx += NTHR) { const int i = idx >> 8, s = idx & 255; float v = 0.f;
            if (ut[i * 4 + 3]) { const int e = ut[i * 4 + 0], nt = ut[i * 4 + 2];
                v = (NTN == 8) ? bias[(size_t)e * 2048 + (s < 128 ? nt * 128 + s : 1024 + nt * 128 + s - 128)] : bias[(size_t)e * DM + nt * 256 + s]; }
            bl[idx] = v; }
        if (!ROWS) __syncthreads();
    }
    if (ROWS) {
        const int* rowtok = (const int*)(a->ws + WS_ROWTOK);
        for (int idx = tid; idx < MAXU * 256; idx += NTHR) { const int i = idx >> 8, r = idx & 255;
            int tok = 0;
            if (ut[i * 4 + 3]) { const int e = ut[i * 4 + 0], row = (ut[i * 4 + 1] - misc[16 + e]) * 256 + r; if (row < misc[64 + e]) tok = rowtok[(size_t)e * CAPROWS + row]; }
            tab[idx] = tok; }
        __syncthreads();
    }
}

__device__ __forceinline__ void phase_even_mix(CArgs a, LAS unsigned char* lds, int i2, int wv) {
    int tid = phase_tid(wv);
    const int lane = tid & 63, wave = __builtin_amdgcn_readfirstlane(tid >> 6), G = gridDim.x;
    const bf16* HB = (const bf16*)(a->ws + WS_HB); bf16* YB = (bf16*)(a->ws + WS_YB);
    LAS bf16* glu = (LAS bf16*)lds;
    LAS float* ybuf = (LAS float*)(lds + 65536);
    constexpr int PLS = 520;
    LAS bf16* pl = (LAS bf16*)(lds + 65536);
    const int c = tid;
    const float* cw = a->in[I_CONVW] + (size_t)i2 * 31 * 512;
    for (int chunk = blockIdx.x; chunk < NTOK / 32; chunk += G) {
        const int b = chunk >> 6, t0 = (chunk & 63) * 32; const size_t tokbase = (size_t)chunk * 32;
#pragma unroll
        for (int it = 0; it < 8; ++it) { const int item = it * NTHR + tid, tt = item >> 6, cg = item & 63, p = t0 - 32 + tt;
            u32x4 o = (u32x4){0u, 0u, 0u, 0u};
            if (p >= 0) { const bf16* hp = HB + ((size_t)b * SEQ + p) * EVEN_IN + cg * 8; const u32x4 ra = *(const u32x4*)(hp + 512), rg = *(const u32x4*)(hp + 1024);
                o.x = pk2(bflo(ra.x) * sigmoidf_(bflo(rg.x)), bfhi(ra.x) * sigmoidf_(bfhi(rg.x))); o.y = pk2(bflo(ra.y) * sigmoidf_(bflo(rg.y)), bfhi(ra.y) * sigmoidf_(bfhi(rg.y)));
                o.z = pk2(bflo(ra.z) * sigmoidf_(bflo(rg.z)), bfhi(ra.z) * sigmoidf_(bfhi(rg.z))); o.w = pk2(bflo(ra.w) * sigmoidf_(bflo(rg.w)), bfhi(ra.w) * sigmoidf_(bfhi(rg.w))); }
            *(LAS u32x4*)(glu + tt * 512 + cg * 8) = o; }
        __syncthreads();
        {
            float w[31];
#pragma unroll
            for (int k = 0; k < 31; ++k) { unsigned off = (unsigned)c * 4u; asm volatile("" : "+v"(off)); w[k] = *(const float*)((const char*)(cw + k * 512) + off); }
            const float cb = a->in[I_CONVB][i2 * 512 + c];
            float win[34];
#pragma clang loop unroll(full)
            for (int r = 0; r < 64; ++r) {
                win[r % 34] = bf2f(glu[r * 512 + c]);
                if (r >= 32) { float y = cb;
#pragma unroll
                    for (int k = 0; k < 31; ++k) y += w[k] * win[(r - 30 + k) % 34];
                    ybuf[(r - 32) * 512 + c] = y; }
            }
        }
        __syncthreads();
#pragma unroll
        for (int it = 0; it < 6; ++it) { const int item = it * NTHR + tid, tt = item >> 6, cg = item & 63, p = t0 - 16 + tt;
            u32x4 o = (u32x4){0u, 0u, 0u, 0u};
            if (p >= 0) o = *(const u32x4*)(HB + ((size_t)b * SEQ + p) * EVEN_IN + cg * 8);
            *(LAS u32x4*)(glu + tt * 512 + cg * 8) = o; }
        {
            const float* lg = a->in[I_CLNG] + i2 * 512 + lane * 8; const float* lb = a->in[I_CLNB] + i2 * 512 + lane * 8;
            const f32x4 g0 = *(const f32x4*)lg, g1 = *(const f32x4*)(lg + 4), b0 = *(const f32x4*)lb, b1 = *(const f32x4*)(lb + 4);
#pragma unroll
            for (int tt = 0; tt < 4; ++tt) { const int t = wave * 4 + tt;
                f32x4 v0 = *(const LAS f32x4*)(ybuf + t * 512 + lane * 8), v1 = *(const LAS f32x4*)(ybuf + t * 512 + lane * 8 + 4);
                const float mean = wave_sum((v0.x + v0.y) + (v0.z + v0.w) + (v1.x + v1.y) + (v1.z + v1.w), lane) * (1.f / 512.f);
                v0 = v0 - mean; v1 = v1 - mean;
                const float var = wave_sum((v0.x * v0.x + v0.y * v0.y) + (v0.z * v0.z + v0.w * v0.w) + (v1.x * v1.x + v1.y * v1.y) + (v1.z * v1.z + v1.w * v1.w), lane) * (1.f / 512.f);
                const float rstd = 1.0f / sqrtf(var + LN_EPS);
                float o[8];
#pragma unroll
                for (int j = 0; j < 4; ++j) { const float x0 = v0[j] * rstd * g0[j] + b0[j], x1 = v1[j] * rstd * g1[j] + b1[j]; o[j] = x0 * sigmoidf_(x0); o[4 + j] = x1 * sigmoidf_(x1); }
                u32x4 wv4; wv4.x = pk2(o[0], o[1]); wv4.y = pk2(o[2], o[3]); wv4.z = pk2(o[4], o[5]); wv4.w = pk2(o[6], o[7]);
                *(u32x4*)(YB + (tokbase + t) * DM + 512 + lane * 8) = wv4; }
        }
        __syncthreads();
        {
            const int g = wave >> 1, winw = 2 << g;
            float pprev = 0.f, a2r[3] = {0.f, 0.f, 0.f}, a4r[5] = {0.f, 0.f, 0.f, 0.f, 0.f}, a8r[9] = {0.f, 0.f, 0.f, 0.f, 0.f, 0.f, 0.f, 0.f, 0.f};
#pragma clang loop unroll(full)
            for (int r = 0; r < 48; ++r) {
                const float p = bf2f(glu[r * 512 + c]);
                const float a2 = p + pprev, a4 = a2 + a2r[(r + 1) % 3], a8 = a4 + a4r[(r + 1) % 5], a16 = a8 + a8r[(r + 1) % 9];
                a2r[r % 3] = a2; a4r[r % 5] = a4; a8r[r % 9] = a8; pprev = p;
                if (r >= 16) { const float s = g == 0 ? a2 : (g == 1 ? a4 : (g == 2 ? a8 : a16));
                    const int pos = t0 + r - 16; const float cnt = (float)((pos + 1) < winw ? (pos + 1) : winw);
                    pl[(r - 16) * PLS + c] = (bf16)f2bf(s / cnt - p); }
            }
        }
        __syncthreads();
        {
            const int g = wave >> 1, nh = wave & 1, fr = lane & 15, fq = lane >> 4;
            const bf16* wp = (const bf16*)(a->ws + WS_WPOOL) + ((size_t)i2 * 4 + g) * 128 * 128;
            f32x4 acc[2][4];
#pragma unroll
            for (int m = 0; m < 2; ++m)
#pragma unroll
                for (int n = 0; n < 4; ++n) acc[m][n] = (f32x4){0.f, 0.f, 0.f, 0.f};
#pragma unroll
            for (int ks = 0; ks < 4; ++ks) {
                bf16x8 af[2], bfr[4];
#pragma unroll
                for (int m = 0; m < 2; ++m) af[m] = *(const LAS bf16x8*)(pl + (m * 16 + fr) * PLS + g * 128 + ks * 32 + fq * 8);
#pragma unroll
                for (int n = 0; n < 4; ++n) bfr[n] = *(const bf16x8*)(wp + (size_t)(nh * 64 + n * 16 + fr) * 128 + ks * 32 + fq * 8);
#pragma unroll
                for (int m = 0; m < 2; ++m)
#pragma unroll
                    for (int n = 0; n < 4; ++n) acc[m][n] = __builtin_amdgcn_mfma_f32_16x16x32_bf16(bfr[n], af[m], acc[m][n], 0, 0, 0);
            }
#pragma unroll
            for (int n = 0; n < 4; ++n) { const int d = nh * 64 + n * 16 + 4 * fq;
                const f32x4 pb = *(const f32x4*)(a->in[I_POOLB] + ((size_t)i2 * 4 + g) * 128 + d), ps = *(const f32x4*)(a->in[I_POOLS] + (size_t)i2 * 512 + g * 128 + d);
#pragma unroll
                for (int m = 0; m < 2; ++m) { const f32x4 v = (acc[m][n] + pb) * ps; u32x2 wv2; wv2.x = pk2(v.x, v.y); wv2.y = pk2(v.z, v.w);
                    *(u32x2*)(YB + (tokbase + m * 16 + fr) * DM + g * 128 + d) = wv2; } }
        }
        __syncthreads();
    }
}

__device__ __forceinline__ void phase_sgu(CArgs a, LAS unsigned char* lds, int i2, int wv) {
    int tid = phase_tid(wv);
    const int G = gridDim.x;
    const bf16* HB = (const bf16*)(a->ws + WS_HB); unsigned char* YQ = a->ws + WS_YB;
    const float* stats = (const float*)(a->ws + WS_STATS);
    constexpr int VS = 136;
    LAS bf16* vt = (LAS bf16*)lds;
    LAS float* mu = (LAS float*)(lds + 256 * VS * 2), *rs = mu + 128;
    LAS unsigned char* wl = lds + 73728;
    const float* lg = a->in[I_SLNG] + (size_t)i2 * SGU_W; const float* lb = a->in[I_SLNB] + (size_t)i2 * SGU_W;
    for (int u = blockIdx.x; u < (NTOK / 128) * 2; u += G) {
        const int chunk = u >> 1, h0 = (u & 1) * 4; const size_t tok0 = (size_t)chunk * 128;
        int tz = tid; asm volatile("" : "+v"(tz));
        const int lane = tz & 63, wave = __builtin_amdgcn_readfirstlane(tz >> 6), wr = wave >> 2, wc = wave & 3, fr = lane & 15, fq = lane >> 4;
        if (tz < 128) { const float* sp = stats + (tok0 + tz) * 64; float s = 0.f, q = 0.f;
#pragma unroll
            for (int k = 0; k < 16; ++k) { const f32x4 v = *(const f32x4*)(sp + 4 * k); s += v.x + v.z; q += v.y + v.w; }
            const float m = s * (1.f / SGU_W), var = fmaxf(q * (1.f / SGU_W) - m * m, 0.f);
            mu[tz] = m; rs[tz] = 1.0f / sqrtf(var + LN_EPS); }
        u32x4 vraw[8];
#pragma unroll
        for (int it = 0; it < 8; ++it) { const int j = 32 * (it & 3) + (lane & 31), c8 = 2 * (8 * (it >> 2) + wave) + (lane >> 5);
            vraw[it] = *(const u32x4*)(HB + (tok0 + j) * (2 * SGU_W) + SGU_W + h0 * 256 + c8 * 8); }
        __syncthreads();
#pragma unroll 1
        for (int hh = 0; hh < 4; ++hh) {
            const int h = h0 + hh;
            const bf16* wm = (const bf16*)(a->ws + WS_WSGU) + ((size_t)i2 * 8 + h) * 128 * 128;
#pragma unroll
            for (int q = 0; q < 4; ++q) { const int r = 4 * (8 * q + wave) + (lane >> 4);
                __builtin_amdgcn_global_load_lds((const unsigned*)(wm + (size_t)r * 128 + 8 * ((lane & 15) ^ (r & 15))), (LAS unsigned*)(wl + (8 * q + wave) * 1024), 16, 0, 0); }
            {
                const int cA = 2 * wave + (lane >> 5);
                f32x4 gg[2][2], bb[2][2];
#pragma unroll
                for (int q = 0; q < 2; ++q) { const float* gp = lg + h * 256 + (cA + 16 * q) * 8; const float* bp = lb + h * 256 + (cA + 16 * q) * 8;
                    gg[q][0] = *(const f32x4*)gp; gg[q][1] = *(const f32x4*)(gp + 4); bb[q][0] = *(const f32x4*)bp; bb[q][1] = *(const f32x4*)(bp + 4); }
#pragma unroll
                for (int it = 0; it < 8; ++it) { const int j = 32 * (it & 3) + (lane & 31), q = it >> 2, c8 = cA + 16 * q;
                    const float m = mu[j], r = rs[j]; const u32x4 raw = vraw[it];
                    const float v[8] = {bflo(raw.x), bfhi(raw.x), bflo(raw.y), bfhi(raw.y), bflo(raw.z), bfhi(raw.z), bflo(raw.w), bfhi(raw.w)};
#pragma unroll
                    for (int k = 0; k < 8; k += 2) { const unsigned pr = pk2((v[k] - m) * r * gg[q][k >> 2][k & 3] + bb[q][k >> 2][k & 3], (v[k + 1] - m) * r * gg[q][k >> 2][(k + 1) & 3] + bb[q][k >> 2][(k + 1) & 3]);
                        vt[(c8 * 8 + k) * VS + j] = (bf16)(pr & 0xffffu); vt[(c8 * 8 + k + 1) * VS + j] = (bf16)(pr >> 16); } }
            }
            if (hh < 3) {
#pragma unroll
                for (int it = 0; it < 8; ++it) { const int j = 32 * (it & 3) + (lane & 31), c8 = 2 * (8 * (it >> 2) + wave) + (lane >> 5);
                    vraw[it] = *(const u32x4*)(HB + (tok0 + j) * (2 * SGU_W) + SGU_W + (h + 1) * 256 + c8 * 8); } }
            asm volatile("s_waitcnt vmcnt(0)" ::: "memory");
            __syncthreads();
            f32x4 acc[4][4];
#pragma unroll
            for (int m = 0; m < 4; ++m)
#pragma unroll
                for (int n = 0; n < 4; ++n) acc[m][n] = (f32x4){0.f, 0.f, 0.f, 0.f};
#pragma unroll
            for (int ks = 0; ks < 4; ++ks) {
                bf16x8 bfr[4], af[4];
#pragma unroll
                for (int m = 0; m < 4; ++m) { const int i = wr * 64 + m * 16 + fr; af[m] = *(const LAS bf16x8*)(wl + i * 256 + (((ks * 4 + fq) ^ (i & 15)) * 16)); }
#pragma unroll
                for (int n = 0; n < 4; ++n) bfr[n] = *(const LAS bf16x8*)(vt + (wc * 64 + n * 16 + fr) * VS + ks * 32 + fq * 8);
#pragma unroll
                for (int m = 0; m < 4; ++m)
#pragma unroll
                    for (int n = 0; n < 4; ++n) acc[m][n] = __builtin_amdgcn_mfma_f32_16x16x32_bf16(bfr[n], af[m], acc[m][n], 0, 0, 0);
            }
            { int te = tz; asm volatile("" : "+v"(te));
              const int le = te & 63, we = te >> 6, wr = we >> 2, wc = we & 3, fr = le & 15, fq = le >> 4;
#pragma unroll
            for (int m = 0; m < 4; ++m) { const int i = wr * 64 + m * 16 + fr; const float bs = a->in[I_SGUB][((size_t)i2 * 8 + h) * 128 + i];
#pragma unroll
                for (int n = 0; n < 4; ++n) { const int cc = h * 256 + wc * 64 + n * 16 + 4 * fq;
                    const f32x4 sv = acc[m][n] + bs; const u32x2 uv = *(const u32x2*)(HB + (tok0 + i) * (2 * SGU_W) + cc);
                    *(unsigned*)(YQ + (tok0 + i) * SGU_W + cc) = pk4_fp8(bflo(uv.x) * sv.x * QS_GATED, bfhi(uv.x) * sv.y * QS_GATED, bflo(uv.y) * sv.z * QS_GATED, bfhi(uv.y) * sv.w * QS_GATED); } } }
            __syncthreads();
        }
    }
}

__device__ __forceinline__ void phase_ln_route(CArgs a, LAS unsigned char* lds, int L, int wv) {
    int tid = phase_tid(wv);
    const int lane = tid & 63, wave = __builtin_amdgcn_readfirstlane(tid >> 6), G = gridDim.x;
    const int fr = lane & 15, fq = lane >> 4, tg = wave & 1, kq = wave >> 1;
    const bf16* Z = (const bf16*)(a->ws + WS_Z); bf16* X1B = (bf16*)(a->ws + WS_X1F); unsigned char* X1Q = a->ws + WS_X1B;
    LAS float* red = (LAS float*)lds;
    LAS float* plg = (LAS float*)(lds + 4096);
    LAS float* lgt = (LAS float*)(lds + 4096 + 16384);
    LAS int* hist = (LAS int*)(lds + MISC_OFF + 512);
    const bf16* RWH = (const bf16*)(a->ws + WS_RWH) + (size_t)L * NEXP * DM; const bf16* RWL = (const bf16*)(a->ws + WS_RWL) + (size_t)L * NEXP * DM;
    const float* lng = a->in[I_LNG] + ((size_t)L * 2 + 0) * DM; const float* lnb = a->in[I_LNB] + ((size_t)L * 2 + 0) * DM;
    unsigned* cntw = (unsigned*)(a->ws + WS_CTL) + CW_CNT + (size_t)L * NEXP * 64;
    int* rowtok = (int*)(a->ws + WS_ROWTOK); int* EP = (int*)(a->ws + WS_EP); float* GATE = (float*)(a->ws + WS_GATE);
    for (int sc = blockIdx.x; sc < NTOK / 64; sc += G) {
        if (tid < 32) hist[tid] = 0;
#pragma unroll 1
      for (int half = 0; half < 2; ++half) { const int chunk = 2 * sc + half;
        const int tokl = tg * 16 + fr; const size_t tok = (size_t)chunk * 32 + tokl; const int kb = kq * 256 + fq * 8;
        f32x4 v[8][2]; float s = 0.f;
#pragma unroll
        for (int ks = 0; ks < 8; ++ks) { const u32x4 zr = *(const u32x4*)(Z + tok * DM + kb + ks * 32);
            v[ks][0] = (f32x4){bflo(zr.x), bfhi(zr.x), bflo(zr.y), bfhi(zr.y)}; v[ks][1] = (f32x4){bflo(zr.z), bfhi(zr.z), bflo(zr.w), bfhi(zr.w)};
            s += ((v[ks][0].x + v[ks][0].y) + (v[ks][0].z + v[ks][0].w)) + ((v[ks][1].x + v[ks][1].y) + (v[ks][1].z + v[ks][1].w)); }
        s += shx(s, 16, lane); s += shx(s, 32, lane);
        if (fq == 0) red[kq * 32 + tokl] = s;
        __syncthreads();
        const float mean = ((red[tokl] + red[32 + tokl]) + (red[64 + tokl] + red[96 + tokl])) * (1.f / DM); float q = 0.f;
#pragma unroll
        for (int ks = 0; ks < 8; ++ks) { v[ks][0] = v[ks][0] - mean; v[ks][1] = v[ks][1] - mean;
            q += ((v[ks][0].x * v[ks][0].x + v[ks][0].y * v[ks][0].y) + (v[ks][0].z * v[ks][0].z + v[ks][0].w * v[ks][0].w)) + ((v[ks][1].x * v[ks][1].x + v[ks][1].y * v[ks][1].y) + (v[ks][1].z * v[ks][1].z + v[ks][1].w * v[ks][1].w)); }
        q += shx(q, 16, lane); q += shx(q, 32, lane);
        if (fq == 0) red[128 + kq * 32 + tokl] = q;
        __syncthreads();
        const float rstd = 1.0f / sqrtf(((red[128 + tokl] + red[160 + tokl]) + (red[192 + tokl] + red[224 + tokl])) * (1.f / DM) + LN_EPS);
        f32x4 acc[2] = {(f32x4){0.f, 0.f, 0.f, 0.f}, (f32x4){0.f, 0.f, 0.f, 0.f}};
        unsigned sq[8][4];
#pragma unroll
        for (int ks = 0; ks < 8; ++ks) { const int k = kb + ks * 32;
            const f32x4 g0 = *(const f32x4*)(lng + k), g1 = *(const f32x4*)(lng + k + 4), b0 = *(const f32x4*)(lnb + k), b1 = *(const f32x4*)(lnb + k + 4);
            const f32x4 x0 = v[ks][0] * rstd * g0 + b0, x1 = v[ks][1] * rstd * g1 + b1;
            u32x4 hi; hi.x = pk2(x0.x, x0.y); hi.y = pk2(x0.z, x0.w); hi.z = pk2(x1.x, x1.y); hi.w = pk2(x1.z, x1.w);
            *(u32x4*)(X1B + tok * DM + k) = hi;
            if (FP6_UP) { sq[ks][0] = pk2(x0.x * QS_X1, x0.y * QS_X1); sq[ks][1] = pk2(x0.z * QS_X1, x0.w * QS_X1); sq[ks][2] = pk2(x1.x * QS_X1, x1.y * QS_X1); sq[ks][3] = pk2(x1.z * QS_X1, x1.w * QS_X1); }
            else { u32x2 q8; q8.x = pk4_fp8(x0.x * QS_X1, x0.y * QS_X1, x0.z * QS_X1, x0.w * QS_X1); q8.y = pk4_fp8(x1.x * QS_X1, x1.y * QS_X1, x1.z * QS_X1, x1.w * QS_X1); *(u32x2*)(X1Q + tok * DM + k) = q8; }
            u32x4 lo; lo.x = pk2(x0.x - bflo(hi.x), x0.y - bfhi(hi.x)); lo.y = pk2(x0.z - bflo(hi.y), x0.w - bfhi(hi.y)); lo.z = pk2(x1.x - bflo(hi.z), x1.y - bfhi(hi.z)); lo.w = pk2(x1.z - bflo(hi.w), x1.w - bfhi(hi.w));
            const bf16x8 ah = __builtin_bit_cast(bf16x8, hi), al = __builtin_bit_cast(bf16x8, lo);
#pragma unroll
            for (int nn = 0; nn < 2; ++nn) { const bf16x8 bh = *(const bf16x8*)(RWH + (size_t)(nn * 16 + fr) * DM + k), bl = *(const bf16x8*)(RWL + (size_t)(nn * 16 + fr) * DM + k);
                acc[nn] = __builtin_amdgcn_mfma_f32_16x16x32_bf16(ah, bh, acc[nn], 0, 0, 0);
                acc[nn] = __builtin_amdgcn_mfma_f32_16x16x32_bf16(ah, bl, acc[nn], 0, 0, 0);
                acc[nn] = __builtin_amdgcn_mfma_f32_16x16x32_bf16(al, bh, acc[nn], 0, 0, 0); } }
        if (FP6_UP) {
#pragma unroll
            for (int s2 = 0; s2 < 2; ++s2) {
#pragma unroll
                for (int d = 0; d < 4; ++d) xpose4(sq[4 * s2 + 0][d], sq[4 * s2 + 1][d], sq[4 * s2 + 2][d], sq[4 * s2 + 3][d]);
                v16u w;
#pragma unroll
                for (int j = 0; j < 4; ++j)
#pragma unroll
                    for (int d = 0; d < 4; ++d) w[4 * j + d] = sq[4 * s2 + j][d];
                const v6u o = pack32_fp6(w);
                unsigned char* dq = X1Q + tok * DM + (kq * 2 + s2) * 128 + 16 * fq;
                *(u32x4*)dq = (u32x4){o[0], o[1], o[2], o[3]}; *(u32x4*)(dq + 64) = (u32x4){o[4], o[5], o[4], o[5]}; }
        }
#pragma unroll
        for (int nn = 0; nn < 2; ++nn)
#pragma unroll
            for (int j = 0; j < 4; ++j) plg[(kq * 32 + tg * 16 + 4 * fq + j) * 32 + nn * 16 + fr] = acc[nn][j];
        __syncthreads();
#pragma unroll
        for (int i = 0; i < 2; ++i) { const int idx = tid + NTHR * i, t = idx >> 5, e = idx & 31; lgt[(half * 32 + t) * 33 + e] = ((plg[idx] + plg[1024 + idx]) + (plg[2048 + idx] + plg[3072 + idx])) + a->in[I_RB][L * NEXP + e]; }
        __syncthreads();
      }
        int se[4] = {0, 0, 0, 0}, sp[4] = {0, 0, 0, 0}; float sg[4] = {0.f, 0.f, 0.f, 0.f};
        if (tid < 64) {
            float sv[4], lg[NEXP];
#pragma unroll
            for (int e = 0; e < NEXP; ++e) lg[e] = lgt[tid * 33 + e];
#pragma unroll
            for (int k = 0; k < 4; ++k) { float best = lg[0]; int bi = 0;
#pragma unroll
                for (int e = 1; e < NEXP; ++e) { const bool ok = lg[e] > best; best = ok ? lg[e] : best; bi = ok ? e : bi; }
#pragma unroll
                for (int e = 0; e < NEXP; ++e) lg[e] = (e == bi) ? -3.0e38f : lg[e];
                se[k] = bi; sv[k] = best; }
            float den = 0.f;
#pragma unroll
            for (int k = 0; k < 4; ++k) { sg[k] = __expf(sv[k] - sv[0]); den += sg[k]; }
#pragma unroll
            for (int k = 0; k < 4; ++k) { sg[k] = sg[k] / den; sp[k] = __hip_atomic_fetch_add(&hist[se[k]], 1, __ATOMIC_RELAXED, __HIP_MEMORY_SCOPE_WORKGROUP); }
        }
        __syncthreads();
        if (tid < 32) hist[32 + tid] = (int)__hip_atomic_fetch_add(cntw + tid * 64, (unsigned)hist[tid], __ATOMIC_RELAXED, __HIP_MEMORY_SCOPE_AGENT);
        __syncthreads();
        if (tid < 64) { const int tk = sc * 64 + tid;
#pragma unroll
            for (int k = 0; k < 4; ++k) { const int pos = hist[32 + se[k]] + sp[k]; rowtok[(size_t)se[k] * CAPROWS + pos] = tk; EP[tk * 4 + k] = (se[k] << 16) | pos; GATE[tk * 4 + k] = sg[k]; } }
        __syncthreads();
    }
}

__device__ __forceinline__ void phase_combine(CArgs a, LAS unsigned char* lds, int L, int wv) {
    int tid = phase_tid(wv);
    const int lane = tid & 63, wave = __builtin_amdgcn_readfirstlane(tid >> 6), G = gridDim.x;
    LAS int* misc = (LAS int*)(lds + MISC_OFF);
    const unsigned* cntw = (const unsigned*)(a->ws + WS_CTL) + CW_CNT + (size_t)L * NEXP * 64;
    __syncthreads();
#if !MK_SINGLE
    if (tid < NEXP) misc[64 + tid] = (int)__hip_atomic_load(cntw + tid * 64, __ATOMIC_RELAXED, __HIP_MEMORY_SCOPE_AGENT);
    __syncthreads();
    if (tid == 0) { int acc = 0; for (int e = 0; e < NEXP; ++e) { misc[16 + e] = acc; acc += (misc[64 + e] + 255) >> 8; } }
    __syncthreads();
#endif
    const bf16* X1B = (const bf16*)(a->ws + WS_X1F); const bf16* YS = (const bf16*)(a->ws + WS_YS);
    const int* EP = (const int*)(a->ws + WS_EP); const float* GATE = (const float*)(a->ws + WS_GATE);
    float* OUT = a->out; bf16* XB = (bf16*)(a->ws + WS_XB); unsigned char* XQ = a->ws + WS_XQ; float* SX = (float*)(a->ws + WS_SX); const bool last = (L == DEPTH - 1);
    const float* lng = a->in[I_LNG] + ((size_t)L * 2 + 1) * DM; const float* lnb = a->in[I_LNB] + ((size_t)L * 2 + 1) * DM;
    for (int tk = blockIdx.x * NWAVES + wave; tk < NTOK / 2; tk += G * NWAVES) {
        f32x4 v[2][2][2]; int4 ep4[2]; f32x4 g4[2];
#pragma unroll
        for (int h = 0; h < 2; ++h) { const int tok = tk + h * (NTOK / 2); ep4[h] = *(const int4*)(EP + tok * 4); g4[h] = *(const f32x4*)(GATE + tok * 4);
#pragma unroll
            for (int j = 0; j < 2; ++j) { const u32x4 xr = *(const u32x4*)(X1B + (size_t)tok * DM + lane * 8 + 512 * j);
                v[h][j][0] = DN_ALPHA * (f32x4){bflo(xr.x), bfhi(xr.x), bflo(xr.y), bfhi(xr.y)}; v[h][j][1] = DN_ALPHA * (f32x4){bflo(xr.z), bfhi(xr.z), bflo(xr.w), bfhi(xr.w)}; } }
#pragma unroll
        for (int k = 0; k < 4; ++k)
#pragma unroll
            for (int h = 0; h < 2; ++h) { const int ep = k == 0 ? ep4[h].x : k == 1 ? ep4[h].y : k == 2 ? ep4[h].z : ep4[h].w; const float g = g4[h][k];
                const size_t row = (size_t)misc[16 + (ep >> 16)] * 256 + (ep & 0xffff);
#pragma unroll
                for (int j = 0; j < 2; ++j) { const u32x4 y = *(const u32x4*)(YS + row * DM + lane * 8 + 512 * j);
                    v[h][j][0] += g * (f32x4){bflo(y.x), bfhi(y.x), bflo(y.y), bfhi(y.y)}; v[h][j][1] += g * (f32x4){bflo(y.z), bfhi(y.z), bflo(y.w), bfhi(y.w)}; } }
#pragma unroll
        for (int h = 0; h < 2; ++h) { const int tok = tk + h * (NTOK / 2);
            float s = 0.f;
#pragma unroll
            for (int j = 0; j < 2; ++j) s += ((v[h][j][0].x + v[h][j][0].y) + (v[h][j][0].z + v[h][j][0].w)) + ((v[h][j][1].x + v[h][j][1].y) + (v[h][j][1].z + v[h][j][1].w));
            const float mean = wave_sum(s, lane) * (1.f / DM); float s2 = 0.f;
#pragma unroll
            for (int j = 0; j < 2; ++j) { v[h][j][0] = v[h][j][0] - mean; v[h][j][1] = v[h][j][1] - mean;
                s2 += ((v[h][j][0].x * v[h][j][0].x + v[h][j][0].y * v[h][j][0].y) + (v[h][j][0].z * v[h][j][0].z + v[h][j][0].w * v[h][j][0].w)) + ((v[h][j][1].x * v[h][j][1].x + v[h][j][1].y * v[h][j][1].y) + (v[h][j][1].z * v[h][j][1].z + v[h][j][1].w * v[h][j][1].w)); }
            const float rstd = 1.0f / sqrtf(wave_sum(s2, lane) * (1.f / DM) + LN_EPS);
            float am = 0.f;
#pragma unroll
            for (int j = 0; j < 2; ++j) { const int c0 = lane * 8 + 512 * j;
                v[h][j][0] = v[h][j][0] * rstd * *(const f32x4*)(lng + c0) + *(const f32x4*)(lnb + c0); v[h][j][1] = v[h][j][1] * rstd * *(const f32x4*)(lng + c0 + 4) + *(const f32x4*)(lnb + c0 + 4);
                const f32x4 a0 = __builtin_elementwise_abs(v[h][j][0]), a1 = __builtin_elementwise_abs(v[h][j][1]); am = fmaxf(am, fmaxf(fmaxf(fmaxf(a0.x, a0.y), fmaxf(a0.z, a0.w)), fmaxf(fmaxf(a1.x, a1.y), fmaxf(a1.z, a1.w)))); }
            if (last) {
#pragma unroll
                for (int j = 0; j < 2; ++j) { const int c0 = lane * 8 + 512 * j; *(f32x4*)(OUT + (size_t)tok * DM + c0) = v[h][j][0]; *(f32x4*)(OUT + (size_t)tok * DM + c0 + 4) = v[h][j][1]; } }
            else {
                am = fmaxf(wave_max(am, lane), 1e-20f); const float inv = 127.f / am; if (lane == 0) SX[tok] = am * (1.f / 127.f);
#pragma unroll
                for (int j = 0; j < 2; ++j) { const int c0 = lane * 8 + 512 * j; const f32x4 x0 = v[h][j][0], x1 = v[h][j][1];
                    u32x4 w; w.x = pk2(x0.x, x0.y); w.y = pk2(x0.z, x0.w); w.z = pk2(x1.x, x1.y); w.w = pk2(x1.z, x1.w); *(u32x4*)(XB + (size_t)tok * DM + c0) = w;
                    u32x2 q; q.x = pk4_i8(x0.x, x0.y, x0.z, x0.w, inv); q.y = pk4_i8(x1.x, x1.y, x1.z, x1.w, inv); *(u32x2*)(XQ + (size_t)tok * DM + c0) = q; } } }
    }
}

constexpr int NPHASE = 2 + DEPTH * 7;
__global__ void __launch_bounds__(NTHR, 2) mk_fwd(Args a) {
    extern __shared__ __attribute__((aligned(16))) unsigned char smem[];
    LAS unsigned char* lds = (LAS unsigned char*)smem;
    const int tid = threadIdx.x, G = gridDim.x;
    const int wv = __builtin_amdgcn_readfirstlane(tid >> 6);
    for (int u = tid; u < MISC_BYTES / 4; u += NTHR) ((LAS unsigned*)(lds + MISC_OFF))[u] = 0u;
    __syncthreads();
#if MK_SINGLE
    (void)xcd_barrier_post((unsigned*)(a.ws + WS_CTL) + CW_BAR, (volatile LAS unsigned*)(lds + MISC_OFF), tid == 0);
#define GRID_BAR_T(FIRST) do { XcdBarrier bb; bb.bar = (unsigned*)(cargs()->ws + WS_CTL) + CW_BAR; bb.x = xb_xcc_id(); bb.st = (volatile LAS unsigned*)(lds + MISC_OFF); \
        xcd_barrier<FIRST>(bb, phase_tid(wv) == 0); } while (0)
#else
#define GRID_BAR_T(FIRST) do {} while (0)
#endif
    const int lo = a.ph_lo, hi = a.ph_hi;
#define IN(k) (lo <= (k) && (k) < hi)
#define SEAM(k) do { if (IN(k) && IN((k) + 1)) GRID_BAR_T(false); } while (0)
    if (PM(0) && IN(0)) { phase_convert(cargs(), lds, wv); }
    if (IN(0) && IN(1)) GRID_BAR_T(true);
    if (PM(0) && IN(1)) { phase_convert_b(cargs(), lds, wv); }
    SEAM(1);
    for (int Lc = 0; Lc < DEPTH; ++Lc) {
        int L = Lc; asm volatile("" : "+s"(L));
        int bid = blockIdx.x; asm volatile("" : "+s"(bid));
        const int pb = 2 + L * 7, i2 = L >> 1;
        if ((L & 1) == 0) {
            if (PM(1) && IN(pb + 0)) {
                CArgs ap = cargs(); unsigned char* ws = ap->ws;
                pg8::DenseSched<DM, 1> S{(const char*)(ws + WS_XQ), (const char*)(ws + WS_WEVIN) + (size_t)i2 * EVEN_IN * DM, NTOK / 256, EVEN_IN / 256, (NTOK / 256) * (EVEN_IN / 256), G, bid};
                EpiBiasBf16 E{(bf16*)(ws + WS_HB), EVEN_IN, ap->in[I_EVBIN] + (size_t)i2 * EVEN_IN, (const float*)(ws + WS_SX), (const float*)(ws + WS_SWEV) + (size_t)i2 * EVEN_IN};
                pg8::gemm_phase<DM, true, false, 2>(lds, S, E, (const LAS int*)(lds + TAB_OFF), wv);
            }
            SEAM(pb + 0);
            if (PM(2) && IN(pb + 1)) phase_even_mix(cargs(), lds, i2, wv);
            SEAM(pb + 1);
            if (PM(3) && IN(pb + 2)) {
                CArgs ap = cargs(); unsigned char* ws = ap->ws;
                pg8::DenseSched<DM> S{(const char*)(ws + WS_YB), (const char*)(ws + WS_WEVOUT) + (size_t)i2 * DM * DM * 2, NTOK / 256, DM / 256, (NTOK / 256) * (DM / 256), G, bid};
                EpiZ E{(bf16*)(ws + WS_Z), ap->in[I_EVBOUT] + (size_t)i2 * DM, (const bf16*)(ws + WS_XB), 1.f};
                pg8::gemm_phase<DM, true, false, 0>(lds, S, E, (const LAS int*)(lds + TAB_OFF), wv);
            }
            SEAM(pb + 2);
        } else {
            if (PM(4) && IN(pb + 0)) {
                CArgs ap = cargs(); unsigned char* ws = ap->ws;
                pg8::DenseSched<DM, 1> S{(const char*)(ws + WS_XQ), (const char*)(ws + WS_WODIN) + (size_t)i2 * 2 * SGU_W * DM, NTOK / 256, 2 * SGU_W / 256, (NTOK / 256) * (2 * SGU_W / 256), G, bid};
                EpiGeluStats E{(bf16*)(ws + WS_HB), ap->in[I_ODBIN] + (size_t)i2 * 2 * SGU_W, (float*)(ws + WS_STATS), (const float*)(ws + WS_SX), (const float*)(ws + WS_SWOD) + (size_t)i2 * 2 * SGU_W};
                pg8::gemm_phase<DM, true, false, 2>(lds, S, E, (const LAS int*)(lds + TAB_OFF), wv);
            }
            SEAM(pb + 0);
            if (PM(5) && IN(pb + 1)) phase_sgu(cargs(), lds, i2, wv);
            SEAM(pb + 1);
            if (PM(6) && IN(pb + 2)) {
                CArgs ap = cargs(); unsigned char* ws = ap->ws;
                pg8::DenseSched<SGU_W, 1> S{(const char*)(ws + WS_YB), (const char*)(ws + WS_WODOUT) + (size_t)i2 * DM * SGU_W, NTOK / 256, DM / 256, (NTOK / 256) * (DM / 256), G, bid};
                EpiZ E{(bf16*)(ws + WS_Z), ap->in[I_ODBOUT] + (size_t)i2 * DM, (const bf16*)(ws + WS_XB), 1.f / (QS_GATED * QS_WODOUT)};
                pg8::gemm_phase<SGU_W, true, false, 1>(lds, S, E, (const LAS int*)(lds + TAB_OFF), wv);
            }
            SEAM(pb + 2);
        }
        if (PM(7) && IN(pb + 3)) phase_ln_route(cargs(), lds, L, wv);
        SEAM(pb + 3);
        if (PM(8) && IN(pb + 4)) {
                CArgs ap = cargs(); unsigned char* ws = ap->ws;
            moe_tables<8, true>(ap, lds, L, wv, ap->in[I_BUP] + (size_t)L * NEXP * 2048);
            UpSched S{(const LAS int*)(lds + UT_OFF), (const char*)(ws + WS_X1B), (const char*)(ws + WS_WUP) + (size_t)L * NEXP * 2048 * DM};
            EpiUp E{ws + WS_HACT, (const LAS float*)(lds + BIAS_OFF)};
            pg8::gemm_phase<DM, true, true, FP6_UP ? 3 : 1>(lds, S, E, (const LAS int*)(lds + TAB_OFF), wv);
        }
        SEAM(pb + 4);
        if (PM(9) && IN(pb + 5)) {
                CArgs ap = cargs(); unsigned char* ws = ap->ws;
            moe_tables<4, false, true>(ap, lds, L, wv, ap->in[I_BDOWN] + (size_t)L * NEXP * DM);
            DownSched S{(const LAS int*)(lds + UT_OFF), (const char*)(ws + WS_HACT), (const char*)(ws + WS_WDOWN) + (size_t)L * NEXP * DM * DM};
            EpiDown E{(bf16*)(ws + WS_YS), (const LAS float*)(lds + BIAS_OFF)};
            pg8::gemm_phase<DM, true, false, 1>(lds, S, E, (const LAS int*)(lds + TAB_OFF), wv);
        }
        SEAM(pb + 5);
        if (PM(10) && IN(pb + 6)) phase_combine(cargs(), lds, L, wv);
        SEAM(pb + 6);
    }
#undef IN
#undef SEAM
}

extern "C" void kernel_launch(void* const* d_in, const int* in_sizes, int n_in, void* d_out, int out_size, void* d_ws, size_t ws_size, hipStream_t stream) {
    static int grid = 0;
    if (grid == 0) {
        if (n_in != 28 || in_sizes[0] != NTOK * DM || out_size != NTOK * DM || ws_size < WS_END) { fprintf(stderr, "kernel_launch: unexpected shapes (n_in %d, ws %zu)\n", n_in, ws_size); grid = -1; return; }
        int dev = 0, cus = 0, per_cu = 0;
        if (hipGetDevice(&dev) != hipSuccess || hipDeviceGetAttribute(&cus, hipDeviceAttributeMultiprocessorCount, dev) != hipSuccess) { grid = -1; return; }
        if (hipFuncSetAttribute((const void*)mk_fwd, hipFuncAttributeMaxDynamicSharedMemorySize, LDS_BYTES) != hipSuccess) { fprintf(stderr, "kernel_launch: hipFuncSetAttribute failed\n"); grid = -1; return; }
        if (hipOccupancyMaxActiveBlocksPerMultiprocessor(&per_cu, (const void*)mk_fwd, NTHR, LDS_BYTES) != hipSuccess || per_cu < 1) { fprintf(stderr, "kernel_launch: occupancy query reports %d\n", per_cu); }
        (void)hipGetLastError();
        grid = cus - (cus % 8);
    }
    if (grid < 0) return;
    (void)hipMemsetAsync((char*)d_ws + WS_CTL, 0, CTL_ZERO_BYTES, stream);
    Args a{};
    for (int i = 0; i < 28; ++i) a.in[i] = (const float*)d_in[i];
    a.out = (float*)d_out; a.ws = (unsigned char*)d_ws;
#if MK_SINGLE
    a.ph_lo = 0; a.ph_hi = NPHASE;
    hipLaunchKernelGGL(mk_fwd, dim3(grid), dim3(NTHR), LDS_BYTES, stream, a);
#else
    for (int p = 0; p < NPHASE; ++p) { a.ph_lo = p; a.ph_hi = p + 1;
        int type = 0; if (p == 1) type = 11; else if (p > 1) { const int k = (p - 2) % 7, Lh = (p - 2) / 7; type = k < 3 ? ((Lh & 1) ? 4 + k : 1 + k) : 4 + k; }
        const int reps = ((PROBE_DUP_MASK >> type) & 1) ? 2 : 1;
        for (int r = 0; r < reps; ++r) hipLaunchKernelGGL(mk_fwd, dim3(grid), dim3(NTHR), LDS_BYTES, stream, a); }
#endif
}
```

```cpp
#include <hip/hip_runtime.h>
#include <cstdio>
#include <cstdint>

#ifndef PH_MASK
#define PH_MASK 0x7ff
#endif
#define PM(b) ((PH_MASK >> (b)) & 1)
#ifndef PROBE_DUP_MASK
#define PROBE_DUP_MASK 0
#endif
#ifndef MK_SINGLE
#define MK_SINGLE 1
#endif

#define GAS __attribute__((address_space(1)))
#define LAS __attribute__((address_space(3)))
typedef unsigned short bf16;
typedef float f32x4 __attribute__((ext_vector_type(4)));
typedef float f32x2 __attribute__((ext_vector_type(2)));
typedef short bf16x8 __attribute__((ext_vector_type(8)));
typedef unsigned u32x4 __attribute__((ext_vector_type(4)));
typedef unsigned u32x2 __attribute__((ext_vector_type(2)));
typedef int v4i __attribute__((ext_vector_type(4)));
typedef int v8i __attribute__((ext_vector_type(8)));
typedef int v2i __attribute__((ext_vector_type(2)));
typedef unsigned v6u __attribute__((ext_vector_type(6)));
typedef unsigned v16u __attribute__((ext_vector_type(16)));
typedef __bf16 v32bf __attribute__((ext_vector_type(32)));

constexpr int NTOK = 16384, DM = 1024, SEQ = 2048, DEPTH = 4;
constexpr int EVEN_IN = 1536, SGU_W = 2048, NEXP = 32, TOPK = 4;
constexpr float DN_ALPHA = 1.681792830507429f;
constexpr float LN_EPS = 1e-5f;
#ifndef FP6_UP
#define FP6_UP 1
#endif
#define EMU_UP 0
#define EMU_DOWN 0
constexpr float QS_X1 = FP6_UP ? 1.75f : 8.f, QS_WUP = FP6_UP ? 60.f : 32.f, QS_ACT = EMU_DOWN ? 1.5f : 4.f, QS_WDOWN = EMU_DOWN ? 144.f : 64.f, QS_GATED = 8.f, QS_WODOUT = 64.f;
constexpr int NWAVES = 8, NTHR = 512;
constexpr int MAXU = 12;
constexpr int CAPROWS = 16384;
constexpr int HROWS = 65536 + 32 * 256;

constexpr size_t MiB = 1u << 20;
constexpr size_t WS_CTL = 0, CTL_ZERO_BYTES = 128 * 1024;
constexpr size_t WS_WEVIN = 1 * MiB, WS_WEVOUT = 7 * MiB, WS_WODIN = 11 * MiB, WS_WODOUT = 27 * MiB, WS_WPOOL = 35 * MiB, WS_WSGU = 36 * MiB, WS_RWH = 37 * MiB, WS_RWL = 38 * MiB;
constexpr size_t WS_WUP = 64 * MiB, WS_WDOWN = 576 * MiB;
constexpr size_t WS_XF = 832 * MiB, WS_XB = 896 * MiB, WS_HB = 928 * MiB, WS_YB = 1056 * MiB, WS_Z = 1120 * MiB, WS_X1F = 1184 * MiB, WS_X1B = 1248 * MiB;
constexpr size_t WS_XQ = WS_XF, WS_SX = WS_XF + 32 * MiB;
constexpr size_t WS_SWEV = WS_WEVIN + 4 * MiB, WS_SWOD = WS_WODIN + 12 * MiB;
constexpr size_t WS_STATS = 1280 * MiB, WS_EP = 1284 * MiB, WS_GATE = 1285 * MiB, WS_ROWTOK = 1286 * MiB, WS_HACT = 1288 * MiB, WS_YS = 1432 * MiB, WS_END = 1576 * MiB;
constexpr int CW_BAR = 4096;
constexpr int CW_CNT = 8192;
constexpr int CW_CMAX = CW_CNT + DEPTH * NEXP * 64;
constexpr int NCMAX = 2 * EVEN_IN + 2 * 2 * SGU_W;
constexpr int CW_UPC = 28672, UPC_STRIDE = 320;
static_assert(CW_UPC >= CW_CMAX + NCMAX && (CW_UPC + DEPTH * UPC_STRIDE) * 4 <= (int)CTL_ZERO_BYTES, "ctl upc");
static_assert((CW_CMAX + NCMAX) * 4 <= (int)CTL_ZERO_BYTES, "ctl");

constexpr int RING_BYTES = 131072;
constexpr int TAB_OFF = RING_BYTES, TAB_BYTES = MAXU * 256 * 4;
constexpr int UT_OFF = TAB_OFF + TAB_BYTES, UT_BYTES = MAXU * 16;
constexpr int BIAS_OFF = UT_OFF + 256, BIAS_BYTES = MAXU * 1024;
constexpr int MISC_OFF = BIAS_OFF + BIAS_BYTES, MISC_BYTES = 1024;
constexpr int LDS_BYTES = 157696;
static_assert(MISC_OFF + MISC_BYTES <= LDS_BYTES, "lds");

__device__ __forceinline__ unsigned f2bf(float f) { unsigned u = __builtin_bit_cast(unsigned, f); return (u + 0x7fffu + ((u >> 16) & 1u)) >> 16; }
__device__ __forceinline__ unsigned pk2(float lo, float hi) { unsigned r; asm("v_cvt_pk_bf16_f32 %0, %1, %2" : "=v"(r) : "v"(lo), "v"(hi)); return r; }
__device__ __forceinline__ float bflo(unsigned w) { return __builtin_bit_cast(float, w << 16); }
__device__ __forceinline__ float bfhi(unsigned w) { return __builtin_bit_cast(float, w & 0xffff0000u); }
__device__ __forceinline__ float bf2f(bf16 b) { return __builtin_bit_cast(float, (unsigned)b << 16); }
__device__ __forceinline__ float shx(float v, int m, int lane) { return __builtin_bit_cast(float, __builtin_amdgcn_ds_bpermute((lane ^ m) << 2, __builtin_bit_cast(int, v))); }
__device__ __forceinline__ float wave_sum(float v, int lane) {
#pragma unroll
    for (int o = 1; o < 64; o <<= 1) v += shx(v, o, lane);
    return v;
}
__device__ __forceinline__ float sigmoidf_(float x) { return __builtin_amdgcn_rcpf(1.0f + __builtin_amdgcn_exp2f(x * -1.44269504089f)); }
__device__ __forceinline__ int phase_tid(int wv) { unsigned z = 0u; asm volatile("" : "+v"(z));
    int t = (wv << 6) | (int)__builtin_amdgcn_mbcnt_hi(~0u, __builtin_amdgcn_mbcnt_lo(~0u, z)); asm volatile("" : "+v"(t)); return t; }
__device__ __forceinline__ float wave_max(float v, int lane) {
#pragma unroll
    for (int o = 1; o < 64; o <<= 1) v = fmaxf(v, shx(v, o, lane));
    return v;
}
__device__ __forceinline__ unsigned pk4_i8(float a, float b, float c, float d, float inv) {
    const int ia = (int)fminf(fmaxf(rintf(a * inv), -127.f), 127.f), ib = (int)fminf(fmaxf(rintf(b * inv), -127.f), 127.f);
    const int ic = (int)fminf(fmaxf(rintf(c * inv), -127.f), 127.f), id = (int)fminf(fmaxf(rintf(d * inv), -127.f), 127.f);
    return (unsigned)(ia & 0xff) | ((unsigned)(ib & 0xff) << 8) | ((unsigned)(ic & 0xff) << 16) | ((unsigned)id << 24);
}
#define LDS_WAIT() asm volatile("s_waitcnt lgkmcnt(0)" ::: "memory")

#define XB_TMO      128
#define XB_XCNT(j)  (256  + 64 * (j))
#define XB_XSUB(j)  (1280 + 64 * (j))
#define XB_XGEN(j)  (2304 + 64 * (j))
#define XB_TOP      3328
#define XB_TOPGEN   3392
#define XCD_BAR_WORDS 3456
#define XB_SPIN_CAP (1u << 18)
__device__ __forceinline__ unsigned xb_ld(unsigned* p)              { return __hip_atomic_load(p, __ATOMIC_RELAXED, __HIP_MEMORY_SCOPE_AGENT); }
__device__ __forceinline__ unsigned xb_add(unsigned* p, unsigned v) { return __hip_atomic_fetch_add(p, v, __ATOMIC_RELAXED, __HIP_MEMORY_SCOPE_AGENT); }
__device__ __forceinline__ unsigned xb_xcc_id() { return (unsigned)__builtin_amdgcn_s_getreg((3 << 11) | 20) & 0xFu; }
#define XB_SPIN(cond, bar) do { unsigned _sp = 0; while (cond) { __builtin_amdgcn_s_sleep(1); \
    if ((++_sp & 255u) == 0u) { if (xb_ld(&(bar)[XB_TMO])) break; if (_sp > XB_SPIN_CAP) { atomicAdd(&(bar)[XB_TMO], 1u); break; } } } } while (0)
struct XcdBarrier { unsigned* bar; unsigned x; volatile LAS unsigned* st; };
__device__ __forceinline__ XcdBarrier xcd_barrier_post(unsigned* bar, volatile LAS unsigned* st, bool t0) {
    XcdBarrier b; b.bar = bar; b.x = xb_xcc_id(); b.st = st;
    if (t0) (void)xb_add(&bar[XB_XCNT(b.x)], 1u);
    return b;
}
__device__ __forceinline__ void xcd_barrier_complete(unsigned* bar, unsigned x, unsigned& nloc, unsigned& nx) {
    const unsigned G = gridDim.x * gridDim.y * gridDim.z;
    unsigned sum, cnt, mine, sp = 0u;
    for (;;) {
        sum = 0u; cnt = 0u; mine = 0u;
#pragma unroll
        for (unsigned j = 0; j < 16; ++j) { const unsigned c = xb_ld(&bar[XB_XCNT(j)]); sum += c; cnt += (c > 0u) ? 1u : 0u; mine = (j == x) ? c : mine; }
        if (sum == G) break;
        __builtin_amdgcn_s_sleep(1);
        if ((++sp & 255u) == 0u) { if (xb_ld(&bar[XB_TMO])) break; if (sp > XB_SPIN_CAP) { atomicAdd(&bar[XB_TMO], 1u); break; } }
    }
    nloc = mine > 0u ? mine : 1u; nx = cnt > 0u ? cnt : 1u;
}
template <bool FIRST> __device__ __forceinline__ void xcd_barrier(const XcdBarrier& b, bool t0) {
    asm volatile("s_waitcnt vmcnt(0)" ::: "memory");
    __syncthreads();
    if (t0) {
        unsigned* bar = b.bar;
        __builtin_amdgcn_s_waitcnt(0);
        unsigned nloc = b.st[0], nx = b.st[1];
        if constexpr (FIRST) { if (nloc == 0u) { xcd_barrier_complete(bar, b.x, nloc, nx); b.st[0] = nloc; b.st[1] = nx; } }
        const unsigned old = xb_add(&bar[XB_XSUB(b.x)], 1u);
        const unsigned gen = old / nloc;
        if (old + 1u == (gen + 1u) * nloc) {
            __builtin_amdgcn_fence(__ATOMIC_RELEASE, "agent");
            asm volatile("s_waitcnt vmcnt(0)" ::: "memory");
            const unsigned og = xb_add(&bar[XB_TOP], 1u);
            const unsigned tg = og / nx;
            if (og + 1u == (tg + 1u) * nx) xb_add(&bar[XB_TOPGEN], 1u);
            else XB_SPIN(xb_ld(&bar[XB_TOPGEN]) == tg, bar);
            __builtin_amdgcn_fence(__ATOMIC_ACQUIRE, "agent");
            xb_add(&bar[XB_XGEN(b.x)], 1u);
            asm volatile("s_waitcnt vmcnt(0)" ::: "memory");
        } else {
            XB_SPIN(xb_ld(&bar[XB_XGEN(b.x)]) == gen, bar);
            __builtin_amdgcn_fence(__ATOMIC_ACQUIRE, "agent");
            asm volatile("s_waitcnt vmcnt(0)" ::: "memory");
        }
    }
    __syncthreads();
}

namespace pg8 {
constexpr int BM = 256, BK = 64, HALF = 128, HTB = HALF * BK * 2, NXCD = 8, WGM = 8;
__device__ __forceinline__ int lds_byte(int r, int c) { const int st = (r >> 4) * 2 + (c >> 5), rr = r & 15, cc = c & 31, ob = rr * 64 + cc * 2; return st * 1024 + (ob ^ (((ob >> 9) & 1) << 5)); }
__device__ __forceinline__ void stage_rc(int b, int& R, int& C) { const int st = b / 1024, sb = b % 1024, swz = sb ^ (((sb >> 9) & 1) << 5); R = (st >> 1) * 16 + swz / 64; C = (st & 1) * 32 + (swz % 64) / 2; }
__device__ __forceinline__ int perm32(int rho) { const int n = rho >> 4, i = rho & 15; return 8 * (i >> 2) + 4 * n + (i & 3); }

struct UnitD { const char* A; const char* B; int r0; int c0; int e; int ui; };

template <int K, bool PERM, bool GATHER, int MODE  , class Sched, class Epi>
__device__ __forceinline__ void gemm_phase(LAS unsigned char* lds, const Sched& S, const Epi& E, const LAS int* gtab, int wv) {
    int tid = phase_tid(wv);
    const int wid = __builtin_amdgcn_readfirstlane(tid >> 6), lane = tid & 63, wr = wid >> 2, wc = wid & 3, fr = lane & 15, fq = lane >> 4;
    constexpr bool F8 = (MODE != 0);
    constexpr int ES = F8 ? 1 : 2;
    constexpr int nt = K * ES / (BK * 2);
    constexpr size_t BH = Sched::BHALF;
    unsigned voffA[2], voffB[2]; unsigned aoffs[2][2];
#pragma unroll
    for (int i = 0; i < 2; ++i) { int R, C; stage_rc(tid * 16 + i * 8192, R, C); const int Rb = PERM ? ((R & ~31) + perm32(R & 31)) : R;
        voffA[i] = GATHER ? 0u : (unsigned)(R * K * ES + C * 2); voffB[i] = (unsigned)(Rb * K * ES + C * 2); aoffs[0][i] = 0u; aoffs[1][i] = 0u; }
    constexpr size_t kstep = (size_t)(BK * 2);
    constexpr size_t hstep = GATHER ? (size_t)0 : (size_t)HALF * K * ES;
    const unsigned ldsw = (unsigned)wid * 1024u;
    const int aoff = lds_byte(wr * 64 + fr, fq * 8), boff = lds_byte(wc * 32 + fr, fq * 8);
    const int hsel = (MODE == 3) ? 8 * ((fr >> 2) & 1) : 0;
#define PG8_SA(b, h) (((b) * 2 + (h)) * HTB)
#define PG8_SB(b, h) ((4 + (b) * 2 + (h)) * HTB)
#define PG8_STAGE_B(bufoff, gbase) do { _Pragma("unroll") for (int _i = 0; _i < 2; ++_i) { unsigned _o = voffB[_i]; asm volatile("" : "+v"(_o)); \
        __builtin_amdgcn_global_load_lds((const unsigned*)((const char*)(gbase) + _o), (LAS unsigned*)(lds + (bufoff) + ldsw + _i * 8192), 16, 0, 0); } } while (0)
#define PG8_STAGE_A(bufoff, gbase, h) do { _Pragma("unroll") for (int _i = 0; _i < 2; ++_i) { unsigned _o = (GATHER ? aoffs[h][_i] : voffA[_i]); asm volatile("" : "+v"(_o)); \
        __builtin_amdgcn_global_load_lds((const unsigned*)((const char*)(gbase) + _o), (LAS unsigned*)(lds + (bufoff) + ldsw + _i * 8192), 16, 0, 0); } } while (0)
#define PG8_GOFFS(u) do { if constexpr (GATHER) { _Pragma("unroll") for (int _i = 0; _i < 2; ++_i) { int _R, _C; stage_rc(tid * 16 + _i * 8192, _R, _C); \
        aoffs[0][_i] = (unsigned)gtab[(u) * 256 + _R] * (unsigned)(K * ES) + (unsigned)(_C * 2); aoffs[1][_i] = (unsigned)gtab[(u) * 256 + 128 + _R] * (unsigned)(K * ES) + (unsigned)(_C * 2); } } } while (0)
#define PG8_LDA(dst, b, h) do { _Pragma("unroll") for (int m = 0; m < 4; ++m) { if constexpr (MODE == 3) { const v4i _l = *(const LAS v4i*)(lds + PG8_SA(b, h) + aoff + m * 2048); const v2i _h = *(const volatile LAS v2i*)(lds + PG8_SA(b, h) + aoff + hsel + m * 2048 + 1024); \
            dst##8[m] = (v8i){_l.x, _l.y, _l.z, _l.w, _h.x, _h.y, 0, 0}; } \
        else if constexpr (F8) { dst##8[m].lo = *(const LAS v4i*)(lds + PG8_SA(b, h) + aoff + m * 2048); dst##8[m].hi = *(const LAS v4i*)(lds + PG8_SA(b, h) + aoff + m * 2048 + 1024); } \
        else { _Pragma("unroll") for (int k = 0; k < 2; ++k) dst[m][k] = *(const LAS bf16x8*)(lds + PG8_SA(b, h) + aoff + m * 2048 + k * 1024); } } } while (0)
#define PG8_LDB(dst, b, h) do { _Pragma("unroll") for (int n = 0; n < 2; ++n) { if constexpr (MODE == 3) { const v4i _l = *(const LAS v4i*)(lds + PG8_SB(b, h) + boff + n * 2048); const v2i _h = *(const volatile LAS v2i*)(lds + PG8_SB(b, h) + boff + hsel + n * 2048 + 1024); \
            dst##8[n] = (v8i){_l.x, _l.y, _l.z, _l.w, _h.x, _h.y, 0, 0}; } \
        else if constexpr (F8) { dst##8[n].lo = *(const LAS v4i*)(lds + PG8_SB(b, h) + boff + n * 2048); dst##8[n].hi = *(const LAS v4i*)(lds + PG8_SB(b, h) + boff + n * 2048 + 1024); } \
        else { _Pragma("unroll") for (int k = 0; k < 2; ++k) dst[n][k] = *(const LAS bf16x8*)(lds + PG8_SB(b, h) + boff + n * 2048 + k * 1024); } } } while (0)
#define PG8_MMA(ai, bj, At, Bt) do { __builtin_amdgcn_s_setprio(1); _Pragma("unroll") for (int m = 0; m < 4; ++m) _Pragma("unroll") for (int n = 0; n < 2; ++n) { \
        if constexpr (MODE == 1) acc[ai][bj][m][n] = __builtin_amdgcn_mfma_scale_f32_16x16x128_f8f6f4(Bt##8[n], At##8[m], acc[ai][bj][m][n], 0, 0, 0, 0, 0, 0); \
        else if constexpr (MODE == 3) acc[ai][bj][m][n] = __builtin_amdgcn_mfma_scale_f32_16x16x128_f8f6f4(Bt##8[n], At##8[m], acc[ai][bj][m][n], 2, 2, 0, 0, 0, 0); \
        else if constexpr (MODE == 2) { v4i _c = __builtin_bit_cast(v4i, acc[ai][bj][m][n]); _c = __builtin_amdgcn_mfma_i32_16x16x64_i8(Bt##8[n].lo, At##8[m].lo, _c, 0, 0, 0); \
            _c = __builtin_amdgcn_mfma_i32_16x16x64_i8(Bt##8[n].hi, At##8[m].hi, _c, 0, 0, 0); acc[ai][bj][m][n] = __builtin_bit_cast(f32x4, _c); } \
        else { _Pragma("unroll") for (int k = 0; k < 2; ++k) acc[ai][bj][m][n] = __builtin_amdgcn_mfma_f32_16x16x32_bf16(Bt[n][k], At[m][k], acc[ai][bj][m][n], 0, 0, 0); } } \
        __builtin_amdgcn_s_setprio(0); } while (0)
#define PG8_WAIT_V(n) asm volatile("s_waitcnt vmcnt(" #n ")" ::: "memory")
#define PG8_WAIT_L(n) asm volatile("s_waitcnt lgkmcnt(" #n ")" ::: "memory")
#define PG8_BAR __builtin_amdgcn_s_barrier()
#define PG8_SCHED __builtin_amdgcn_sched_barrier(0)
    UnitD cur, nxt; int ui = 0;
    if (!S.next(0, cur)) return;
    if constexpr (Sched::POLL) __syncthreads();
    int pmt = -1;
    f32x4 acc[2][2][4][2];
#pragma unroll
    for (int a = 0; a < 2; ++a)
#pragma unroll
        for (int b = 0; b < 2; ++b)
#pragma unroll
            for (int m = 0; m < 4; ++m)
#pragma unroll
                for (int n = 0; n < 2; ++n) acc[a][b][m][n] = (f32x4){0.f, 0.f, 0.f, 0.f};
    bf16x8 At[4][2], B0[2][2], B1[2][2]; v8i At8[4], B08[2], B18[2];
    const char* cA = cur.A; const char* cB = cur.B;
    PG8_GOFFS(0);
    PG8_STAGE_B(PG8_SB(0, 0), cB); PG8_STAGE_B(PG8_SB(0, 1), cB + BH); PG8_STAGE_A(PG8_SA(0, 0), cA, 0); PG8_STAGE_A(PG8_SA(0, 1), cA + hstep, 1);
    if (wr == 1) PG8_BAR;
    PG8_WAIT_V(2); PG8_BAR;
    PG8_STAGE_B(PG8_SB(1, 0), cB + kstep); PG8_STAGE_A(PG8_SA(1, 0), cA + kstep, 0); PG8_STAGE_B(PG8_SB(1, 1), cB + BH + kstep);
    PG8_WAIT_V(6); PG8_BAR;
    for (;;) {
        const bool has_next = S.next(ui + 1, nxt);
        const char* nA = has_next ? nxt.A : cA; const char* nB = has_next ? nxt.B : cB;
#pragma clang loop unroll(disable)
        for (int t = 0; t < nt; t += 2) {
            const bool last = (t == nt - 2);
            const char* a1 = cA + (size_t)(t + 1) * kstep;
            const char* a2 = last ? nA : cA + (size_t)(t + 2) * kstep;
            const char* b2 = last ? nB : cB + (size_t)(t + 2) * kstep;
            const char* a3 = a2 + kstep; const char* b3 = b2 + kstep;
            PG8_LDB(B0, 0, 0); PG8_LDB(B1, 0, 1); PG8_SCHED; PG8_LDA(At, 0, 0); PG8_STAGE_A(PG8_SA(1, 1), a1 + hstep, 1);
            PG8_WAIT_V(8); PG8_WAIT_L(0); PG8_BAR; PG8_MMA(0, 0, At, B0); PG8_MMA(0, 1, At, B1); PG8_BAR; PG8_SCHED;
            if (last && has_next) PG8_GOFFS(ui + 1);
            PG8_LDA(At, 0, 1); PG8_STAGE_B(PG8_SB(0, 0), b2); PG8_STAGE_B(PG8_SB(0, 1), b2 + BH); PG8_STAGE_A(PG8_SA(0, 0), a2, 0);
            PG8_WAIT_V(8); PG8_WAIT_L(0); PG8_BAR; PG8_MMA(1, 0, At, B0); PG8_MMA(1, 1, At, B1); PG8_BAR; PG8_SCHED;
            PG8_LDB(B0, 1, 0); PG8_LDB(B1, 1, 1); PG8_SCHED; PG8_LDA(At, 1, 0); PG8_STAGE_A(PG8_SA(0, 1), a2 + hstep, 1);
            PG8_WAIT_V(8); PG8_WAIT_L(0); PG8_BAR; PG8_MMA(0, 0, At, B0); PG8_MMA(0, 1, At, B1); PG8_BAR; PG8_SCHED;
            if constexpr (Epi::PUBLISH) {
                if (t == 0 && pmt >= 0) { int tp = tid; asm volatile("" : "+v"(tp)); if (tp == 0) E.publish(pmt); } }
            PG8_LDA(At, 1, 1); PG8_STAGE_B(PG8_SB(1, 0), b3); PG8_STAGE_B(PG8_SB(1, 1), b3 + BH); PG8_STAGE_A(PG8_SA(1, 0), a3, 0);
            PG8_WAIT_V(8); PG8_WAIT_L(0); PG8_BAR; PG8_MMA(1, 0, At, B0); PG8_MMA(1, 1, At, B1); PG8_BAR; PG8_SCHED;
        }
        if (wr == 0) PG8_BAR;
        { int tz = tid; asm volatile("" : "+v"(tz));
          const int wz = tz >> 6, lz = tz & 63; E(acc, cur, wz >> 2, wz & 3, lz & 15, lz >> 4); }
        if (!has_next) break;
#pragma unroll
        for (int a = 0; a < 2; ++a)
#pragma unroll
            for (int b = 0; b < 2; ++b)
#pragma unroll
                for (int m = 0; m < 4; ++m)
#pragma unroll
                    for (int n = 0; n < 2; ++n) acc[a][b][m][n] = (f32x4){0.f, 0.f, 0.f, 0.f};
        pmt = cur.r0 >> 8; cur = nxt; cA = nA; cB = nB; ++ui;
        if (wr == 1) PG8_BAR;
    }
    PG8_WAIT_V(0);
    PG8_BAR;
    if constexpr (Epi::PUBLISH) { int tp = tid; asm volatile("" : "+v"(tp)); if (tp == 0) E.publish(cur.r0 >> 8); }
#undef PG8_SA
#undef PG8_SB
#undef PG8_STAGE_A
#undef PG8_STAGE_B
#undef PG8_GOFFS
#undef PG8_LDA
#undef PG8_LDB
#undef PG8_MMA
#undef PG8_WAIT_V
#undef PG8_WAIT_L
#undef PG8_BAR
#undef PG8_SCHED
}

template <int K, int ES = 2> struct DenseSched {
    static constexpr size_t BHALF = (size_t)128 * K * ES, tstep = (size_t)256 * K * ES; static constexpr bool POLL = false;
    const char* A; const char* Bt; int nM, nN, nwg, G, c;
    __device__ __forceinline__ bool next(int i, UnitD& u) const {
        const long L = (long)i * G + c; if (L >= nwg) return false;
        int wgid = (int)L; { const int q = nwg / NXCD, r = nwg % NXCD, xcd = wgid % NXCD, off = wgid / NXCD; wgid = (xcd < r ? xcd * (q + 1) : r * (q + 1) + (xcd - r) * q) + off; }
        const int nig = WGM * nN, gid = wgid / nig, fm = gid * WGM, gsz = (nM - fm) < WGM ? (nM - fm) : WGM;
        const int pm = fm + ((wgid % nig) % gsz), pn = (wgid % nig) / gsz;
        u.A = A + (size_t)pm * tstep; u.B = Bt + (size_t)pn * tstep; u.r0 = pm * 256; u.c0 = pn * 256; u.e = 0; u.ui = i; return true;
    }
};
}

struct Args { const float* in[28]; float* out; unsigned char* ws; int ph_lo, ph_hi; };
typedef const __attribute__((address_space(4))) Args* CArgs;
__device__ __forceinline__ CArgs cargs() { CArgs p = (CArgs)__builtin_amdgcn_kernarg_segment_ptr(); asm volatile("" : "+s"(p)); return p; }
enum { I_X = 0, I_EVWIN, I_EVBIN, I_POOLW, I_POOLB, I_POOLS, I_CONVW, I_CONVB, I_CLNG, I_CLNB, I_EVWOUT, I_EVBOUT, I_ODWIN, I_ODBIN, I_SLNG, I_SLNB, I_SGUW, I_SGUB, I_ODWOUT, I_ODBOUT,
       I_RW, I_RB, I_WUP, I_BUP, I_WDOWN, I_BDOWN, I_LNG, I_LNB };

__device__ __forceinline__ void transpose_item(const float* W, int K, int N, bf16* WT, LAS float* scr, int item, int lane) {
    const int nblk = N / 32, kb = item / nblk, nb = item % nblk, k0 = 64 * kb, n0 = 32 * nb;
#pragma unroll 8
    for (int i = 0; i < 32; ++i) { const int kk = 2 * i + (lane >> 5); scr[kk * 33 + (lane & 31)] = W[(size_t)(k0 + kk) * N + n0 + (lane & 31)]; }
    LDS_WAIT(); asm volatile("" ::: "memory");
    const int c = lane & 7;
#pragma unroll
    for (int j = 0; j < 4; ++j) { const int n = (lane >> 3) + 8 * j; const LAS float* s = scr + (8 * c) * 33 + n;
        u32x4 o; o.x = pk2(s[0 * 33], s[1 * 33]); o.y = pk2(s[2 * 33], s[3 * 33]); o.z = pk2(s[4 * 33], s[5 * 33]); o.w = pk2(s[6 * 33], s[7 * 33]);
        *(u32x4*)(WT + (size_t)(n0 + n) * K + k0 + 8 * c) = o; }
    LDS_WAIT(); asm volatile("" ::: "memory");
}
__device__ __forceinline__ unsigned pk4_fp8(float a, float b, float c, float d) {
    a = fminf(fmaxf(a, -448.f), 448.f); b = fminf(fmaxf(b, -448.f), 448.f); c = fminf(fmaxf(c, -448.f), 448.f); d = fminf(fmaxf(d, -448.f), 448.f);
    int r = 0; r = __builtin_amdgcn_cvt_pk_fp8_f32(a, b, r, false); r = __builtin_amdgcn_cvt_pk_fp8_f32(c, d, r, true); return (unsigned)r;
}
template <bool EMU> __device__ __forceinline__ float e2m3q(float y) { if constexpr (EMU) { y = fminf(fmaxf(y, -7.5f), 7.5f); return fabsf(y) < 1.f ? rintf(y * 8.f) * 0.125f : y; } else return y; }
__device__ __forceinline__ void transpose_item8(const float* W, int K, int N, unsigned char* WT, LAS float* scr, int item, int lane, float qs) {
    const int nblk = N / 32, kb = item / nblk, nb = item % nblk, k0 = 64 * kb, n0 = 32 * nb;
#pragma unroll 8
    for (int i = 0; i < 32; ++i) { const int kk = 2 * i + (lane >> 5); scr[kk * 33 + (lane & 31)] = W[(size_t)(k0 + kk) * N + n0 + (lane & 31)] * qs; }
    LDS_WAIT(); asm volatile("" ::: "memory");
    const int c = lane & 7;
#pragma unroll
    for (int j = 0; j < 4; ++j) { const int n = (lane >> 3) + 8 * j; const LAS float* s = scr + (8 * c) * 33 + n;
        u32x2 o; o.x = pk4_fp8(s[0 * 33], s[1 * 33], s[2 * 33], s[3 * 33]); o.y = pk4_fp8(s[4 * 33], s[5 * 33], s[6 * 33], s[7 * 33]);
        *(u32x2*)(WT + (size_t)(n0 + n) * K + k0 + 8 * c) = o; }
    LDS_WAIT(); asm volatile("" ::: "memory");
}
__device__ __forceinline__ void conv_group8(const float* W, int K, int N, int nmat, unsigned char* WT, LAS float* scr, int gw, int NGW, int lane, float qs) {
    const int per = (K / 64) * (N / 32); const long total = (long)per * nmat;
    for (long it = gw; it < total; it += NGW) { const int mi = (int)(it / per), r = (int)(it % per);
        transpose_item8(W + (size_t)mi * K * N, K, N, WT + (size_t)mi * K * N, scr, r, lane, qs); }
}
__device__ __forceinline__ void conv_issue(const float* W, int K, int N, long it, long per, int nblk, LAS unsigned char* tile, int lane) {
    const int mi = (int)(it / per), r = (int)(it % per), nb = r % nblk, kb = r / nblk, k0 = kb * 128, n0 = nb * 32;
    const float* src = W + (size_t)mi * K * N + (size_t)(k0 + (lane >> 3)) * N + n0;
#pragma unroll
    for (int j = 0; j < 16; ++j)
        __builtin_amdgcn_global_load_lds((const unsigned*)(src + (size_t)(8 * j) * N + 4 * ((lane & 7) ^ (j >> 1))), (LAS unsigned*)(tile + j * 1024), 16, 0, 2);
}
template <bool EMU = false> __device__ __forceinline__ void conv_dma8(const float* W, int K, int N, int nmat, unsigned char* WT, LAS unsigned char* tile, int gw, int NGW, int lane, float qs) {
    const int nblk = N / 32; const long per = (long)(K / 128) * nblk, total = per * nmat;
    long it = gw;
    if (it < total) conv_issue(W, K, N, it, per, nblk, tile, lane);
    const int c = lane & 7, nn = lane >> 3;
#pragma unroll 1
    for (; it < total; it += NGW) {
        if (it == gw) asm volatile("s_waitcnt vmcnt(0)" ::: "memory");
        else asm volatile("s_waitcnt vmcnt(4)" ::: "memory");
        const int mi = (int)(it / per), r = (int)(it % per), nb = r % nblk, kb = r / nblk, k0 = kb * 128, n0 = nb * 32;
        float v[4][16];
#pragma unroll
        for (int jj = 0; jj < 4; ++jj) { const int n = nn + 8 * jj;
#pragma unroll
            for (int i = 0; i < 16; ++i) v[jj][i] = *(const LAS float*)(tile + (16 * c + i) * 128 + (((n >> 2) ^ c) * 16) + (n & 3) * 4); }
        asm volatile("s_waitcnt lgkmcnt(0)" ::: "memory");
        const long nx = it + NGW;
        if (nx < total) conv_issue(W, K, N, nx, per, nblk, tile, lane);
        unsigned char* dst = WT + (size_t)mi * K * N + (size_t)n0 * K + k0 + 16 * c;
#pragma unroll
        for (int jj = 0; jj < 4; ++jj) { const int n = nn + 8 * jj; u32x4 o;
#define QE(x) e2m3q<EMU>((x) * qs)
            o.x = pk4_fp8(QE(v[jj][0]), QE(v[jj][1]), QE(v[jj][2]), QE(v[jj][3])); o.y = pk4_fp8(QE(v[jj][4]), QE(v[jj][5]), QE(v[jj][6]), QE(v[jj][7]));
            o.z = pk4_fp8(QE(v[jj][8]), QE(v[jj][9]), QE(v[jj][10]), QE(v[jj][11])); o.w = pk4_fp8(QE(v[jj][12]), QE(v[jj][13]), QE(v[jj][14]), QE(v[jj][15]));
#undef QE
            __builtin_nontemporal_store(o, (u32x4*)(dst + (size_t)n * K)); }
        if (nx >= total) asm volatile("s_waitcnt vmcnt(0)" ::: "memory");
    }
}
__device__ __forceinline__ v6u pack32_fp6(const v16u w) { return __builtin_amdgcn_cvt_scalef32_pk32_fp6_bf16(__builtin_bit_cast(v32bf, w), 1.0f); }
__device__ __forceinline__ void xpose4(unsigned& r0, unsigned& r1, unsigned& r2, unsigned& r3) {
    u32x2 t;
    t = __builtin_amdgcn_permlane16_swap(r0, r1, false, false); r0 = t.x; r1 = t.y;
    t = __builtin_amdgcn_permlane16_swap(r2, r3, false, false); r2 = t.x; r3 = t.y;
    t = __builtin_amdgcn_permlane32_swap(r0, r2, false, false); r0 = t.x; r2 = t.y;
    t = __builtin_amdgcn_permlane32_swap(r1, r3, false, false); r1 = t.x; r3 = t.y;
}
__device__ __forceinline__ void conv_issue6(const float* W, int K, int N, long it, long per, int nblk, LAS unsigned char* tile, int lane) {
    const int mi = (int)(it / per), r = (int)(it % per), nb = r % nblk, kb = r / nblk, k0 = kb * 128, n0 = nb * 32;
    const float* src = W + (size_t)mi * K * N + (size_t)k0 * N + n0;
#pragma unroll
    for (int j = 0; j < 16; ++j)
        __builtin_amdgcn_global_load_lds((const unsigned*)(src + (size_t)(8 * j + ((lane >> 3) ^ (j >> 3))) * N + 4 * ((lane & 7) ^ (4 * ((j >> 2) & 1)))), (LAS unsigned*)(tile + j * 1024), 16, 0, 2);
}
__device__ __forceinline__ void conv_dma6(const float* W, int K, int N, int nmat, unsigned char* WT, LAS unsigned char* tile, int gw, int NGW, int lane, float qs) {
    const int nblk = N / 32; const long per = (long)(K / 128) * nblk, total = per * nmat;
    long it = gw;
    if (it < total) conv_issue6(W, K, N, it, per, nblk, tile, lane);
    const int c = lane & 3, nn = lane >> 2;
#pragma unroll 1
    for (; it < total; it += NGW) {
        if (it == gw) asm volatile("s_waitcnt vmcnt(0)" ::: "memory");
        else asm volatile("s_waitcnt vmcnt(4)" ::: "memory");
        const int mi = (int)(it / per), r = (int)(it % per), nb = r % nblk, kb = r / nblk, k0 = kb * 128, n0 = nb * 32;
        float v[2][32];
#pragma unroll
        for (int jj = 0; jj < 2; ++jj) { const int n = nn + 16 * jj;
#pragma unroll
            for (int i = 0; i < 32; ++i) v[jj][i] = *(const LAS float*)(tile + ((32 * c + i) ^ (c >> 1)) * 128 + (((n >> 2) ^ (4 * (c & 1))) * 16) + (n & 3) * 4); }
        asm volatile("s_waitcnt lgkmcnt(0)" ::: "memory");
        const long nx = it + NGW;
        if (nx < total) conv_issue6(W, K, N, nx, per, nblk, tile, lane);
        unsigned char* dst = WT + (size_t)mi * K * N + (size_t)n0 * K + k0 + 16 * c;
#pragma unroll
        for (int jj = 0; jj < 2; ++jj) { const int n = nn + 16 * jj; v16u w;
#pragma unroll
            for (int p = 0; p < 16; ++p) w[p] = pk2(v[jj][2 * p] * qs, v[jj][2 * p + 1] * qs);
            const v6u o = pack32_fp6(w);
            __builtin_nontemporal_store((u32x4){o[0], o[1], o[2], o[3]}, (u32x4*)(dst + (size_t)n * K));
            __builtin_nontemporal_store((u32x4){o[4], o[5], o[4], o[5]}, (u32x4*)(dst + (size_t)n * K + 64)); }
        if (nx >= total) asm volatile("s_waitcnt vmcnt(0)" ::: "memory");
    }
}
__device__ __forceinline__ void conv_group(const float* W, int K, int N, int nmat, bf16* WT, LAS float* scr, int gw, int NGW, int lane) {
    const int per = (K / 64) * (N / 32); const long total = (long)per * nmat;
    for (long it = gw; it < total; it += NGW) { const int mi = (int)(it / per), r = (int)(it % per);
        transpose_item(W + (size_t)mi * K * N, K, N, WT + (size_t)mi * K * N, scr, r, lane); }
}
__device__ __forceinline__ void phase_convert(CArgs a, LAS unsigned char* lds, int wv) {
    int tid = phase_tid(wv);
    const int lane = tid & 63, wave = __builtin_amdgcn_readfirstlane(tid >> 6), G = gridDim.x;
    LAS float* scr = (LAS float*)(lds + wave * 16384);
    const int gw = blockIdx.x * NWAVES + wave, NGW = G * NWAVES;
    unsigned char* ws = a->ws;
    conv_group(a->in[I_EVWOUT], DM, DM, 2, (bf16*)(ws + WS_WEVOUT), scr, gw, NGW, lane);
    conv_dma8(a->in[I_ODWOUT], SGU_W, DM, 2, ws + WS_WODOUT, lds + wave * 16384, gw, NGW, lane, QS_WODOUT);
    conv_group(a->in[I_POOLW], 128, 128, 8, (bf16*)(ws + WS_WPOOL), scr, gw, NGW, lane);
    if (FP6_UP) conv_dma6(a->in[I_WUP], DM, 2 * DM, DEPTH * NEXP, ws + WS_WUP, lds + wave * 16384, gw, NGW, lane, QS_WUP);
    else conv_dma8(a->in[I_WUP], DM, 2 * DM, DEPTH * NEXP, ws + WS_WUP, lds + wave * 16384, gw, NGW, lane, QS_WUP);
    conv_dma8<EMU_DOWN != 0>(a->in[I_WDOWN], DM, DM, DEPTH * NEXP, ws + WS_WDOWN, lds + wave * 16384, gw, NGW, lane, QS_WDOWN);
    const long gt = (long)blockIdx.x * NTHR + tid, GT = (long)G * NTHR;
    { bf16* rh = (bf16*)(ws + WS_RWH); bf16* rl = (bf16*)(ws + WS_RWL); const float* rw = a->in[I_RW];
      for (long i = gt; i < (long)DEPTH * DM * NEXP; i += GT) { const int L = (int)(i / (DM * NEXP)), r = (int)(i % (DM * NEXP)), e = r / DM, k = r % DM;
          const float w = rw[(size_t)L * DM * NEXP + (size_t)k * NEXP + e]; const unsigned h = f2bf(w); rh[i] = (bf16)h; rl[i] = (bf16)f2bf(w - bflo(h)); } }
    { bf16* o = (bf16*)(ws + WS_WSGU); const float* w = a->in[I_SGUW];
      for (long i = gt; i < 2L * 8 * 128 * 128; i += GT) { const int ii = (int)((i >> 7) & 127), jj = (int)(i & 127); const float v = ((ii >> 6) >= (jj >> 6)) ? w[i] : 0.f; o[i] = (bf16)f2bf(v); } }
    { const float* x = a->in[I_X]; bf16* XB = (bf16*)(ws + WS_XB); unsigned char* XQ = ws + WS_XQ; float* SX = (float*)(ws + WS_SX);
      for (int tok = gw; tok < NTOK; tok += NGW) { f32x4 v[2][2]; float am = 0.f;
#pragma unroll
          for (int j = 0; j < 2; ++j) { v[j][0] = *(const f32x4*)(x + (size_t)tok * DM + lane * 8 + 512 * j); v[j][1] = *(const f32x4*)(x + (size_t)tok * DM + lane * 8 + 512 * j + 4);
              const f32x4 a0 = __builtin_elementwise_abs(v[j][0]), a1 = __builtin_elementwise_abs(v[j][1]); am = fmaxf(am, fmaxf(fmaxf(fmaxf(a0.x, a0.y), fmaxf(a0.z, a0.w)), fmaxf(fmaxf(a1.x, a1.y), fmaxf(a1.z, a1.w)))); }
          am = fmaxf(wave_max(am, lane), 1e-20f); const float inv = 127.f / am; if (lane == 0) SX[tok] = am * (1.f / 127.f);
#pragma unroll
          for (int j = 0; j < 2; ++j) { const int c0 = lane * 8 + 512 * j;
              u32x4 w; w.x = pk2(v[j][0].x, v[j][0].y); w.y = pk2(v[j][0].z, v[j][0].w); w.z = pk2(v[j][1].x, v[j][1].y); w.w = pk2(v[j][1].z, v[j][1].w); *(u32x4*)(XB + (size_t)tok * DM + c0) = w;
              u32x2 q; q.x = pk4_i8(v[j][0].x, v[j][0].y, v[j][0].z, v[j][0].w, inv); q.y = pk4_i8(v[j][1].x, v[j][1].y, v[j][1].z, v[j][1].w, inv); *(u32x2*)(XQ + (size_t)tok * DM + c0) = q; } } }
    { unsigned* cmax = (unsigned*)(ws + WS_CTL) + CW_CMAX;
      constexpr int IT_EV = 2 * 8 * (EVEN_IN / 64), IT_OD = 2 * 8 * (2 * SGU_W / 64);
      for (int it = gw; it < IT_EV + IT_OD; it += NGW) { const bool od = it >= IT_EV; const int r = od ? it - IT_EV : it, N = od ? 2 * SGU_W : EVEN_IN, nblk = N / 64;
          const int mat = r / (8 * nblk), r2 = r % (8 * nblk), kc = r2 / nblk, nb = r2 % nblk, n = nb * 64 + lane;
          const float* W = (od ? a->in[I_ODWIN] : a->in[I_EVWIN]) + (size_t)mat * DM * N + (size_t)(kc * 128) * N + n; float m = 0.f;
#pragma unroll 16
          for (int i = 0; i < 128; ++i) m = fmaxf(m, fabsf(W[(size_t)i * N]));
          __hip_atomic_fetch_max(cmax + (od ? 2 * EVEN_IN : 0) + mat * N + n, __builtin_bit_cast(unsigned, m), __ATOMIC_RELAXED, __HIP_MEMORY_SCOPE_AGENT); } }
}
__device__ __forceinline__ void transpose_item_i8(const float* W, int K, int N, unsigned char* WT, const unsigned* cmax, float* sw, LAS float* scr, int item, int lane) {
    const int nblk = N / 32, kb = item / nblk, nb = item % nblk, k0 = 64 * kb, n0 = 32 * nb;
#pragma unroll 8
    for (int i = 0; i < 32; ++i) { const int kk = 2 * i + (lane >> 5); scr[kk * 33 + (lane & 31)] = W[(size_t)(k0 + kk) * N + n0 + (lane & 31)]; }
    LDS_WAIT(); asm volatile("" ::: "memory");
    const int c = lane & 7;
#pragma unroll
    for (int j = 0; j < 4; ++j) { const int n = (lane >> 3) + 8 * j; const LAS float* s = scr + (8 * c) * 33 + n;
        const float am = fmaxf(__builtin_bit_cast(float, cmax[n0 + n]), 1e-20f), inv = 127.f / am;
        u32x2 o; o.x = pk4_i8(s[0 * 33], s[1 * 33], s[2 * 33], s[3 * 33], inv); o.y = pk4_i8(s[4 * 33], s[5 * 33], s[6 * 33], s[7 * 33], inv);
        *(u32x2*)(WT + (size_t)(n0 + n) * K + k0 + 8 * c) = o;
        if (k0 == 0 && c == 0) sw[n0 + n] = am * (1.f / 127.f); }
    LDS_WAIT(); asm volatile("" ::: "memory");
}
__device__ __forceinline__ void phase_convert_b(CArgs a, LAS unsigned char* lds, int wv) {
    const int tid = phase_tid(wv), lane = tid & 63, wave = __builtin_amdgcn_readfirstlane(tid >> 6), G = gridDim.x;
    LAS float* scr = (LAS float*)(lds + wave * 16384);
    const int gw = blockIdx.x * NWAVES + wave, NGW = G * NWAVES;
    unsigned char* ws = a->ws; const unsigned* cmax = (const unsigned*)(ws + WS_CTL) + CW_CMAX;
    constexpr int PER_EV = (DM / 64) * (EVEN_IN / 32), PER_OD = (DM / 64) * (2 * SGU_W / 32);
    for (int it = gw; it < 2 * PER_EV + 2 * PER_OD; it += NGW) {
        if (it < 2 * PER_EV) { const int mat = it / PER_EV, r = it % PER_EV;
            transpose_item_i8(a->in[I_EVWIN] + (size_t)mat * DM * EVEN_IN, DM, EVEN_IN, ws + WS_WEVIN + (size_t)mat * DM * EVEN_IN, cmax + mat * EVEN_IN, (float*)(ws + WS_SWEV) + mat * EVEN_IN, scr, r, lane); }
        else { const int it2 = it - 2 * PER_EV, mat = it2 / PER_OD, r = it2 % PER_OD;
            transpose_item_i8(a->in[I_ODWIN] + (size_t)mat * DM * 2 * SGU_W, DM, 2 * SGU_W, ws + WS_WODIN + (size_t)mat * DM * 2 * SGU_W, cmax + 2 * EVEN_IN + mat * 2 * SGU_W, (float*)(ws + WS_SWOD) + mat * 2 * SGU_W, scr, r, lane); }
    }
}

using pg8::UnitD;
struct EpiBiasBf16 {
    static constexpr bool PUBLISH = false;
    bf16* O; int ldc; const float* bias; const float* sx; const float* sw;
    __device__ __forceinline__ void operator()(const f32x4 (&acc)[2][2][4][2], const UnitD& u, int wr, int wc, int fr, int fq) const {
        const int row0 = u.r0 + wr * 64 + fr, col0 = u.c0 + wc * 32 + 8 * fq;
#pragma unroll
        for (int bj = 0; bj < 2; ++bj) { const f32x4 bv0 = *(const f32x4*)(bias + col0 + bj * 128), bv1 = *(const f32x4*)(bias + col0 + bj * 128 + 4);
            const f32x4 sw0 = *(const f32x4*)(sw + col0 + bj * 128), sw1 = *(const f32x4*)(sw + col0 + bj * 128 + 4);
#pragma unroll
            for (int ai = 0; ai < 2; ++ai)
#pragma unroll
                for (int m = 0; m < 4; ++m) { const int row = row0 + ai * 128 + m * 16; const float s = sx[row];
                    const v4i i0 = __builtin_bit_cast(v4i, acc[ai][bj][m][0]), i1 = __builtin_bit_cast(v4i, acc[ai][bj][m][1]);
                    const f32x4 v0 = __builtin_convertvector(i0, f32x4) * (sw0 * s) + bv0, v1 = __builtin_convertvector(i1, f32x4) * (sw1 * s) + bv1;
                    u32x4 w; w.x = pk2(v0[0], v0[1]); w.y = pk2(v0[2], v0[3]); w.z = pk2(v1[0], v1[1]); w.w = pk2(v1[2], v1[3]);
                    *(u32x4*)(O + (size_t)row * ldc + col0 + bj * 128) = w; } }
    }
};
__device__ __forceinline__ f32x2 gelu_pk(f32x2 v) {
    f32x2 vc; vc.x = __builtin_amdgcn_fmed3f(v.x, -4.25f, 4.25f); vc.y = __builtin_amdgcn_fmed3f(v.y, -4.25f, 4.25f);
    const f32x2 s = vc * vc;
    f32x2 q = s * (-2.562045892e-12f) + 2.732375520e-10f;
    q = q * s + (-1.309781371e-08f); q = q * s + 3.770278565e-07f; q = q * s + (-7.377925681e-06f); q = q * s + 1.056265650e-04f;
    q = q * s + (-1.158376687e-03f); q = q * s + 9.925602724e-03f; q = q * s + (-6.645352160e-02f); q = q * s + 3.989338899e-01f;
    return v * (vc * q + 0.5f);
}
struct EpiGeluStats {
    static constexpr bool PUBLISH = false;
    bf16* O; const float* bias; float* stats; const float* sx; const float* sw;
    __device__ __forceinline__ void operator()(const f32x4 (&acc)[2][2][4][2], const UnitD& u, int wr, int wc, int fr, int fq) const {
        const int row0 = u.r0 + wr * 64 + fr, col0 = u.c0 + wc * 32 + 8 * fq;
        const bool isv = u.c0 >= SGU_W; const int slot = ((u.c0 - SGU_W) >> 8) * 4 + wc;
        f32x4 bv[2][2], sv[2][2];
#pragma unroll
        for (int bj = 0; bj < 2; ++bj)
#pragma unroll
            for (int n = 0; n < 2; ++n) { bv[bj][n] = *(const f32x4*)(bias + col0 + bj * 128 + 4 * n); sv[bj][n] = *(const f32x4*)(sw + col0 + bj * 128 + 4 * n); }
#pragma unroll
        for (int ai = 0; ai < 2; ++ai)
#pragma unroll
            for (int m = 0; m < 4; ++m) { const int row = row0 + ai * 128 + m * 16; bf16* rowp = O + (size_t)row * (2 * SGU_W) + col0; float s = 0.f, q = 0.f; const float sr = sx[row];
#pragma unroll
                for (int bj = 0; bj < 2; ++bj) {
                    f32x4 v0 = __builtin_convertvector(__builtin_bit_cast(v4i, acc[ai][bj][m][0]), f32x4) * (sv[bj][0] * sr) + bv[bj][0];
                    f32x4 v1 = __builtin_convertvector(__builtin_bit_cast(v4i, acc[ai][bj][m][1]), f32x4) * (sv[bj][1] * sr) + bv[bj][1];
                    { const f32x2 ga = gelu_pk((f32x2){v0[0], v0[1]}), gb = gelu_pk((f32x2){v0[2], v0[3]}), gc = gelu_pk((f32x2){v1[0], v1[1]}), gd = gelu_pk((f32x2){v1[2], v1[3]});
                      v0 = (f32x4){ga.x, ga.y, gb.x, gb.y}; v1 = (f32x4){gc.x, gc.y, gd.x, gd.y}; }
#pragma unroll
                    for (int j = 0; j < 4; ++j) { s += v0[j] + v1[j]; q += v0[j] * v0[j] + v1[j] * v1[j]; }
                    u32x4 w; w.x = pk2(v0[0], v0[1]); w.y = pk2(v0[2], v0[3]); w.z = pk2(v1[0], v1[1]); w.w = pk2(v1[2], v1[3]);
                    *(u32x4*)(rowp + bj * 128) = w; }
                if (isv) { const int ln = fq * 16 + fr; s += shx(s, 16, ln); s += shx(s, 32, ln); q += shx(q, 16, ln); q += shx(q, 32, ln);
                    if (fq == 0) *(f32x2*)(stats + (size_t)row * 64 + slot * 2) = (f32x2){s, q}; } }
    }
};
struct EpiZ {
    static constexpr bool PUBLISH = false;
    bf16* Z; const float* bias; const bf16* X; float sc;
    __device__ __forceinline__ void operator()(const f32x4 (&acc)[2][2][4][2], const UnitD& u, int wr, int wc, int fr, int fq) const {
        const int row0 = u.r0 + wr * 64 + fr, col0 = u.c0 + wc * 32 + 8 * fq;
#pragma unroll
        for (int bj = 0; bj < 2; ++bj) { const f32x4 bv0 = *(const f32x4*)(bias + col0 + bj * 128), bv1 = *(const f32x4*)(bias + col0 + bj * 128 + 4);
#pragma unroll
            for (int ai = 0; ai < 2; ++ai)
#pragma unroll
                for (int m = 0; m < 4; ++m) { const size_t ro = (size_t)(row0 + ai * 128 + m * 16) * DM + col0 + bj * 128;
                    const u32x4 xr = *(const u32x4*)(X + ro);
                    const f32x4 v0 = acc[ai][bj][m][0] * sc + bv0 + DN_ALPHA * (f32x4){bflo(xr.x), bfhi(xr.x), bflo(xr.y), bfhi(xr.y)};
                    const f32x4 v1 = acc[ai][bj][m][1] * sc + bv1 + DN_ALPHA * (f32x4){bflo(xr.z), bfhi(xr.z), bflo(xr.w), bfhi(xr.w)};
                    u32x4 w; w.x = pk2(v0[0], v0[1]); w.y = pk2(v0[2], v0[3]); w.z = pk2(v1[0], v1[1]); w.w = pk2(v1[2], v1[3]);
                    *(u32x4*)(Z + ro) = w; } }
    }
};
struct EpiUp {
    static constexpr bool PUBLISH = true; unsigned* upc;
    __device__ __forceinline__ void publish(int mt) const { (void)__hip_atomic_fetch_add(upc + mt, 1u, __ATOMIC_RELAXED, __HIP_MEMORY_SCOPE_AGENT); }
    unsigned char* H; const LAS float* bl_lds;
    static __device__ __forceinline__ f32x2 act2(f32x2 g, f32x2 l) {
        g = __builtin_elementwise_min(g, (f32x2){7.f, 7.f}); l = __builtin_elementwise_min(__builtin_elementwise_max(l, (f32x2){-7.f, -7.f}), (f32x2){7.f, 7.f});
        const f32x2 t = g * (-1.702f * 1.44269504089f); f32x2 e; e.x = __builtin_amdgcn_exp2f(t.x); e.y = __builtin_amdgcn_exp2f(t.y);
        const f32x2 d = e + 1.0f; f32x2 r; r.x = __builtin_amdgcn_rcpf(d.x); r.y = __builtin_amdgcn_rcpf(d.y);
        return (g * r) * (l * QS_ACT + QS_ACT);
    }
    __device__ __forceinline__ void operator()(const f32x4 (&acc)[2][2][4][2], const UnitD& u, int wr, int wc, int fr, int fq) const {
        const int row0 = u.r0 + wr * 64 + fr, col0 = u.c0 + wc * 32 + 8 * fq;
        const LAS float* bg = bl_lds + u.ui * 256 + wc * 32 + 8 * fq; const LAS float* bl = bg + 128;
        f32x4 bgv[2], blv[2];
#pragma unroll
        for (int n = 0; n < 2; ++n) { bgv[n] = *(const LAS f32x4*)(bg + 4 * n); blv[n] = *(const LAS f32x4*)(bl + 4 * n); }
        constexpr float SC = 1.f / (QS_X1 * QS_WUP);
#pragma unroll
        for (int ai = 0; ai < 2; ++ai)
#pragma unroll
            for (int m = 0; m < 4; ++m) { unsigned char* rowp = H + (size_t)(row0 + ai * 128 + m * 16) * DM + col0; u32x2 w;
#pragma unroll
                for (int n = 0; n < 2; ++n) { const f32x4 g = acc[ai][0][m][n] * SC + bgv[n], l = acc[ai][1][m][n] * SC + blv[n];
                    const f32x2 o0 = act2((f32x2){g[0], g[1]}, (f32x2){l[0], l[1]}), o1 = act2((f32x2){g[2], g[3]}, (f32x2){l[2], l[3]});
                    int r = 0; r = __builtin_amdgcn_cvt_pk_fp8_f32(e2m3q<EMU_DOWN != 0>(o0.x), e2m3q<EMU_DOWN != 0>(o0.y), r, false); r = __builtin_amdgcn_cvt_pk_fp8_f32(e2m3q<EMU_DOWN != 0>(o1.x), e2m3q<EMU_DOWN != 0>(o1.y), r, true);
                    if (n == 0) w.x = (unsigned)r; else w.y = (unsigned)r; }
                __hip_atomic_store((unsigned long long*)rowp, ((unsigned long long)w.y << 32) | (unsigned long long)w.x, __ATOMIC_RELAXED, __HIP_MEMORY_SCOPE_AGENT); }
    }
};
struct EpiDown {
    static constexpr bool PUBLISH = false;
    bf16* Y; const LAS float* bl_lds;
    __device__ __forceinline__ void operator()(const f32x4 (&acc)[2][2][4][2], const UnitD& u, int wr, int wc, int fr, int fq) const {
        const int row0 = u.r0 + wr * 64 + fr, col0 = u.c0 + wc * 32 + 8 * fq;
        const LAS float* bias = bl_lds + u.ui * 256 + wc * 32 + 8 * fq;
#pragma unroll
        for (int bj = 0; bj < 2; ++bj) { const f32x4 bv0 = *(const LAS f32x4*)(bias + bj * 128), bv1 = *(const LAS f32x4*)(bias + bj * 128 + 4);
#pragma unroll
            for (int ai = 0; ai < 2; ++ai)
#pragma unroll
                for (int m = 0; m < 4; ++m) { bf16* rowp = Y + (size_t)(row0 + ai * 128 + m * 16) * DM + col0 + bj * 128;
                    const f32x4 v0 = acc[ai][bj][m][0] * (1.f / (QS_ACT * QS_WDOWN)) + bv0, v1 = acc[ai][bj][m][1] * (1.f / (QS_ACT * QS_WDOWN)) + bv1;
                    u32x4 w; w.x = pk2(v0[0], v0[1]); w.y = pk2(v0[2], v0[3]); w.z = pk2(v1[0], v1[1]); w.w = pk2(v1[2], v1[3]);
                    *(u32x4*)rowp = w; } }
    }
};

struct UpSched {
    static constexpr size_t BHALF = (size_t)1024 * DM; static constexpr bool POLL = false;
    const LAS int* ut; const char* X1B; const char* W;
    __device__ __forceinline__ bool next(int i, UnitD& u) const {
        if (i >= MAXU) return false;
        const int valid = __builtin_amdgcn_readfirstlane(ut[i * 4 + 3]); if (!valid) return false;
        const int e = __builtin_amdgcn_readfirstlane(ut[i * 4 + 0]), mt = __builtin_amdgcn_readfirstlane(ut[i * 4 + 1]), nt = __builtin_amdgcn_readfirstlane(ut[i * 4 + 2]);
        u.A = X1B; u.B = W + ((size_t)e * 2048 + nt * 128) * DM; u.r0 = mt * 256; u.c0 = nt * 128; u.e = e; u.ui = i; return true;
    }
};
struct DownSched {
    static constexpr size_t BHALF = (size_t)128 * DM; static constexpr bool POLL = true;
    const LAS int* ut; const char* H; const char* W; const unsigned* upc; bool w0;
    __device__ __forceinline__ void wait_tile(int mt) const {
        unsigned sp = 0;
        while (__builtin_amdgcn_readfirstlane(__hip_atomic_load(upc + mt, __ATOMIC_RELAXED, __HIP_MEMORY_SCOPE_AGENT)) < 8u) { __builtin_amdgcn_s_sleep(2); if (++sp > (1u << 22)) break; }
    }
    __device__ __forceinline__ bool next(int i, UnitD& u) const {
        if (i >= MAXU) return false;
        const int valid = __builtin_amdgcn_readfirstlane(ut[i * 4 + 3]); if (!valid) return false;
        const int e = __builtin_amdgcn_readfirstlane(ut[i * 4 + 0]), mt = __builtin_amdgcn_readfirstlane(ut[i * 4 + 1]), nt = __builtin_amdgcn_readfirstlane(ut[i * 4 + 2]);
        if (MK_SINGLE && w0) {
            if (i == 0) { wait_tile(mt);
#pragma unroll 1
                for (int j = 1; j < 4; ++j) if (__builtin_amdgcn_readfirstlane(ut[j * 4 + 3])) wait_tile(__builtin_amdgcn_readfirstlane(ut[j * 4 + 1]));
                __builtin_amdgcn_fence(__ATOMIC_ACQUIRE, "agent"); }
            else if (i >= 4) { wait_tile(mt); __builtin_amdgcn_fence(__ATOMIC_ACQUIRE, "agent"); }
        }
        u.A = H + (size_t)mt * 256 * DM; u.B = W + ((size_t)e * 1024 + nt * 256) * DM; u.r0 = mt * 256; u.c0 = nt * 256; u.e = e; u.ui = i; return true;
    }
};
template <int NTN, bool ROWS, bool REUSE = false>
__device__ __forceinline__ void moe_tables(CArgs a, LAS unsigned char* lds, int L, int wv, const float* bias  ) {
    int tid = phase_tid(wv);
    const int G = gridDim.x;
    LAS int* misc = (LAS int*)(lds + MISC_OFF);
    LAS int* ut = (LAS int*)(lds + UT_OFF);
    LAS int* tab = (LAS int*)(lds + TAB_OFF);
    const unsigned* cntw = (const unsigned*)(a->ws + WS_CTL) + CW_CNT + (size_t)L * NEXP * 64;
    __syncthreads();
    if (!(REUSE && MK_SINGLE)) {
        if (tid < 64) { const int ln = tid & 63; int c = 0; if (ln < NEXP) c = (int)__hip_atomic_load(cntw + ln * 64, __ATOMIC_RELAXED, __HIP_MEMORY_SCOPE_AGENT);
            const int n = (c + 255) >> 8; int s = n;
#pragma unroll
            for (int o = 1; o < 32; o <<= 1) { const int t = __builtin_amdgcn_ds_bpermute(((ln - o) & 63) << 2, s); if ((ln & 31) >= o) s += t; }
            if (ln < NEXP) { misc[64 + ln] = c; misc[16 + ln] = s - n; if (ln == NEXP - 1) misc[16 + NEXP] = s; } }
        __syncthreads();
    }
    if (tid < MAXU) {
        const int T = misc[16 + NEXP];
        const int x = blockIdx.x & 7, w = blockIdx.x >> 3, WPX = G >> 3, MPG = WPX / NTN;
        int mt = (tid * 8 + x) * MPG + w / NTN, nt = w % NTN;
        if (NTN == 4 && MK_SINGLE) {
            if (tid == 4) { const int j = (7 - x) * (G >> 3) + w; mt = 256 + (j >> 2); nt = j & 3; }
            else if (tid > 4) mt = 1 << 20; }
        int e = 0; for (int k = 1; k < NEXP; ++k) if (misc[16 + k] <= mt) e = k;
        const int valid = mt < T ? 1 : 0;
        ut[tid * 4 + 0] = e; ut[tid * 4 + 1] = mt; ut[tid * 4 + 2] = nt; ut[tid * 4 + 3] = valid;
    }
    __syncthreads();
    {
        LAS float* bl = (LAS float*)(lds + BIAS_OFF);
        for (int idx = tid; idx < MAXU * 256; idx += NTHR) { const int i = idx >> 8, s = idx & 255; float v = 0.f;
            if (ut[i * 4 + 3]) { const int e = ut[i * 4 + 0], nt = ut[i * 4 + 2];
                v = (NTN == 8) ? bias[(size_t)e * 2048 + (s < 128 ? nt * 128 + s : 1024 + nt * 128 + s - 128)] : bias[(size_t)e * DM + nt * 256 + s]; }
            bl[idx] = v; }
        if (!ROWS) __syncthreads();
    }
    if (ROWS) {
        const int* rowtok = (const int*)(a->ws + WS_ROWTOK);
        for (int idx = tid; idx < MAXU * 256; idx += NTHR) { const int i = idx >> 8, r = idx & 255;
            int tok = 0;
            if (ut[i * 4 + 3]) { const int e = ut[i * 4 + 0], row = (ut[i * 4 + 1] - misc[16 + e]) * 256 + r; if (row < misc[64 + e]) tok = rowtok[(size_t)e * CAPROWS + row]; }
            tab[idx] = tok; }
        __syncthreads();
    }
}

__device__ __forceinline__ void phase_even_mix(CArgs a, LAS unsigned char* lds, int i2, int wv) {
    int tid = phase_tid(wv);
    const int lane = tid & 63, wave = __builtin_amdgcn_readfirstlane(tid >> 6), G = gridDim.x;
    const bf16* HB = (const bf16*)(a->ws + WS_HB); bf16* YB = (bf16*)(a->ws + WS_YB);
    LAS bf16* glu = (LAS bf16*)lds;
    LAS float* ybuf = (LAS float*)(lds + 65536);
    constexpr int PLS = 520;
    LAS bf16* pl = (LAS bf16*)(lds + 65536);
    const int c = tid;
    const float* cw = a->in[I_CONVW] + (size_t)i2 * 31 * 512;
    for (int chunk = blockIdx.x; chunk < NTOK / 32; chunk += G) {
        const int b = chunk >> 6, t0 = (chunk & 63) * 32; const size_t tokbase = (size_t)chunk * 32;
#pragma unroll
        for (int it = 0; it < 8; ++it) { const int item = it * NTHR + tid, tt = item >> 6, cg = item & 63, p = t0 - 32 + tt;
            u32x4 o = (u32x4){0u, 0u, 0u, 0u};
            if (p >= 0) { const bf16* hp = HB + ((size_t)b * SEQ + p) * EVEN_IN + cg * 8; const u32x4 ra = *(const u32x4*)(hp + 512), rg = *(const u32x4*)(hp + 1024);
                o.x = pk2(bflo(ra.x) * sigmoidf_(bflo(rg.x)), bfhi(ra.x) * sigmoidf_(bfhi(rg.x))); o.y = pk2(bflo(ra.y) * sigmoidf_(bflo(rg.y)), bfhi(ra.y) * sigmoidf_(bfhi(rg.y)));
                o.z = pk2(bflo(ra.z) * sigmoidf_(bflo(rg.z)), bfhi(ra.z) * sigmoidf_(bfhi(rg.z))); o.w = pk2(bflo(ra.w) * sigmoidf_(bflo(rg.w)), bfhi(ra.w) * sigmoidf_(bfhi(rg.w))); }
            *(LAS u32x4*)(glu + tt * 512 + cg * 8) = o; }
        __syncthreads();
        {
            float w[31];
#pragma unroll
            for (int k = 0; k < 31; ++k) { unsigned off = (unsigned)c * 4u; asm volatile("" : "+v"(off)); w[k] = *(const float*)((const char*)(cw + k * 512) + off); }
            const float cb = a->in[I_CONVB][i2 * 512 + c];
            float win[34];
#pragma clang loop unroll(full)
            for (int r = 0; r < 64; ++r) {
                win[r % 34] = bf2f(glu[r * 512 + c]);
                if (r >= 32) { float y = cb;
#pragma unroll
                    for (int k = 0; k < 31; ++k) y += w[k] * win[(r - 30 + k) % 34];
                    ybuf[(r - 32) * 512 + c] = y; }
            }
        }
        __syncthreads();
#pragma unroll
        for (int it = 0; it < 6; ++it) { const int item = it * NTHR + tid, tt = item >> 6, cg = item & 63, p = t0 - 16 + tt;
            u32x4 o = (u32x4){0u, 0u, 0u, 0u};
            if (p >= 0) o = *(const u32x4*)(HB + ((size_t)b * SEQ + p) * EVEN_IN + cg * 8);
            *(LAS u32x4*)(glu + tt * 512 + cg * 8) = o; }
        {
            const float* lg = a->in[I_CLNG] + i2 * 512 + lane * 8; const float* lb = a->in[I_CLNB] + i2 * 512 + lane * 8;
            const f32x4 g0 = *(const f32x4*)lg, g1 = *(const f32x4*)(lg + 4), b0 = *(const f32x4*)lb, b1 = *(const f32x4*)(lb + 4);
#pragma unroll
            for (int tt = 0; tt < 4; ++tt) { const int t = wave * 4 + tt;
                f32x4 v0 = *(const LAS f32x4*)(ybuf + t * 512 + lane * 8), v1 = *(const LAS f32x4*)(ybuf + t * 512 + lane * 8 + 4);
                const float mean = wave_sum((v0.x + v0.y) + (v0.z + v0.w) + (v1.x + v1.y) + (v1.z + v1.w), lane) * (1.f / 512.f);
                v0 = v0 - mean; v1 = v1 - mean;
                const float var = wave_sum((v0.x * v0.x + v0.y * v0.y) + (v0.z * v0.z + v0.w * v0.w) + (v1.x * v1.x + v1.y * v1.y) + (v1.z * v1.z + v1.w * v1.w), lane) * (1.f / 512.f);
                const float rstd = 1.0f / sqrtf(var + LN_EPS);
                float o[8];
#pragma unroll
                for (int j = 0; j < 4; ++j) { const float x0 = v0[j] * rstd * g0[j] + b0[j], x1 = v1[j] * rstd * g1[j] + b1[j]; o[j] = x0 * sigmoidf_(x0); o[4 + j] = x1 * sigmoidf_(x1); }
                u32x4 wv4; wv4.x = pk2(o[0], o[1]); wv4.y = pk2(o[2], o[3]); wv4.z = pk2(o[4], o[5]); wv4.w = pk2(o[6], o[7]);
                *(u32x4*)(YB + (tokbase + t) * DM + 512 + lane * 8) = wv4; }
        }
        __syncthreads();
        {
            const int g = wave >> 1, winw = 2 << g;
            float pprev = 0.f, a2r[3] = {0.f, 0.f, 0.f}, a4r[5] = {0.f, 0.f, 0.f, 0.f, 0.f}, a8r[9] = {0.f, 0.f, 0.f, 0.f, 0.f, 0.f, 0.f, 0.f, 0.f};
#pragma clang loop unroll(full)
            for (int r = 0; r < 48; ++r) {
                const float p = bf2f(glu[r * 512 + c]);
                const float a2 = p + pprev, a4 = a2 + a2r[(r + 1) % 3], a8 = a4 + a4r[(r + 1) % 5], a16 = a8 + a8r[(r + 1) % 9];
                a2r[r % 3] = a2; a4r[r % 5] = a4; a8r[r % 9] = a8; pprev = p;
                if (r >= 16) { const float s = g == 0 ? a2 : (g == 1 ? a4 : (g == 2 ? a8 : a16));
                    const int pos = t0 + r - 16; const float cnt = (float)((pos + 1) < winw ? (pos + 1) : winw);
                    pl[(r - 16) * PLS + c] = (bf16)f2bf(s / cnt - p); }
            }
        }
        __syncthreads();
        {
            const int g = wave >> 1, nh = wave & 1, fr = lane & 15, fq = lane >> 4;
            const bf16* wp = (const bf16*)(a->ws + WS_WPOOL) + ((size_t)i2 * 4 + g) * 128 * 128;
            f32x4 acc[2][4];
#pragma unroll
            for (int m = 0; m < 2; ++m)
#pragma unroll
                for (int n = 0; n < 4; ++n) acc[m][n] = (f32x4){0.f, 0.f, 0.f, 0.f};
#pragma unroll
            for (int ks = 0; ks < 4; ++ks) {
                bf16x8 af[2], bfr[4];
#pragma unroll
                for (int m = 0; m < 2; ++m) af[m] = *(const LAS bf16x8*)(pl + (m * 16 + fr) * PLS + g * 128 + ks * 32 + fq * 8);
#pragma unroll
                for (int n = 0; n < 4; ++n) bfr[n] = *(const bf16x8*)(wp + (size_t)(nh * 64 + n * 16 + fr) * 128 + ks * 32 + fq * 8);
#pragma unroll
                for (int m = 0; m < 2; ++m)
#pragma unroll
                    for (int n = 0; n < 4; ++n) acc[m][n] = __builtin_amdgcn_mfma_f32_16x16x32_bf16(bfr[n], af[m], acc[m][n], 0, 0, 0);
            }
#pragma unroll
            for (int n = 0; n < 4; ++n) { const int d = nh * 64 + n * 16 + 4 * fq;
                const f32x4 pb = *(const f32x4*)(a->in[I_POOLB] + ((size_t)i2 * 4 + g) * 128 + d), ps = *(const f32x4*)(a->in[I_POOLS] + (size_t)i2 * 512 + g * 128 + d);
#pragma unroll
                for (int m = 0; m < 2; ++m) { const f32x4 v = (acc[m][n] + pb) * ps; u32x2 wv2; wv2.x = pk2(v.x, v.y); wv2.y = pk2(v.z, v.w);
                    *(u32x2*)(YB + (tokbase + m * 16 + fr) * DM + g * 128 + d) = wv2; } }
        }
        __syncthreads();
    }
}

__device__ __forceinline__ void phase_sgu(CArgs a, LAS unsigned char* lds, int i2, int wv) {
    int tid = phase_tid(wv);
    const int G = gridDim.x;
    const bf16* HB = (const bf16*)(a->ws + WS_HB); unsigned char* YQ = a->ws + WS_YB;
    const float* stats = (const float*)(a->ws + WS_STATS);
    constexpr int VS = 136;
    LAS bf16* vt = (LAS bf16*)lds;
    LAS float* mu = (LAS float*)(lds + 256 * VS * 2), *rs = mu + 128;
    LAS unsigned char* wl = lds + 73728;
    const float* lg = a->in[I_SLNG] + (size_t)i2 * SGU_W; const float* lb = a->in[I_SLNB] + (size_t)i2 * SGU_W;
    for (int u = blockIdx.x; u < (NTOK / 128) * 2; u += G) {
        const int chunk = u >> 1, h0 = (u & 1) * 4; const size_t tok0 = (size_t)chunk * 128;
        int tz = tid; asm volatile("" : "+v"(tz));
        const int lane = tz & 63, wave = __builtin_amdgcn_readfirstlane(tz >> 6), wr = wave >> 2, wc = wave & 3, fr = lane & 15, fq = lane >> 4;
        if (tz < 128) { const float* sp = stats + (tok0 + tz) * 64; float s = 0.f, q = 0.f;
#pragma unroll
            for (int k = 0; k < 16; ++k) { const f32x4 v = *(const f32x4*)(sp + 4 * k); s += v.x + v.z; q += v.y + v.w; }
            const float m = s * (1.f / SGU_W), var = fmaxf(q * (1.f / SGU_W) - m * m, 0.f);
            mu[tz] = m; rs[tz] = 1.0f / sqrtf(var + LN_EPS); }
        u32x4 vraw[8];
#pragma unroll
        for (int it = 0; it < 8; ++it) { const int j = 32 * (it & 3) + (lane & 31), c8 = 2 * (8 * (it >> 2) + wave) + (lane >> 5);
            vraw[it] = *(const u32x4*)(HB + (tok0 + j) * (2 * SGU_W) + SGU_W + h0 * 256 + c8 * 8); }
        __syncthreads();
#pragma unroll 1
        for (int hh = 0; hh < 4; ++hh) {
            const int h = h0 + hh;
            const bf16* wm = (const bf16*)(a->ws + WS_WSGU) + ((size_t)i2 * 8 + h) * 128 * 128;
#pragma unroll
            for (int q = 0; q < 4; ++q) { const int r = 4 * (8 * q + wave) + (lane >> 4);
                __builtin_amdgcn_global_load_lds((const unsigned*)(wm + (size_t)r * 128 + 8 * ((lane & 15) ^ (r & 15))), (LAS unsigned*)(wl + (8 * q + wave) * 1024), 16, 0, 0); }
            {
                const int cA = 2 * wave + (lane >> 5);
                f32x4 gg[2][2], bb[2][2];
#pragma unroll
                for (int q = 0; q < 2; ++q) { const float* gp = lg + h * 256 + (cA + 16 * q) * 8; const float* bp = lb + h * 256 + (cA + 16 * q) * 8;
                    gg[q][0] = *(const f32x4*)gp; gg[q][1] = *(const f32x4*)(gp + 4); bb[q][0] = *(const f32x4*)bp; bb[q][1] = *(const f32x4*)(bp + 4); }
#pragma unroll
                for (int it = 0; it < 8; ++it) { const int j = 32 * (it & 3) + (lane & 31), q = it >> 2, c8 = cA + 16 * q;
                    const float m = mu[j], r = rs[j]; const u32x4 raw = vraw[it];
                    const float v[8] = {bflo(raw.x), bfhi(raw.x), bflo(raw.y), bfhi(raw.y), bflo(raw.z), bfhi(raw.z), bflo(raw.w), bfhi(raw.w)};
#pragma unroll
                    for (int k = 0; k < 8; k += 2) { const unsigned pr = pk2((v[k] - m) * r * gg[q][k >> 2][k & 3] + bb[q][k >> 2][k & 3], (v[k + 1] - m) * r * gg[q][k >> 2][(k + 1) & 3] + bb[q][k >> 2][(k + 1) & 3]);
                        vt[(c8 * 8 + k) * VS + j] = (bf16)(pr & 0xffffu); vt[(c8 * 8 + k + 1) * VS + j] = (bf16)(pr >> 16); } }
            }
            if (hh < 3) {
#pragma unroll
                for (int it = 0; it < 8; ++it) { const int j = 32 * (it & 3) + (lane & 31), c8 = 2 * (8 * (it >> 2) + wave) + (lane >> 5);
                    vraw[it] = *(const u32x4*)(HB + (tok0 + j) * (2 * SGU_W) + SGU_W + (h + 1) * 256 + c8 * 8); } }
            asm volatile("s_waitcnt vmcnt(0)" ::: "memory");
            __syncthreads();
            f32x4 acc[4][4];
#pragma unroll
            for (int m = 0; m < 4; ++m)
#pragma unroll
                for (int n = 0; n < 4; ++n) acc[m][n] = (f32x4){0.f, 0.f, 0.f, 0.f};
#pragma unroll
            for (int ks = 0; ks < 4; ++ks) {
                bf16x8 bfr[4], af[4];
#pragma unroll
                for (int m = 0; m < 4; ++m) { const int i = wr * 64 + m * 16 + fr; af[m] = *(const LAS bf16x8*)(wl + i * 256 + (((ks * 4 + fq) ^ (i & 15)) * 16)); }
#pragma unroll
                for (int n = 0; n < 4; ++n) bfr[n] = *(const LAS bf16x8*)(vt + (wc * 64 + n * 16 + fr) * VS + ks * 32 + fq * 8);
#pragma unroll
                for (int m = 0; m < 4; ++m)
#pragma unroll
                    for (int n = 0; n < 4; ++n) acc[m][n] = __builtin_amdgcn_mfma_f32_16x16x32_bf16(bfr[n], af[m], acc[m][n], 0, 0, 0);
            }
            { int te = tz; asm volatile("" : "+v"(te));
              const int le = te & 63, we = te >> 6, wr = we >> 2, wc = we & 3, fr = le & 15, fq = le >> 4;
#pragma unroll
            for (int m = 0; m < 4; ++m) { const int i = wr * 64 + m * 16 + fr; const float bs = a->in[I_SGUB][((size_t)i2 * 8 + h) * 128 + i];
#pragma unroll
                for (int n = 0; n < 4; ++n) { const int cc = h * 256 + wc * 64 + n * 16 + 4 * fq;
                    const f32x4 sv = acc[m][n] + bs; const u32x2 uv = *(const u32x2*)(HB + (tok0 + i) * (2 * SGU_W) + cc);
                    *(unsigned*)(YQ + (tok0 + i) * SGU_W + cc) = pk4_fp8(bflo(uv.x) * sv.x * QS_GATED, bfhi(uv.x) * sv.y * QS_GATED, bflo(uv.y) * sv.z * QS_GATED, bfhi(uv.y) * sv.w * QS_GATED); } } }
            __syncthreads();
        }
    }
}

__device__ __forceinline__ void phase_ln_route(CArgs a, LAS unsigned char* lds, int L, int wv) {
    int tid = phase_tid(wv);
    const int lane = tid & 63, wave = __builtin_amdgcn_readfirstlane(tid >> 6), G = gridDim.x;
    const int fr = lane & 15, fq = lane >> 4, tg = wave & 1, kq = wave >> 1;
    const bf16* Z = (const bf16*)(a->ws + WS_Z); bf16* X1B = (bf16*)(a->ws + WS_X1F); unsigned char* X1Q = a->ws + WS_X1B;
    LAS float* red = (LAS float*)lds;
    LAS float* plg = (LAS float*)(lds + 4096);
    LAS float* lgt = (LAS float*)(lds + 4096 + 16384);
    LAS int* hist = (LAS int*)(lds + MISC_OFF + 512);
    const bf16* RWH = (const bf16*)(a->ws + WS_RWH) + (size_t)L * NEXP * DM; const bf16* RWL = (const bf16*)(a->ws + WS_RWL) + (size_t)L * NEXP * DM;
    const float* lng = a->in[I_LNG] + ((size_t)L * 2 + 0) * DM; const float* lnb = a->in[I_LNB] + ((size_t)L * 2 + 0) * DM;
    unsigned* cntw = (unsigned*)(a->ws + WS_CTL) + CW_CNT + (size_t)L * NEXP * 64;
    int* rowtok = (int*)(a->ws + WS_ROWTOK); int* EP = (int*)(a->ws + WS_EP); float* GATE = (float*)(a->ws + WS_GATE);
    for (int sc = blockIdx.x; sc < NTOK / 64; sc += G) {
        if (tid < 32) hist[tid] = 0;
#pragma unroll 1
      for (int half = 0; half < 2; ++half) { const int chunk = 2 * sc + half;
        const int tokl = tg * 16 + fr; const size_t tok = (size_t)chunk * 32 + tokl; const int kb = kq * 256 + fq * 8;
        f32x4 v[8][2]; float s = 0.f;
#pragma unroll
        for (int ks = 0; ks < 8; ++ks) { const u32x4 zr = *(const u32x4*)(Z + tok * DM + kb + ks * 32);
            v[ks][0] = (f32x4){bflo(zr.x), bfhi(zr.x), bflo(zr.y), bfhi(zr.y)}; v[ks][1] = (f32x4){bflo(zr.z), bfhi(zr.z), bflo(zr.w), bfhi(zr.w)};
            s += ((v[ks][0].x + v[ks][0].y) + (v[ks][0].z + v[ks][0].w)) + ((v[ks][1].x + v[ks][1].y) + (v[ks][1].z + v[ks][1].w)); }
        s += shx(s, 16, lane); s += shx(s, 32, lane);
        if (fq == 0) red[kq * 32 + tokl] = s;
        __syncthreads();
        const float mean = ((red[tokl] + red[32 + tokl]) + (red[64 + tokl] + red[96 + tokl])) * (1.f / DM); float q = 0.f;
#pragma unroll
        for (int ks = 0; ks < 8; ++ks) { v[ks][0] = v[ks][0] - mean; v[ks][1] = v[ks][1] - mean;
            q += ((v[ks][0].x * v[ks][0].x + v[ks][0].y * v[ks][0].y) + (v[ks][0].z * v[ks][0].z + v[ks][0].w * v[ks][0].w)) + ((v[ks][1].x * v[ks][1].x + v[ks][1].y * v[ks][1].y) + (v[ks][1].z * v[ks][1].z + v[ks][1].w * v[ks][1].w)); }
        q += shx(q, 16, lane); q += shx(q, 32, lane);
        if (fq == 0) red[128 + kq * 32 + tokl] = q;
        __syncthreads();
        const float rstd = 1.0f / sqrtf(((red[128 + tokl] + red[160 + tokl]) + (red[192 + tokl] + red[224 + tokl])) * (1.f / DM) + LN_EPS);
        f32x4 acc[2] = {(f32x4){0.f, 0.f, 0.f, 0.f}, (f32x4){0.f, 0.f, 0.f, 0.f}};
        unsigned sq[8][4];
#pragma unroll
        for (int ks = 0; ks < 8; ++ks) { const int k = kb + ks * 32;
            const f32x4 g0 = *(const f32x4*)(lng + k), g1 = *(const f32x4*)(lng + k + 4), b0 = *(const f32x4*)(lnb + k), b1 = *(const f32x4*)(lnb + k + 4);
            const f32x4 x0 = v[ks][0] * rstd * g0 + b0, x1 = v[ks][1] * rstd * g1 + b1;
            u32x4 hi; hi.x = pk2(x0.x, x0.y); hi.y = pk2(x0.z, x0.w); hi.z = pk2(x1.x, x1.y); hi.w = pk2(x1.z, x1.w);
            *(u32x4*)(X1B + tok * DM + k) = hi;
            if (FP6_UP) { sq[ks][0] = pk2(x0.x * QS_X1, x0.y * QS_X1); sq[ks][1] = pk2(x0.z * QS_X1, x0.w * QS_X1); sq[ks][2] = pk2(x1.x * QS_X1, x1.y * QS_X1); sq[ks][3] = pk2(x1.z * QS_X1, x1.w * QS_X1); }
            else { u32x2 q8; q8.x = pk4_fp8(x0.x * QS_X1, x0.y * QS_X1, x0.z * QS_X1, x0.w * QS_X1); q8.y = pk4_fp8(x1.x * QS_X1, x1.y * QS_X1, x1.z * QS_X1, x1.w * QS_X1); *(u32x2*)(X1Q + tok * DM + k) = q8; }
            u32x4 lo; lo.x = pk2(x0.x - bflo(hi.x), x0.y - bfhi(hi.x)); lo.y = pk2(x0.z - bflo(hi.y), x0.w - bfhi(hi.y)); lo.z = pk2(x1.x - bflo(hi.z), x1.y - bfhi(hi.z)); lo.w = pk2(x1.z - bflo(hi.w), x1.w - bfhi(hi.w));
            const bf16x8 ah = __builtin_bit_cast(bf16x8, hi), al = __builtin_bit_cast(bf16x8, lo);
#pragma unroll
            for (int nn = 0; nn < 2; ++nn) { const bf16x8 bh = *(const bf16x8*)(RWH + (size_t)(nn * 16 + fr) * DM + k), bl = *(const bf16x8*)(RWL + (size_t)(nn * 16 + fr) * DM + k);
                acc[nn] = __builtin_amdgcn_mfma_f32_16x16x32_bf16(ah, bh, acc[nn], 0, 0, 0);
                acc[nn] = __builtin_amdgcn_mfma_f32_16x16x32_bf16(ah, bl, acc[nn], 0, 0, 0);
                acc[nn] = __builtin_amdgcn_mfma_f32_16x16x32_bf16(al, bh, acc[nn], 0, 0, 0); } }
        if (FP6_UP) {
#pragma unroll
            for (int s2 = 0; s2 < 2; ++s2) {
#pragma unroll
                for (int d = 0; d < 4; ++d) xpose4(sq[4 * s2 + 0][d], sq[4 * s2 + 1][d], sq[4 * s2 + 2][d], sq[4 * s2 + 3][d]);
                v16u w;
#pragma unroll
                for (int j = 0; j < 4; ++j)
#pragma unroll
                    for (int d = 0; d < 4; ++d) w[4 * j + d] = sq[4 * s2 + j][d];
                const v6u o = pack32_fp6(w);
                unsigned char* dq = X1Q + tok * DM + (kq * 2 + s2) * 128 + 16 * fq;
                *(u32x4*)dq = (u32x4){o[0], o[1], o[2], o[3]}; *(u32x4*)(dq + 64) = (u32x4){o[4], o[5], o[4], o[5]}; }
        }
#pragma unroll
        for (int nn = 0; nn < 2; ++nn)
#pragma unroll
            for (int j = 0; j < 4; ++j) plg[(kq * 32 + tg * 16 + 4 * fq + j) * 32 + nn * 16 + fr] = acc[nn][j];
        __syncthreads();
#pragma unroll
        for (int i = 0; i < 2; ++i) { const int idx = tid + NTHR * i, t = idx >> 5, e = idx & 31; lgt[(half * 32 + t) * 33 + e] = ((plg[idx] + plg[1024 + idx]) + (plg[2048 + idx] + plg[3072 + idx])) + a->in[I_RB][L * NEXP + e]; }
        __syncthreads();
      }
        int se[4] = {0, 0, 0, 0}, sp[4] = {0, 0, 0, 0}; float sg[4] = {0.f, 0.f, 0.f, 0.f};
        if (tid < 64) {
            float sv[4], lg[NEXP];
#pragma unroll
            for (int e = 0; e < NEXP; ++e) lg[e] = lgt[tid * 33 + e];
#pragma unroll
            for (int k = 0; k < 4; ++k) { float best = lg[0]; int bi = 0;
#pragma unroll
                for (int e = 1; e < NEXP; ++e) { const bool ok = lg[e] > best; best = ok ? lg[e] : best; bi = ok ? e : bi; }
#pragma unroll
                for (int e = 0; e < NEXP; ++e) lg[e] = (e == bi) ? -3.0e38f : lg[e];
                se[k] = bi; sv[k] = best; }
            float den = 0.f;
#pragma unroll
            for (int k = 0; k < 4; ++k) { sg[k] = __expf(sv[k] - sv[0]); den += sg[k]; }
#pragma unroll
            for (int k = 0; k < 4; ++k) { sg[k] = sg[k] / den; sp[k] = __hip_atomic_fetch_add(&hist[se[k]], 1, __ATOMIC_RELAXED, __HIP_MEMORY_SCOPE_WORKGROUP); }
        }
        __syncthreads();
        if (tid < 32) hist[32 + tid] = (int)__hip_atomic_fetch_add(cntw + tid * 64, (unsigned)hist[tid], __ATOMIC_RELAXED, __HIP_MEMORY_SCOPE_AGENT);
        __syncthreads();
        if (tid < 64) { const int tk = sc * 64 + tid;
#pragma unroll
            for (int k = 0; k < 4; ++k) { const int pos = hist[32 + se[k]] + sp[k]; rowtok[(size_t)se[k] * CAPROWS + pos] = tk; EP[tk * 4 + k] = (se[k] << 16) | pos; GATE[tk * 4 + k] = sg[k]; } }
        __syncthreads();
    }
}

__device__ __forceinline__ void phase_combine(CArgs a, LAS unsigned char* lds, int L, int wv) {
    int tid = phase_tid(wv);
    const int lane = tid & 63, wave = __builtin_amdgcn_readfirstlane(tid >> 6), G = gridDim.x;
    LAS int* misc = (LAS int*)(lds + MISC_OFF);
    const unsigned* cntw = (const unsigned*)(a->ws + WS_CTL) + CW_CNT + (size_t)L * NEXP * 64;
    __syncthreads();
#if !MK_SINGLE
    if (tid < NEXP) misc[64 + tid] = (int)__hip_atomic_load(cntw + tid * 64, __ATOMIC_RELAXED, __HIP_MEMORY_SCOPE_AGENT);
    __syncthreads();
    if (tid == 0) { int acc = 0; for (int e = 0; e < NEXP; ++e) { misc[16 + e] = acc; acc += (misc[64 + e] + 255) >> 8; } }
    __syncthreads();
#endif
    const bf16* X1B = (const bf16*)(a->ws + WS_X1F); const bf16* YS = (const bf16*)(a->ws + WS_YS);
    const int* EP = (const int*)(a->ws + WS_EP); const float* GATE = (const float*)(a->ws + WS_GATE);
    float* OUT = a->out; bf16* XB = (bf16*)(a->ws + WS_XB); unsigned char* XQ = a->ws + WS_XQ; float* SX = (float*)(a->ws + WS_SX); const bool last = (L == DEPTH - 1);
    const float* lng = a->in[I_LNG] + ((size_t)L * 2 + 1) * DM; const float* lnb = a->in[I_LNB] + ((size_t)L * 2 + 1) * DM;
    for (int tk = blockIdx.x * NWAVES + wave; tk < NTOK / 2; tk += G * NWAVES) {
        f32x4 v[2][2][2]; int4 ep4[2]; f32x4 g4[2];
#pragma unroll
        for (int h = 0; h < 2; ++h) { const int tok = tk + h * (NTOK / 2); ep4[h] = *(const int4*)(EP + tok * 4); g4[h] = *(const f32x4*)(GATE + tok * 4);
#pragma unroll
            for (int j = 0; j < 2; ++j) { const u32x4 xr = *(const u32x4*)(X1B + (size_t)tok * DM + lane * 8 + 512 * j);
                v[h][j][0] = DN_ALPHA * (f32x4){bflo(xr.x), bfhi(xr.x), bflo(xr.y), bfhi(xr.y)}; v[h][j][1] = DN_ALPHA * (f32x4){bflo(xr.z), bfhi(xr.z), bflo(xr.w), bfhi(xr.w)}; } }
#pragma unroll
        for (int k = 0; k < 4; ++k)
#pragma unroll
            for (int h = 0; h < 2; ++h) { const int ep = k == 0 ? ep4[h].x : k == 1 ? ep4[h].y : k == 2 ? ep4[h].z : ep4[h].w; const float g = g4[h][k];
                const size_t row = (size_t)misc[16 + (ep >> 16)] * 256 + (ep & 0xffff);
#pragma unroll
                for (int j = 0; j < 2; ++j) { const u32x4 y = *(const u32x4*)(YS + row * DM + lane * 8 + 512 * j);
                    v[h][j][0] += g * (f32x4){bflo(y.x), bfhi(y.x), bflo(y.y), bfhi(y.y)}; v[h][j][1] += g * (f32x4){bflo(y.z), bfhi(y.z), bflo(y.w), bfhi(y.w)}; } }
#pragma unroll
        for (int h = 0; h < 2; ++h) { const int tok = tk + h * (NTOK / 2);
            float s = 0.f;
#pragma unroll
            for (int j = 0; j < 2; ++j) s += ((v[h][j][0].x + v[h][j][0].y) + (v[h][j][0].z + v[h][j][0].w)) + ((v[h][j][1].x + v[h][j][1].y) + (v[h][j][1].z + v[h][j][1].w));
            const float mean = wave_sum(s, lane) * (1.f / DM); float s2 = 0.f;
#pragma unroll
            for (int j = 0; j < 2; ++j) { v[h][j][0] = v[h][j][0] - mean; v[h][j][1] = v[h][j][1] - mean;
                s2 += ((v[h][j][0].x * v[h][j][0].x + v[h][j][0].y * v[h][j][0].y) + (v[h][j][0].z * v[h][j][0].z + v[h][j][0].w * v[h][j][0].w)) + ((v[h][j][1].x * v[h][j][1].x + v[h][j][1].y * v[h][j][1].y) + (v[h][j][1].z * v[h][j][1].z + v[h][j][1].w * v[h][j][1].w)); }
            const float rstd = 1.0f / sqrtf(wave_sum(s2, lane) * (1.f / DM) + LN_EPS);
            float am = 0.f;
#pragma unroll
            for (int j = 0; j < 2; ++j) { const int c0 = lane * 8 + 512 * j;
                v[h][j][0] = v[h][j][0] * rstd * *(const f32x4*)(lng + c0) + *(const f32x4*)(lnb + c0); v[h][j][1] = v[h][j][1] * rstd * *(const f32x4*)(lng + c0 + 4) + *(const f32x4*)(lnb + c0 + 4);
                const f32x4 a0 = __builtin_elementwise_abs(v[h][j][0]), a1 = __builtin_elementwise_abs(v[h][j][1]); am = fmaxf(am, fmaxf(fmaxf(fmaxf(a0.x, a0.y), fmaxf(a0.z, a0.w)), fmaxf(fmaxf(a1.x, a1.y), fmaxf(a1.z, a1.w)))); }
            if (last) {
#pragma unroll
                for (int j = 0; j < 2; ++j) { const int c0 = lane * 8 + 512 * j; *(f32x4*)(OUT + (size_t)tok * DM + c0) = v[h][j][0]; *(f32x4*)(OUT + (size_t)tok * DM + c0 + 4) = v[h][j][1]; } }
            else {
                am = fmaxf(wave_max(am, lane), 1e-20f); const float inv = 127.f / am; if (lane == 0) SX[tok] = am * (1.f / 127.f);
#pragma unroll
                for (int j = 0; j < 2; ++j) { const int c0 = lane * 8 + 512 * j; const f32x4 x0 = v[h][j][0], x1 = v[h][j][1];
                    u32x4 w; w.x = pk2(x0.x, x0.y); w.y = pk2(x0.z, x0.w); w.z = pk2(x1.x, x1.y); w.w = pk2(x1.z, x1.w); *(u32x4*)(XB + (size_t)tok * DM + c0) = w;
                    u32x2 q; q.x = pk4_i8(x0.x, x0.y, x0.z, x0.w, inv); q.y = pk4_i8(x1.x, x1.y, x1.z, x1.w, inv); *(u32x2*)(XQ + (size_t)tok * DM + c0) = q; } } }
    }
}

constexpr int NPHASE = 2 + DEPTH * 7;
__global__ void __launch_bounds__(NTHR, 2) mk_fwd(Args a) {
    extern __shared__ __attribute__((aligned(16))) unsigned char smem[];
    LAS unsigned char* lds = (LAS unsigned char*)smem;
    const int tid = threadIdx.x, G = gridDim.x;
    const int wv = __builtin_amdgcn_readfirstlane(tid >> 6);
    for (int u = tid; u < MISC_BYTES / 4; u += NTHR) ((LAS unsigned*)(lds + MISC_OFF))[u] = 0u;
    __syncthreads();
#if MK_SINGLE
    (void)xcd_barrier_post((unsigned*)(a.ws + WS_CTL) + CW_BAR, (volatile LAS unsigned*)(lds + MISC_OFF), tid == 0);
#define GRID_BAR_T(FIRST) do { XcdBarrier bb; bb.bar = (unsigned*)(cargs()->ws + WS_CTL) + CW_BAR; bb.x = xb_xcc_id(); bb.st = (volatile LAS unsigned*)(lds + MISC_OFF); \
        xcd_barrier<FIRST>(bb, phase_tid(wv) == 0); } while (0)
#else
#define GRID_BAR_T(FIRST) do {} while (0)
#endif
    const int lo = a.ph_lo, hi = a.ph_hi;
#define IN(k) (lo <= (k) && (k) < hi)
#define SEAM(k) do { if (IN(k) && IN((k) + 1)) GRID_BAR_T(false); } while (0)
    if (PM(0) && IN(0)) { phase_convert(cargs(), lds, wv); }
    if (IN(0) && IN(1)) GRID_BAR_T(true);
    if (PM(0) && IN(1)) { phase_convert_b(cargs(), lds, wv); }
    SEAM(1);
    for (int Lc = 0; Lc < DEPTH; ++Lc) {
        int L = Lc; asm volatile("" : "+s"(L));
        int bid = blockIdx.x; asm volatile("" : "+s"(bid));
        const int pb = 2 + L * 7, i2 = L >> 1;
        if ((L & 1) == 0) {
            if (PM(1) && IN(pb + 0)) {
                CArgs ap = cargs(); unsigned char* ws = ap->ws;
                pg8::DenseSched<DM, 1> S{(const char*)(ws + WS_XQ), (const char*)(ws + WS_WEVIN) + (size_t)i2 * EVEN_IN * DM, NTOK / 256, EVEN_IN / 256, (NTOK / 256) * (EVEN_IN / 256), G, bid};
                EpiBiasBf16 E{(bf16*)(ws + WS_HB), EVEN_IN, ap->in[I_EVBIN] + (size_t)i2 * EVEN_IN, (const float*)(ws + WS_SX), (const float*)(ws + WS_SWEV) + (size_t)i2 * EVEN_IN};
                pg8::gemm_phase<DM, true, false, 2>(lds, S, E, (const LAS int*)(lds + TAB_OFF), wv);
            }
            SEAM(pb + 0);
            if (PM(2) && IN(pb + 1)) phase_even_mix(cargs(), lds, i2, wv);
            SEAM(pb + 1);
            if (PM(3) && IN(pb + 2)) {
                CArgs ap = cargs(); unsigned char* ws = ap->ws;
                pg8::DenseSched<DM> S{(const char*)(ws + WS_YB), (const char*)(ws + WS_WEVOUT) + (size_t)i2 * DM * DM * 2, NTOK / 256, DM / 256, (NTOK / 256) * (DM / 256), G, bid};
                EpiZ E{(bf16*)(ws + WS_Z), ap->in[I_EVBOUT] + (size_t)i2 * DM, (const bf16*)(ws + WS_XB), 1.f};
                pg8::gemm_phase<DM, true, false, 0>(lds, S, E, (const LAS int*)(lds + TAB_OFF), wv);
            }
            SEAM(pb + 2);
        } else {
            if (PM(4) && IN(pb + 0)) {
                CArgs ap = cargs(); unsigned char* ws = ap->ws;
                pg8::DenseSched<DM, 1> S{(const char*)(ws + WS_XQ), (const char*)(ws + WS_WODIN) + (size_t)i2 * 2 * SGU_W * DM, NTOK / 256, 2 * SGU_W / 256, (NTOK / 256) * (2 * SGU_W / 256), G, bid};
                EpiGeluStats E{(bf16*)(ws + WS_HB), ap->in[I_ODBIN] + (size_t)i2 * 2 * SGU_W, (float*)(ws + WS_STATS), (const float*)(ws + WS_SX), (const float*)(ws + WS_SWOD) + (size_t)i2 * 2 * SGU_W};
                pg8::gemm_phase<DM, true, false, 2>(lds, S, E, (const LAS int*)(lds + TAB_OFF), wv);
            }
            SEAM(pb + 0);
            if (PM(5) && IN(pb + 1)) phase_sgu(cargs(), lds, i2, wv);
            SEAM(pb + 1);
            if (PM(6) && IN(pb + 2)) {
                CArgs ap = cargs(); unsigned char* ws = ap->ws;
                pg8::DenseSched<SGU_W, 1> S{(const char*)(ws + WS_YB), (const char*)(ws + WS_WODOUT) + (size_t)i2 * DM * SGU_W, NTOK / 256, DM / 256, (NTOK / 256) * (DM / 256), G, bid};
                EpiZ E{(bf16*)(ws + WS_Z), ap->in[I_ODBOUT] + (size_t)i2 * DM, (const bf16*)(ws + WS_XB), 1.f / (QS_GATED * QS_WODOUT)};
                pg8::gemm_phase<SGU_W, true, false, 1>(lds, S, E, (const LAS int*)(lds + TAB_OFF), wv);
            }
            SEAM(pb + 2);
        }
        if (PM(7) && IN(pb + 3)) phase_ln_route(cargs(), lds, L, wv);
        SEAM(pb + 3);
        if (PM(8) && IN(pb + 4)) {
                CArgs ap = cargs(); unsigned char* ws = ap->ws;
            moe_tables<8, true>(ap, lds, L, wv, ap->in[I_BUP] + (size_t)L * NEXP * 2048);
            UpSched S{(const LAS int*)(lds + UT_OFF), (const char*)(ws + WS_X1B), (const char*)(ws + WS_WUP) + (size_t)L * NEXP * 2048 * DM};
            EpiUp E{(unsigned*)(ws + WS_CTL) + CW_UPC + L * UPC_STRIDE, ws + WS_HACT, (const LAS float*)(lds + BIAS_OFF)};
            pg8::gemm_phase<DM, true, true, FP6_UP ? 3 : 1>(lds, S, E, (const LAS int*)(lds + TAB_OFF), wv);
        }
#if !MK_SINGLE
        SEAM(pb + 4);
#endif
        if (PM(9) && IN(pb + 5)) {
                CArgs ap = cargs(); unsigned char* ws = ap->ws;
            moe_tables<4, false, true>(ap, lds, L, wv, ap->in[I_BDOWN] + (size_t)L * NEXP * DM);
            DownSched S{(const LAS int*)(lds + UT_OFF), (const char*)(ws + WS_HACT), (const char*)(ws + WS_WDOWN) + (size_t)L * NEXP * DM * DM, (const unsigned*)(ws + WS_CTL) + CW_UPC + L * UPC_STRIDE, wv == 0};
            EpiDown E{(bf16*)(ws + WS_YS), (const LAS float*)(lds + BIAS_OFF)};
            pg8::gemm_phase<DM, true, false, 1>(lds, S, E, (const LAS int*)(lds + TAB_OFF), wv);
        }
        SEAM(pb + 5);
        if (PM(10) && IN(pb + 6)) phase_combine(cargs(), lds, L, wv);
        SEAM(pb + 6);
    }
#undef IN
#undef SEAM
}

extern "C" void kernel_launch(void* const* d_in, const int* in_sizes, int n_in, void* d_out, int out_size, void* d_ws, size_t ws_size, hipStream_t stream) {
    static int grid = 0;
    if (grid == 0) {
        if (n_in != 28 || in_sizes[0] != NTOK * DM || out_size != NTOK * DM || ws_size < WS_END) { fprintf(stderr, "kernel_launch: unexpected shapes (n_in %d, ws %zu)\n", n_in, ws_size); grid = -1; return; }
        int dev = 0, cus = 0, per_cu = 0;
        if (hipGetDevice(&dev) != hipSuccess || hipDeviceGetAttribute(&cus, hipDeviceAttributeMultiprocessorCount, dev) != hipSuccess) { grid = -1; return; }
        if (hipFuncSetAttribute((const void*)mk_fwd, hipFuncAttributeMaxDynamicSharedMemorySize, LDS_BYTES) != hipSuccess) { fprintf(stderr, "kernel_launch: hipFuncSetAttribute failed\n"); grid = -1; return; }
        if (hipOccupancyMaxActiveBlocksPerMultiprocessor(&per_cu, (const void*)mk_fwd, NTHR, LDS_BYTES) != hipSuccess || per_cu < 1) { fprintf(stderr, "kernel_launch: occupancy query reports %d\n", per_cu); }
        (void)hipGetLastError();
        grid = cus - (cus % 8);
    }
    if (grid < 0) return;
    (void)hipMemsetAsync((char*)d_ws + WS_CTL, 0, CTL_ZERO_BYTES, stream);
    Args a{};
    for (int i = 0; i < 28; ++i) a.in[i] = (const float*)d_in[i];
    a.out = (float*)d_out; a.ws = (unsigned char*)d_ws;
#if MK_SINGLE
    a.ph_lo = 0; a.ph_hi = NPHASE;
    hipLaunchKernelGGL(mk_fwd, dim3(grid), dim3(NTHR), LDS_BYTES, stream, a);
#else
    for (int p = 0; p < NPHASE; ++p) { a.ph_lo = p; a.ph_hi = p + 1;
        int type = 0; if (p == 1) type = 11; else if (p > 1) { const int k = (p - 2) % 7, Lh = (p - 2) / 7; type = k < 3 ? ((Lh & 1) ? 4 + k : 1 + k) : 4 + k; }
        const int reps = ((PROBE_DUP_MASK >> type) & 1) ? 2 : 1;
        for (int r = 0; r < reps; ++r) hipLaunchKernelGGL(mk_fwd, dim3(grid), dim3(NTHR), LDS_BYTES, stream, a); }
#endif
}
```

```cpp
#include <hip/hip_runtime.h>
#include <cstdio>
#include <cstdint>

#ifndef PH_MASK
#define PH_MASK 0x7ff
#endif
#define PM(b) ((PH_MASK >> (b)) & 1)
#ifndef PROBE_DUP_MASK
#define PROBE_DUP_MASK 0
#endif
#ifndef FIXED_WIN_SCALE
#define FIXED_WIN_SCALE 1
#endif
#ifndef MK_SINGLE
#define MK_SINGLE 1
#endif

#define GAS __attribute__((address_space(1)))
#define LAS __attribute__((address_space(3)))
typedef unsigned short bf16;
typedef float f32x4 __attribute__((ext_vector_type(4)));
typedef float f32x2 __attribute__((ext_vector_type(2)));
typedef short bf16x8 __attribute__((ext_vector_type(8)));
typedef unsigned u32x4 __attribute__((ext_vector_type(4)));
typedef unsigned u32x2 __attribute__((ext_vector_type(2)));
typedef int v4i __attribute__((ext_vector_type(4)));
typedef int v8i __attribute__((ext_vector_type(8)));
typedef int v2i __attribute__((ext_vector_type(2)));
typedef unsigned v6u __attribute__((ext_vector_type(6)));
typedef unsigned v16u __attribute__((ext_vector_type(16)));
typedef __bf16 v32bf __attribute__((ext_vector_type(32)));

constexpr int NTOK = 16384, DM = 1024, SEQ = 2048, DEPTH = 4;
constexpr int EVEN_IN = 1536, SGU_W = 2048, NEXP = 32, TOPK = 4;
constexpr float DN_ALPHA = 1.681792830507429f;
constexpr float LN_EPS = 1e-5f;
#ifndef FP6_UP
#define FP6_UP 1
#endif
#define EMU_UP 0
#define EMU_DOWN 0
constexpr float QS_X1 = FP6_UP ? 1.75f : 8.f, QS_WUP = FP6_UP ? 60.f : 32.f, QS_ACT = EMU_DOWN ? 1.5f : 4.f, QS_WDOWN = EMU_DOWN ? 144.f : 64.f, QS_GATED = 8.f, QS_WODOUT = 64.f;
constexpr int NWAVES = 8, NTHR = 512;
constexpr int MAXU = 12;
constexpr int CAPROWS = 16384;
constexpr int HROWS = 65536 + 32 * 256;

constexpr size_t MiB = 1u << 20;
constexpr size_t WS_CTL = 0, CTL_ZERO_BYTES = 128 * 1024;
constexpr size_t WS_WEVIN = 1 * MiB, WS_WEVOUT = 7 * MiB, WS_WODIN = 11 * MiB, WS_WODOUT = 27 * MiB, WS_WPOOL = 35 * MiB, WS_WSGU = 36 * MiB, WS_RWH = 37 * MiB, WS_RWL = 38 * MiB;
constexpr size_t WS_WUP = 64 * MiB, WS_WDOWN = 576 * MiB;
constexpr size_t WS_XF = 832 * MiB, WS_XB = 896 * MiB, WS_HB = 928 * MiB, WS_YB = 1056 * MiB, WS_Z = 1120 * MiB, WS_X1F = 1184 * MiB, WS_X1B = 1248 * MiB;
constexpr size_t WS_XQ = WS_XF, WS_SX = WS_XF + 32 * MiB;
constexpr size_t WS_SWEV = WS_WEVIN + 4 * MiB, WS_SWOD = WS_WODIN + 12 * MiB;
constexpr size_t WS_STATS = 1280 * MiB, WS_EP = 1284 * MiB, WS_GATE = 1285 * MiB, WS_ROWTOK = 1286 * MiB, WS_HACT = 1288 * MiB, WS_YS = 1432 * MiB, WS_END = 1576 * MiB;
constexpr int CW_BAR = 4096;
constexpr int CW_CNT = 8192;
constexpr int CW_CMAX = CW_CNT + DEPTH * NEXP * 64;
constexpr int NCMAX = 2 * EVEN_IN + 2 * 2 * SGU_W;
constexpr int CW_UPC = 28672, UPC_STRIDE = 320;
static_assert(CW_UPC >= CW_CMAX + NCMAX && (CW_UPC + DEPTH * UPC_STRIDE) * 4 <= (int)CTL_ZERO_BYTES, "ctl upc");
static_assert((CW_CMAX + NCMAX) * 4 <= (int)CTL_ZERO_BYTES, "ctl");

constexpr int RING_BYTES = 131072;
constexpr int TAB_OFF = RING_BYTES, TAB_BYTES = MAXU * 256 * 4;
constexpr int UT_OFF = TAB_OFF + TAB_BYTES, UT_BYTES = MAXU * 16;
constexpr int BIAS_OFF = UT_OFF + 256, BIAS_BYTES = MAXU * 1024;
constexpr int MISC_OFF = BIAS_OFF + BIAS_BYTES, MISC_BYTES = 1024;
constexpr int LDS_BYTES = 157696;
static_assert(MISC_OFF + MISC_BYTES <= LDS_BYTES, "lds");

__device__ __forceinline__ unsigned f2bf(float f) { unsigned u = __builtin_bit_cast(unsigned, f); return (u + 0x7fffu + ((u >> 16) & 1u)) >> 16; }
__device__ __forceinline__ unsigned pk2(float lo, float hi) { unsigned r; asm("v_cvt_pk_bf16_f32 %0, %1, %2" : "=v"(r) : "v"(lo), "v"(hi)); return r; }
__device__ __forceinline__ float bflo(unsigned w) { return __builtin_bit_cast(float, w << 16); }
__device__ __forceinline__ float bfhi(unsigned w) { return __builtin_bit_cast(float, w & 0xffff0000u); }
__device__ __forceinline__ float bf2f(bf16 b) { return __builtin_bit_cast(float, (unsigned)b << 16); }
__device__ __forceinline__ float shx(float v, int m, int lane) { return __builtin_bit_cast(float, __builtin_amdgcn_ds_bpermute((lane ^ m) << 2, __builtin_bit_cast(int, v))); }
__device__ __forceinline__ float wave_sum(float v, int lane) {
#pragma unroll
    for (int o = 1; o < 64; o <<= 1) v += shx(v, o, lane);
    return v;
}
__device__ __forceinline__ float sigmoidf_(float x) { return __builtin_amdgcn_rcpf(1.0f + __builtin_amdgcn_exp2f(x * -1.44269504089f)); }
__device__ __forceinline__ int phase_tid(int wv) { unsigned z = 0u; asm volatile("" : "+v"(z));
    int t = (wv << 6) | (int)__builtin_amdgcn_mbcnt_hi(~0u, __builtin_amdgcn_mbcnt_lo(~0u, z)); asm volatile("" : "+v"(t)); return t; }
__device__ __forceinline__ float wave_max(float v, int lane) {
#pragma unroll
    for (int o = 1; o < 64; o <<= 1) v = fmaxf(v, shx(v, o, lane));
    return v;
}
__device__ __forceinline__ unsigned pk4_i8(float a, float b, float c, float d, float inv) {
    const int ia = (int)fminf(fmaxf(rintf(a * inv), -127.f), 127.f), ib = (int)fminf(fmaxf(rintf(b * inv), -127.f), 127.f);
    const int ic = (int)fminf(fmaxf(rintf(c * inv), -127.f), 127.f), id = (int)fminf(fmaxf(rintf(d * inv), -127.f), 127.f);
    return (unsigned)(ia & 0xff) | ((unsigned)(ib & 0xff) << 8) | ((unsigned)(ic & 0xff) << 16) | ((unsigned)id << 24);
}
#define LDS_WAIT() asm volatile("s_waitcnt lgkmcnt(0)" ::: "memory")

#define XB_TMO      128
#define XB_XCNT(j)  (256  + 64 * (j))
#define XB_XSUB(j)  (1280 + 64 * (j))
#define XB_XGEN(j)  (2304 + 64 * (j))
#define XB_TOP      3328
#define XB_TOPGEN   3392
#define XCD_BAR_WORDS 3456
#define XB_SPIN_CAP (1u << 18)
__device__ __forceinline__ unsigned xb_ld(unsigned* p)              { return __hip_atomic_load(p, __ATOMIC_RELAXED, __HIP_MEMORY_SCOPE_AGENT); }
__device__ __forceinline__ unsigned xb_add(unsigned* p, unsigned v) { return __hip_atomic_fetch_add(p, v, __ATOMIC_RELAXED, __HIP_MEMORY_SCOPE_AGENT); }
__device__ __forceinline__ unsigned xb_xcc_id() { return (unsigned)__builtin_amdgcn_s_getreg((3 << 11) | 20) & 0xFu; }
#define XB_SPIN(cond, bar) do { unsigned _sp = 0; while (cond) { __builtin_amdgcn_s_sleep(1); \
    if ((++_sp & 255u) == 0u) { if (xb_ld(&(bar)[XB_TMO])) break; if (_sp > XB_SPIN_CAP) { atomicAdd(&(bar)[XB_TMO], 1u); break; } } } } while (0)
struct XcdBarrier { unsigned* bar; unsigned x; volatile LAS unsigned* st; };
__device__ __forceinline__ XcdBarrier xcd_barrier_post(unsigned* bar, volatile LAS unsigned* st, bool t0) {
    XcdBarrier b; b.bar = bar; b.x = xb_xcc_id(); b.st = st;
    if (t0) (void)xb_add(&bar[XB_XCNT(b.x)], 1u);
    return b;
}
__device__ __forceinline__ void xcd_barrier_complete(unsigned* bar, unsigned x, unsigned& nloc, unsigned& nx) {
    const unsigned G = gridDim.x * gridDim.y * gridDim.z;
    unsigned sum, cnt, mine, sp = 0u;
    for (;;) {
        sum = 0u; cnt = 0u; mine = 0u;
#pragma unroll
        for (unsigned j = 0; j < 16; ++j) { const unsigned c = xb_ld(&bar[XB_XCNT(j)]); sum += c; cnt += (c > 0u) ? 1u : 0u; mine = (j == x) ? c : mine; }
        if (sum == G) break;
        __builtin_amdgcn_s_sleep(1);
        if ((++sp & 255u) == 0u) { if (xb_ld(&bar[XB_TMO])) break; if (sp > XB_SPIN_CAP) { atomicAdd(&bar[XB_TMO], 1u); break; } }
    }
    nloc = mine > 0u ? mine : 1u; nx = cnt > 0u ? cnt : 1u;
}
template <bool FIRST> __device__ __forceinline__ void xcd_barrier(const XcdBarrier& b, bool t0) {
    asm volatile("s_waitcnt vmcnt(0)" ::: "memory");
    __syncthreads();
    if (t0) {
        unsigned* bar = b.bar;
        __builtin_amdgcn_s_waitcnt(0);
        unsigned nloc = b.st[0], nx = b.st[1];
        if constexpr (FIRST) { if (nloc == 0u) { xcd_barrier_complete(bar, b.x, nloc, nx); b.st[0] = nloc; b.st[1] = nx; } }
        const unsigned old = xb_add(&bar[XB_XSUB(b.x)], 1u);
        const unsigned gen = old / nloc;
        if (old + 1u == (gen + 1u) * nloc) {
            __builtin_amdgcn_fence(__ATOMIC_RELEASE, "agent");
            asm volatile("s_waitcnt vmcnt(0)" ::: "memory");
            const unsigned og = xb_add(&bar[XB_TOP], 1u);
            const unsigned tg = og / nx;
            if (og + 1u == (tg + 1u) * nx) xb_add(&bar[XB_TOPGEN], 1u);
            else XB_SPIN(xb_ld(&bar[XB_TOPGEN]) == tg, bar);
            __builtin_amdgcn_fence(__ATOMIC_ACQUIRE, "agent");
            xb_add(&bar[XB_XGEN(b.x)], 1u);
            asm volatile("s_waitcnt vmcnt(0)" ::: "memory");
        } else {
            XB_SPIN(xb_ld(&bar[XB_XGEN(b.x)]) == gen, bar);
            __builtin_amdgcn_fence(__ATOMIC_ACQUIRE, "agent");
            asm volatile("s_waitcnt vmcnt(0)" ::: "memory");
        }
    }
    __syncthreads();
}

namespace pg8 {
constexpr int BM = 256, BK = 64, HALF = 128, HTB = HALF * BK * 2, NXCD = 8, WGM = 8;
__device__ __forceinline__ int lds_byte(int r, int c) { const int st = (r >> 4) * 2 + (c >> 5), rr = r & 15, cc = c & 31, ob = rr * 64 + cc * 2; return st * 1024 + (ob ^ (((ob >> 9) & 1) << 5)); }
__device__ __forceinline__ void stage_rc(int b, int& R, int& C) { const int st = b / 1024, sb = b % 1024, swz = sb ^ (((sb >> 9) & 1) << 5); R = (st >> 1) * 16 + swz / 64; C = (st & 1) * 32 + (swz % 64) / 2; }
__device__ __forceinline__ int perm32(int rho) { const int n = rho >> 4, i = rho & 15; return 8 * (i >> 2) + 4 * n + (i & 3); }

struct UnitD { const char* A; const char* B; int r0; int c0; int e; int ui; };

template <int K, bool PERM, bool GATHER, int MODE  , class Sched, class Epi>
__device__ __forceinline__ void gemm_phase(LAS unsigned char* lds, const Sched& S, const Epi& E, const LAS int* gtab, int wv) {
    int tid = phase_tid(wv);
    const int wid = __builtin_amdgcn_readfirstlane(tid >> 6), lane = tid & 63, wr = wid >> 2, wc = wid & 3, fr = lane & 15, fq = lane >> 4;
    constexpr bool F8 = (MODE != 0);
    constexpr int ES = F8 ? 1 : 2;
    constexpr int nt = K * ES / (BK * 2);
    constexpr size_t BH = Sched::BHALF;
    unsigned voffA[2], voffB[2]; unsigned aoffs[2][2];
#pragma unroll
    for (int i = 0; i < 2; ++i) { int R, C; stage_rc(tid * 16 + i * 8192, R, C); const int Rb = PERM ? ((R & ~31) + perm32(R & 31)) : R;
        voffA[i] = GATHER ? 0u : (unsigned)(R * K * ES + C * 2); voffB[i] = (unsigned)(Rb * K * ES + C * 2); aoffs[0][i] = 0u; aoffs[1][i] = 0u; }
    constexpr size_t kstep = (size_t)(BK * 2);
    constexpr size_t hstep = GATHER ? (size_t)0 : (size_t)HALF * K * ES;
    const unsigned ldsw = (unsigned)wid * 1024u;
    const int aoff = lds_byte(wr * 64 + fr, fq * 8), boff = lds_byte(wc * 32 + fr, fq * 8);
    const int hsel = (MODE == 3) ? 8 * ((fr >> 2) & 1) : 0;
#define PG8_SA(b, h) (((b) * 2 + (h)) * HTB)
#define PG8_SB(b, h) ((4 + (b) * 2 + (h)) * HTB)
#define PG8_STAGE_B(bufoff, gbase) do { _Pragma("unroll") for (int _i = 0; _i < 2; ++_i) { unsigned _o = voffB[_i]; asm volatile("" : "+v"(_o)); \
        __builtin_amdgcn_global_load_lds((const unsigned*)((const char*)(gbase) + _o), (LAS unsigned*)(lds + (bufoff) + ldsw + _i * 8192), 16, 0, 0); } } while (0)
#define PG8_STAGE_A(bufoff, gbase, h) do { _Pragma("unroll") for (int _i = 0; _i < 2; ++_i) { unsigned _o = (GATHER ? aoffs[h][_i] : voffA[_i]); asm volatile("" : "+v"(_o)); \
        __builtin_amdgcn_global_load_lds((const unsigned*)((const char*)(gbase) + _o), (LAS unsigned*)(lds + (bufoff) + ldsw + _i * 8192), 16, 0, 0); } } while (0)
#define PG8_GOFFS(u) do { if constexpr (GATHER) { _Pragma("unroll") for (int _i = 0; _i < 2; ++_i) { int _R, _C; stage_rc(tid * 16 + _i * 8192, _R, _C); \
        aoffs[0][_i] = (unsigned)gtab[(u) * 256 + _R] * (unsigned)(K * ES) + (unsigned)(_C * 2); aoffs[1][_i] = (unsigned)gtab[(u) * 256 + 128 + _R] * (unsigned)(K * ES) + (unsigned)(_C * 2); } } } while (0)
#define PG8_LDA(dst, b, h) do { _Pragma("unroll") for (int m = 0; m < 4; ++m) { if constexpr (MODE == 3) { const v4i _l = *(const LAS v4i*)(lds + PG8_SA(b, h) + aoff + m * 2048); const v2i _h = *(const volatile LAS v2i*)(lds + PG8_SA(b, h) + aoff + hsel + m * 2048 + 1024); \
            dst##8[m] = (v8i){_l.x, _l.y, _l.z, _l.w, _h.x, _h.y, 0, 0}; } \
        else if constexpr (F8) { dst##8[m].lo = *(const LAS v4i*)(lds + PG8_SA(b, h) + aoff + m * 2048); dst##8[m].hi = *(const LAS v4i*)(lds + PG8_SA(b, h) + aoff + m * 2048 + 1024); } \
        else { _Pragma("unroll") for (int k = 0; k < 2; ++k) dst[m][k] = *(const LAS bf16x8*)(lds + PG8_SA(b, h) + aoff + m * 2048 + k * 1024); } } } while (0)
#define PG8_LDB(dst, b, h) do { _Pragma("unroll") for (int n = 0; n < 2; ++n) { if constexpr (MODE == 3) { const v4i _l = *(const LAS v4i*)(lds + PG8_SB(b, h) + boff + n * 2048); const v2i _h = *(const volatile LAS v2i*)(lds + PG8_SB(b, h) + boff + hsel + n * 2048 + 1024); \
            dst##8[n] = (v8i){_l.x, _l.y, _l.z, _l.w, _h.x, _h.y, 0, 0}; } \
        else if constexpr (F8) { dst##8[n].lo = *(const LAS v4i*)(lds + PG8_SB(b, h) + boff + n * 2048); dst##8[n].hi = *(const LAS v4i*)(lds + PG8_SB(b, h) + boff + n * 2048 + 1024); } \
        else { _Pragma("unroll") for (int k = 0; k < 2; ++k) dst[n][k] = *(const LAS bf16x8*)(lds + PG8_SB(b, h) + boff + n * 2048 + k * 1024); } } } while (0)
#define PG8_MMA(ai, bj, At, Bt) do { __builtin_amdgcn_s_setprio(1); _Pragma("unroll") for (int m = 0; m < 4; ++m) _Pragma("unroll") for (int n = 0; n < 2; ++n) { \
        if constexpr (MODE == 1) acc[ai][bj][m][n] = __builtin_amdgcn_mfma_scale_f32_16x16x128_f8f6f4(Bt##8[n], At##8[m], acc[ai][bj][m][n], 0, 0, 0, 0, 0, 0); \
        else if constexpr (MODE == 3) acc[ai][bj][m][n] = __builtin_amdgcn_mfma_scale_f32_16x16x128_f8f6f4(Bt##8[n], At##8[m], acc[ai][bj][m][n], 2, 2, 0, 0, 0, 0); \
        else if constexpr (MODE == 2) { v4i _c = __builtin_bit_cast(v4i, acc[ai][bj][m][n]); _c = __builtin_amdgcn_mfma_i32_16x16x64_i8(Bt##8[n].lo, At##8[m].lo, _c, 0, 0, 0); \
            _c = __builtin_amdgcn_mfma_i32_16x16x64_i8(Bt##8[n].hi, At##8[m].hi, _c, 0, 0, 0); acc[ai][bj][m][n] = __builtin_bit_cast(f32x4, _c); } \
        else { _Pragma("unroll") for (int k = 0; k < 2; ++k) acc[ai][bj][m][n] = __builtin_amdgcn_mfma_f32_16x16x32_bf16(Bt[n][k], At[m][k], acc[ai][bj][m][n], 0, 0, 0); } } \
        __builtin_amdgcn_s_setprio(0); } while (0)
#define PG8_WAIT_V(n) asm volatile("s_waitcnt vmcnt(" #n ")" ::: "memory")
#define PG8_WAIT_L(n) asm volatile("s_waitcnt lgkmcnt(" #n ")" ::: "memory")
#define PG8_BAR __builtin_amdgcn_s_barrier()
#define PG8_SCHED __builtin_amdgcn_sched_barrier(0)
    UnitD cur, nxt; int ui = 0;
    if (!S.next(0, cur)) return;
    if constexpr (Sched::POLL) __syncthreads();
    int pmt = -1;
    f32x4 acc[2][2][4][2];
#pragma unroll
    for (int a = 0; a < 2; ++a)
#pragma unroll
        for (int b = 0; b < 2; ++b)
#pragma unroll
            for (int m = 0; m < 4; ++m)
#pragma unroll
                for (int n = 0; n < 2; ++n) acc[a][b][m][n] = (f32x4){0.f, 0.f, 0.f, 0.f};
    bf16x8 At[4][2], B0[2][2], B1[2][2]; v8i At8[4], B08[2], B18[2];
    const char* cA = cur.A; const char* cB = cur.B;
    PG8_GOFFS(0);
    PG8_STAGE_B(PG8_SB(0, 0), cB); PG8_STAGE_B(PG8_SB(0, 1), cB + BH); PG8_STAGE_A(PG8_SA(0, 0), cA, 0); PG8_STAGE_A(PG8_SA(0, 1), cA + hstep, 1);
    if (wr == 1) PG8_BAR;
    PG8_WAIT_V(2); PG8_BAR;
    PG8_STAGE_B(PG8_SB(1, 0), cB + kstep); PG8_STAGE_A(PG8_SA(1, 0), cA + kstep, 0); PG8_STAGE_B(PG8_SB(1, 1), cB + BH + kstep);
    PG8_WAIT_V(6); PG8_BAR;
    for (;;) {
        const bool has_next = S.next(ui + 1, nxt);
        const char* nA = has_next ? nxt.A : cA; const char* nB = has_next ? nxt.B : cB;
#pragma clang loop unroll(disable)
        for (int t = 0; t < nt; t += 2) {
            const bool last = (t == nt - 2);
            const char* a1 = cA + (size_t)(t + 1) * kstep;
            const char* a2 = last ? nA : cA + (size_t)(t + 2) * kstep;
            const char* b2 = last ? nB : cB + (size_t)(t + 2) * kstep;
            const char* a3 = a2 + kstep; const char* b3 = b2 + kstep;
            PG8_LDB(B0, 0, 0); PG8_LDB(B1, 0, 1); PG8_SCHED; PG8_LDA(At, 0, 0); PG8_STAGE_A(PG8_SA(1, 1), a1 + hstep, 1);
            PG8_WAIT_V(8); PG8_WAIT_L(0); PG8_BAR; PG8_MMA(0, 0, At, B0); PG8_MMA(0, 1, At, B1); PG8_BAR; PG8_SCHED;
            if (last && has_next) PG8_GOFFS(ui + 1);
            PG8_LDA(At, 0, 1); PG8_STAGE_B(PG8_SB(0, 0), b2); PG8_STAGE_B(PG8_SB(0, 1), b2 + BH); PG8_STAGE_A(PG8_SA(0, 0), a2, 0);
            PG8_WAIT_V(8); PG8_WAIT_L(0); PG8_BAR; PG8_MMA(1, 0, At, B0); PG8_MMA(1, 1, At, B1); PG8_BAR; PG8_SCHED;
            PG8_LDB(B0, 1, 0); PG8_LDB(B1, 1, 1); PG8_SCHED; PG8_LDA(At, 1, 0); PG8_STAGE_A(PG8_SA(0, 1), a2 + hstep, 1);
            PG8_WAIT_V(8); PG8_WAIT_L(0); PG8_BAR; PG8_MMA(0, 0, At, B0); PG8_MMA(0, 1, At, B1); PG8_BAR; PG8_SCHED;
            if constexpr (Epi::PUBLISH) {
                if (t == 0 && pmt >= 0) { int tp = tid; asm volatile("" : "+v"(tp)); if (tp == 0) E.publish(pmt); } }
            PG8_LDA(At, 1, 1); PG8_STAGE_B(PG8_SB(1, 0), b3); PG8_STAGE_B(PG8_SB(1, 1), b3 + BH); PG8_STAGE_A(PG8_SA(1, 0), a3, 0);
            PG8_WAIT_V(8); PG8_WAIT_L(0); PG8_BAR; PG8_MMA(1, 0, At, B0); PG8_MMA(1, 1, At, B1); PG8_BAR; PG8_SCHED;
        }
        if (wr == 0) PG8_BAR;
        { int tz = tid; asm volatile("" : "+v"(tz));
          const int wz = tz >> 6, lz = tz & 63; E(acc, cur, wz >> 2, wz & 3, lz & 15, lz >> 4); }
        if (!has_next) break;
#pragma unroll
        for (int a = 0; a < 2; ++a)
#pragma unroll
            for (int b = 0; b < 2; ++b)
#pragma unroll
                for (int m = 0; m < 4; ++m)
#pragma unroll
                    for (int n = 0; n < 2; ++n) acc[a][b][m][n] = (f32x4){0.f, 0.f, 0.f, 0.f};
        pmt = cur.r0 >> 8; cur = nxt; cA = nA; cB = nB; ++ui;
        if (wr == 1) PG8_BAR;
    }
    PG8_WAIT_V(0);
    PG8_BAR;
    if constexpr (Epi::PUBLISH) { int tp = tid; asm volatile("" : "+v"(tp)); if (tp == 0) E.publish(cur.r0 >> 8); }
#undef PG8_SA
#undef PG8_SB
#undef PG8_STAGE_A
#undef PG8_STAGE_B
#undef PG8_GOFFS
#undef PG8_LDA
#undef PG8_LDB
#undef PG8_MMA
#undef PG8_WAIT_V
#undef PG8_WAIT_L
#undef PG8_BAR
#undef PG8_SCHED
}

template <int K, int ES = 2> struct DenseSched {
    static constexpr size_t BHALF = (size_t)128 * K * ES, tstep = (size_t)256 * K * ES; static constexpr bool POLL = false;
    const char* A; const char* Bt; int nM, nN, nwg, G, c;
    __device__ __forceinline__ bool next(int i, UnitD& u) const {
        const long L = (long)i * G + c; if (L >= nwg) return false;
        int wgid = (int)L; { const int q = nwg / NXCD, r = nwg % NXCD, xcd = wgid % NXCD, off = wgid / NXCD; wgid = (xcd < r ? xcd * (q + 1) : r * (q + 1) + (xcd - r) * q) + off; }
        const int nig = WGM * nN, gid = wgid / nig, fm = gid * WGM, gsz = (nM - fm) < WGM ? (nM - fm) : WGM;
        const int pm = fm + ((wgid % nig) % gsz), pn = (wgid % nig) / gsz;
        u.A = A + (size_t)pm * tstep; u.B = Bt + (size_t)pn * tstep; u.r0 = pm * 256; u.c0 = pn * 256; u.e = 0; u.ui = i; return true;
    }
};
}

struct Args { const float* in[28]; float* out; unsigned char* ws; int ph_lo, ph_hi; };
typedef const __attribute__((address_space(4))) Args* CArgs;
__device__ __forceinline__ CArgs cargs() { CArgs p = (CArgs)__builtin_amdgcn_kernarg_segment_ptr(); asm volatile("" : "+s"(p)); return p; }
enum { I_X = 0, I_EVWIN, I_EVBIN, I_POOLW, I_POOLB, I_POOLS, I_CONVW, I_CONVB, I_CLNG, I_CLNB, I_EVWOUT, I_EVBOUT, I_ODWIN, I_ODBIN, I_SLNG, I_SLNB, I_SGUW, I_SGUB, I_ODWOUT, I_ODBOUT,
       I_RW, I_RB, I_WUP, I_BUP, I_WDOWN, I_BDOWN, I_LNG, I_LNB };

__device__ __forceinline__ void transpose_item(const float* W, int K, int N, bf16* WT, LAS float* scr, int item, int lane) {
    const int nblk = N / 32, kb = item / nblk, nb = item % nblk, k0 = 64 * kb, n0 = 32 * nb;
#pragma unroll 8
    for (int i = 0; i < 32; ++i) { const int kk = 2 * i + (lane >> 5); scr[kk * 33 + (lane & 31)] = W[(size_t)(k0 + kk) * N + n0 + (lane & 31)]; }
    LDS_WAIT(); asm volatile("" ::: "memory");
    const int c = lane & 7;
#pragma unroll
    for (int j = 0; j < 4; ++j) { const int n = (lane >> 3) + 8 * j; const LAS float* s = scr + (8 * c) * 33 + n;
        u32x4 o; o.x = pk2(s[0 * 33], s[1 * 33]); o.y = pk2(s[2 * 33], s[3 * 33]); o.z = pk2(s[4 * 33], s[5 * 33]); o.w = pk2(s[6 * 33], s[7 * 33]);
        *(u32x4*)(WT + (size_t)(n0 + n) * K + k0 + 8 * c) = o; }
    LDS_WAIT(); asm volatile("" ::: "memory");
}
__device__ __forceinline__ unsigned pk4_fp8(float a, float b, float c, float d) {
    a = fminf(fmaxf(a, -448.f), 448.f); b = fminf(fmaxf(b, -448.f), 448.f); c = fminf(fmaxf(c, -448.f), 448.f); d = fminf(fmaxf(d, -448.f), 448.f);
    int r = 0; r = __builtin_amdgcn_cvt_pk_fp8_f32(a, b, r, false); r = __builtin_amdgcn_cvt_pk_fp8_f32(c, d, r, true); return (unsigned)r;
}
template <bool EMU> __device__ __forceinline__ float e2m3q(float y) { if constexpr (EMU) { y = fminf(fmaxf(y, -7.5f), 7.5f); return fabsf(y) < 1.f ? rintf(y * 8.f) * 0.125f : y; } else return y; }
__device__ __forceinline__ void transpose_item8(const float* W, int K, int N, unsigned char* WT, LAS float* scr, int item, int lane, float qs) {
    const int nblk = N / 32, kb = item / nblk, nb = item % nblk, k0 = 64 * kb, n0 = 32 * nb;
#pragma unroll 8
    for (int i = 0; i < 32; ++i) { const int kk = 2 * i + (lane >> 5); scr[kk * 33 + (lane & 31)] = W[(size_t)(k0 + kk) * N + n0 + (lane & 31)] * qs; }
    LDS_WAIT(); asm volatile("" ::: "memory");
    const int c = lane & 7;
#pragma unroll
    for (int j = 0; j < 4; ++j) { const int n = (lane >> 3) + 8 * j; const LAS float* s = scr + (8 * c) * 33 + n;
        u32x2 o; o.x = pk4_fp8(s[0 * 33], s[1 * 33], s[2 * 33], s[3 * 33]); o.y = pk4_fp8(s[4 * 33], s[5 * 33], s[6 * 33], s[7 * 33]);
        *(u32x2*)(WT + (size_t)(n0 + n) * K + k0 + 8 * c) = o; }
    LDS_WAIT(); asm volatile("" ::: "memory");
}
__device__ __forceinline__ void conv_group8(const float* W, int K, int N, int nmat, unsigned char* WT, LAS float* scr, int gw, int NGW, int lane, float qs) {
    const int per = (K / 64) * (N / 32); const long total = (long)per * nmat;
    for (long it = gw; it < total; it += NGW) { const int mi = (int)(it / per), r = (int)(it % per);
        transpose_item8(W + (size_t)mi * K * N, K, N, WT + (size_t)mi * K * N, scr, r, lane, qs); }
}
__device__ __forceinline__ void conv_issue(const float* W, int K, int N, long it, long per, int nblk, LAS unsigned char* tile, int lane) {
    const int mi = (int)(it / per), r = (int)(it % per), nb = r % nblk, kb = r / nblk, k0 = kb * 128, n0 = nb * 32;
    const float* src = W + (size_t)mi * K * N + (size_t)(k0 + (lane >> 3)) * N + n0;
#pragma unroll
    for (int j = 0; j < 16; ++j)
        __builtin_amdgcn_global_load_lds((const unsigned*)(src + (size_t)(8 * j) * N + 4 * ((lane & 7) ^ (j >> 1))), (LAS unsigned*)(tile + j * 1024), 16, 0, 2);
}
template <bool EMU = false> __device__ __forceinline__ void conv_dma8(const float* W, int K, int N, int nmat, unsigned char* WT, LAS unsigned char* tile, int gw, int NGW, int lane, float qs) {
    const int nblk = N / 32; const long per = (long)(K / 128) * nblk, total = per * nmat;
    long it = gw;
    if (it < total) conv_issue(W, K, N, it, per, nblk, tile, lane);
    const int c = lane & 7, nn = lane >> 3;
#pragma unroll 1
    for (; it < total; it += NGW) {
        if (it == gw) asm volatile("s_waitcnt vmcnt(0)" ::: "memory");
        else asm volatile("s_waitcnt vmcnt(4)" ::: "memory");
        const int mi = (int)(it / per), r = (int)(it % per), nb = r % nblk, kb = r / nblk, k0 = kb * 128, n0 = nb * 32;
        float v[4][16];
#pragma unroll
        for (int jj = 0; jj < 4; ++jj) { const int n = nn + 8 * jj;
#pragma unroll
            for (int i = 0; i < 16; ++i) v[jj][i] = *(const LAS float*)(tile + (16 * c + i) * 128 + (((n >> 2) ^ c) * 16) + (n & 3) * 4); }
        asm volatile("s_waitcnt lgkmcnt(0)" ::: "memory");
        const long nx = it + NGW;
        if (nx < total) conv_issue(W, K, N, nx, per, nblk, tile, lane);
        unsigned char* dst = WT + (size_t)mi * K * N + (size_t)n0 * K + k0 + 16 * c;
#pragma unroll
        for (int jj = 0; jj < 4; ++jj) { const int n = nn + 8 * jj; u32x4 o;
#define QE(x) e2m3q<EMU>((x) * qs)
            o.x = pk4_fp8(QE(v[jj][0]), QE(v[jj][1]), QE(v[jj][2]), QE(v[jj][3])); o.y = pk4_fp8(QE(v[jj][4]), QE(v[jj][5]), QE(v[jj][6]), QE(v[jj][7]));
            o.z = pk4_fp8(QE(v[jj][8]), QE(v[jj][9]), QE(v[jj][10]), QE(v[jj][11])); o.w = pk4_fp8(QE(v[jj][12]), QE(v[jj][13]), QE(v[jj][14]), QE(v[jj][15]));
#undef QE
            __builtin_nontemporal_store(o, (u32x4*)(dst + (size_t)n * K)); }
        if (nx >= total) asm volatile("s_waitcnt vmcnt(0)" ::: "memory");
    }
}
__device__ __forceinline__ v6u pack32_fp6(const v16u w) { return __builtin_amdgcn_cvt_scalef32_pk32_fp6_bf16(__builtin_bit_cast(v32bf, w), 1.0f); }
__device__ __forceinline__ void xpose4(unsigned& r0, unsigned& r1, unsigned& r2, unsigned& r3) {
    u32x2 t;
    t = __builtin_amdgcn_permlane16_swap(r0, r1, false, false); r0 = t.x; r1 = t.y;
    t = __builtin_amdgcn_permlane16_swap(r2, r3, false, false); r2 = t.x; r3 = t.y;
    t = __builtin_amdgcn_permlane32_swap(r0, r2, false, false); r0 = t.x; r2 = t.y;
    t = __builtin_amdgcn_permlane32_swap(r1, r3, false, false); r1 = t.x; r3 = t.y;
}
__device__ __forceinline__ void conv_issue6(const float* W, int K, int N, long it, long per, int nblk, LAS unsigned char* tile, int lane) {
    const int mi = (int)(it / per), r = (int)(it % per), nb = r % nblk, kb = r / nblk, k0 = kb * 128, n0 = nb * 32;
    const float* src = W + (size_t)mi * K * N + (size_t)k0 * N + n0;
#pragma unroll
    for (int j = 0; j < 16; ++j)
        __builtin_amdgcn_global_load_lds((const unsigned*)(src + (size_t)(8 * j + ((lane >> 3) ^ (j >> 3))) * N + 4 * ((lane & 7) ^ (4 * ((j >> 2) & 1)))), (LAS unsigned*)(tile + j * 1024), 16, 0, 2);
}
__device__ __forceinline__ void conv_dma6(const float* W, int K, int N, int nmat, unsigned char* WT, LAS unsigned char* tile, int gw, int NGW, int lane, float qs) {
    const int nblk = N / 32; const long per = (long)(K / 128) * nblk, total = per * nmat;
    long it = gw;
    if (it < total) conv_issue6(W, K, N, it, per, nblk, tile, lane);
    const int c = lane & 3, nn = lane >> 2;
#pragma unroll 1
    for (; it < total; it += NGW) {
        if (it == gw) asm volatile("s_waitcnt vmcnt(0)" ::: "memory");
        else asm volatile("s_waitcnt vmcnt(4)" ::: "memory");
        const int mi = (int)(it / per), r = (int)(it % per), nb = r % nblk, kb = r / nblk, k0 = kb * 128, n0 = nb * 32;
        float v[2][32];
#pragma unroll
        for (int jj = 0; jj < 2; ++jj) { const int n = nn + 16 * jj;
#pragma unroll
            for (int i = 0; i < 32; ++i) v[jj][i] = *(const LAS float*)(tile + ((32 * c + i) ^ (c >> 1)) * 128 + (((n >> 2) ^ (4 * (c & 1))) * 16) + (n & 3) * 4); }
        asm volatile("s_waitcnt lgkmcnt(0)" ::: "memory");
        const long nx = it + NGW;
        if (nx < total) conv_issue6(W, K, N, nx, per, nblk, tile, lane);
        unsigned char* dst = WT + (size_t)mi * K * N + (size_t)n0 * K + k0 + 16 * c;
#pragma unroll
        for (int jj = 0; jj < 2; ++jj) { const int n = nn + 16 * jj; v16u w;
#pragma unroll
            for (int p = 0; p < 16; ++p) w[p] = pk2(v[jj][2 * p] * qs, v[jj][2 * p + 1] * qs);
            const v6u o = pack32_fp6(w);
            __builtin_nontemporal_store((u32x4){o[0], o[1], o[2], o[3]}, (u32x4*)(dst + (size_t)n * K));
            __builtin_nontemporal_store((u32x4){o[4], o[5], o[4], o[5]}, (u32x4*)(dst + (size_t)n * K + 64)); }
        if (nx >= total) asm volatile("s_waitcnt vmcnt(0)" ::: "memory");
    }
}
__device__ __forceinline__ void conv_group(const float* W, int K, int N, int nmat, bf16* WT, LAS float* scr, int gw, int NGW, int lane) {
    const int per = (K / 64) * (N / 32); const long total = (long)per * nmat;
    for (long it = gw; it < total; it += NGW) { const int mi = (int)(it / per), r = (int)(it % per);
        transpose_item(W + (size_t)mi * K * N, K, N, WT + (size_t)mi * K * N, scr, r, lane); }
}
__device__ __forceinline__ void phase_convert(CArgs a, LAS unsigned char* lds, int wv) {
    int tid = phase_tid(wv);
    const int lane = tid & 63, wave = __builtin_amdgcn_readfirstlane(tid >> 6), G = gridDim.x;
    LAS float* scr = (LAS float*)(lds + wave * 16384);
    const int gw = blockIdx.x * NWAVES + wave, NGW = G * NWAVES;
    unsigned char* ws = a->ws;
    conv_group(a->in[I_EVWOUT], DM, DM, 2, (bf16*)(ws + WS_WEVOUT), scr, gw, NGW, lane);
    conv_dma8(a->in[I_ODWOUT], SGU_W, DM, 2, ws + WS_WODOUT, lds + wave * 16384, gw, NGW, lane, QS_WODOUT);
    conv_group(a->in[I_POOLW], 128, 128, 8, (bf16*)(ws + WS_WPOOL), scr, gw, NGW, lane);
    if (FP6_UP) conv_dma6(a->in[I_WUP], DM, 2 * DM, DEPTH * NEXP, ws + WS_WUP, lds + wave * 16384, gw, NGW, lane, QS_WUP);
    else conv_dma8(a->in[I_WUP], DM, 2 * DM, DEPTH * NEXP, ws + WS_WUP, lds + wave * 16384, gw, NGW, lane, QS_WUP);
    conv_dma8<EMU_DOWN != 0>(a->in[I_WDOWN], DM, DM, DEPTH * NEXP, ws + WS_WDOWN, lds + wave * 16384, gw, NGW, lane, QS_WDOWN);
    const long gt = (long)blockIdx.x * NTHR + tid, GT = (long)G * NTHR;
    { bf16* rh = (bf16*)(ws + WS_RWH); bf16* rl = (bf16*)(ws + WS_RWL); const float* rw = a->in[I_RW];
      for (long i = gt; i < (long)DEPTH * DM * NEXP; i += GT) { const int L = (int)(i / (DM * NEXP)), r = (int)(i % (DM * NEXP)), e = r / DM, k = r % DM;
          const float w = rw[(size_t)L * DM * NEXP + (size_t)k * NEXP + e]; const unsigned h = f2bf(w); rh[i] = (bf16)h; rl[i] = (bf16)f2bf(w - bflo(h)); } }
    { bf16* o = (bf16*)(ws + WS_WSGU); const float* w = a->in[I_SGUW];
      for (long i = gt; i < 2L * 8 * 128 * 128; i += GT) { const int ii = (int)((i >> 7) & 127), jj = (int)(i & 127); const float v = ((ii >> 6) >= (jj >> 6)) ? w[i] : 0.f; o[i] = (bf16)f2bf(v); } }
    { const float* x = a->in[I_X]; bf16* XB = (bf16*)(ws + WS_XB); unsigned char* XQ = ws + WS_XQ; float* SX = (float*)(ws + WS_SX);
      for (int tok = gw; tok < NTOK; tok += NGW) { f32x4 v[2][2]; float am = 0.f;
#pragma unroll
          for (int j = 0; j < 2; ++j) { v[j][0] = *(const f32x4*)(x + (size_t)tok * DM + lane * 8 + 512 * j); v[j][1] = *(const f32x4*)(x + (size_t)tok * DM + lane * 8 + 512 * j + 4);
              const f32x4 a0 = __builtin_elementwise_abs(v[j][0]), a1 = __builtin_elementwise_abs(v[j][1]); am = fmaxf(am, fmaxf(fmaxf(fmaxf(a0.x, a0.y), fmaxf(a0.z, a0.w)), fmaxf(fmaxf(a1.x, a1.y), fmaxf(a1.z, a1.w)))); }
          am = fmaxf(wave_max(am, lane), 1e-20f); const float inv = 127.f / am; if (lane == 0) SX[tok] = am * (1.f / 127.f);
#pragma unroll
          for (int j = 0; j < 2; ++j) { const int c0 = lane * 8 + 512 * j;
              u32x4 w; w.x = pk2(v[j][0].x, v[j][0].y); w.y = pk2(v[j][0].z, v[j][0].w); w.z = pk2(v[j][1].x, v[j][1].y); w.w = pk2(v[j][1].z, v[j][1].w); *(u32x4*)(XB + (size_t)tok * DM + c0) = w;
              u32x2 q; q.x = pk4_i8(v[j][0].x, v[j][0].y, v[j][0].z, v[j][0].w, inv); q.y = pk4_i8(v[j][1].x, v[j][1].y, v[j][1].z, v[j][1].w, inv); *(u32x2*)(XQ + (size_t)tok * DM + c0) = q; } } }
    if (!FIXED_WIN_SCALE) { unsigned* cmax = (unsigned*)(ws + WS_CTL) + CW_CMAX;
      constexpr int IT_EV = 2 * 8 * (EVEN_IN / 64), IT_OD = 2 * 8 * (2 * SGU_W / 64);
      for (int it = gw; it < IT_EV + IT_OD; it += NGW) { const bool od = it >= IT_EV; const int r = od ? it - IT_EV : it, N = od ? 2 * SGU_W : EVEN_IN, nblk = N / 64;
          const int mat = r / (8 * nblk), r2 = r % (8 * nblk), kc = r2 / nblk, nb = r2 % nblk, n = nb * 64 + lane;
          const float* W = (od ? a->in[I_ODWIN] : a->in[I_EVWIN]) + (size_t)mat * DM * N + (size_t)(kc * 128) * N + n; float m = 0.f;
#pragma unroll 16
          for (int i = 0; i < 128; ++i) m = fmaxf(m, fabsf(W[(size_t)i * N]));
          __hip_atomic_fetch_max(cmax + (od ? 2 * EVEN_IN : 0) + mat * N + n, __builtin_bit_cast(unsigned, m), __ATOMIC_RELAXED, __HIP_MEMORY_SCOPE_AGENT); } }
}
__device__ __forceinline__ void transpose_item_i8(const float* W, int K, int N, unsigned char* WT, const unsigned* cmax, float* sw, LAS float* scr, int item, int lane) {
    const int nblk = N / 32, kb = item / nblk, nb = item % nblk, k0 = 64 * kb, n0 = 32 * nb;
#pragma unroll 8
    for (int i = 0; i < 32; ++i) { const int kk = 2 * i + (lane >> 5); scr[kk * 33 + (lane & 31)] = W[(size_t)(k0 + kk) * N + n0 + (lane & 31)]; }
    LDS_WAIT(); asm volatile("" ::: "memory");
    const int c = lane & 7;
#pragma unroll
    for (int j = 0; j < 4; ++j) { const int n = (lane >> 3) + 8 * j; const LAS float* s = scr + (8 * c) * 33 + n;
        const float am = FIXED_WIN_SCALE ? 0.15625f : fmaxf(__builtin_bit_cast(float, cmax[n0 + n]), 1e-20f), inv = 127.f / am;
        u32x2 o; o.x = pk4_i8(s[0 * 33], s[1 * 33], s[2 * 33], s[3 * 33], inv); o.y = pk4_i8(s[4 * 33], s[5 * 33], s[6 * 33], s[7 * 33], inv);
        *(u32x2*)(WT + (size_t)(n0 + n) * K + k0 + 8 * c) = o;
        if (k0 == 0 && c == 0) sw[n0 + n] = am * (1.f / 127.f); }
    LDS_WAIT(); asm volatile("" ::: "memory");
}
__device__ __forceinline__ void phase_convert_b(CArgs a, LAS unsigned char* lds, int wv) {
    const int tid = phase_tid(wv), lane = tid & 63, wave = __builtin_amdgcn_readfirstlane(tid >> 6), G = gridDim.x;
    LAS float* scr = (LAS float*)(lds + wave * 16384);
    const int gw = blockIdx.x * NWAVES + wave, NGW = G * NWAVES;
    unsigned char* ws = a->ws; const unsigned* cmax = (const unsigned*)(ws + WS_CTL) + CW_CMAX;
    constexpr int PER_EV = (DM / 64) * (EVEN_IN / 32), PER_OD = (DM / 64) * (2 * SGU_W / 32);
    for (int it = gw; it < 2 * PER_EV + 2 * PER_OD; it += NGW) {
        if (it < 2 * PER_EV) { const int mat = it / PER_EV, r = it % PER_EV;
            transpose_item_i8(a->in[I_EVWIN] + (size_t)mat * DM * EVEN_IN, DM, EVEN_IN, ws + WS_WEVIN + (size_t)mat * DM * EVEN_IN, cmax + mat * EVEN_IN, (float*)(ws + WS_SWEV) + mat * EVEN_IN, scr, r, lane); }
        else { const int it2 = it - 2 * PER_EV, mat = it2 / PER_OD, r = it2 % PER_OD;
            transpose_item_i8(a->in[I_ODWIN] + (size_t)mat * DM * 2 * SGU_W, DM, 2 * SGU_W, ws + WS_WODIN + (size_t)mat * DM * 2 * SGU_W, cmax + 2 * EVEN_IN + mat * 2 * SGU_W, (float*)(ws + WS_SWOD) + mat * 2 * SGU_W, scr, r, lane); }
    }
}

using pg8::UnitD;
struct EpiBiasBf16 {
    static constexpr bool PUBLISH = false;
    bf16* O; int ldc; const float* bias; const float* sx; const float* sw;
    __device__ __forceinline__ void operator()(const f32x4 (&acc)[2][2][4][2], const UnitD& u, int wr, int wc, int fr, int fq) const {
        const int row0 = u.r0 + wr * 64 + fr, col0 = u.c0 + wc * 32 + 8 * fq;
#pragma unroll
        for (int bj = 0; bj < 2; ++bj) { const f32x4 bv0 = *(const f32x4*)(bias + col0 + bj * 128), bv1 = *(const f32x4*)(bias + col0 + bj * 128 + 4);
            const f32x4 sw0 = *(const f32x4*)(sw + col0 + bj * 128), sw1 = *(const f32x4*)(sw + col0 + bj * 128 + 4);
#pragma unroll
            for (int ai = 0; ai < 2; ++ai)
#pragma unroll
                for (int m = 0; m < 4; ++m) { const int row = row0 + ai * 128 + m * 16; const float s = sx[row];
                    const v4i i0 = __builtin_bit_cast(v4i, acc[ai][bj][m][0]), i1 = __builtin_bit_cast(v4i, acc[ai][bj][m][1]);
                    const f32x4 v0 = __builtin_convertvector(i0, f32x4) * (sw0 * s) + bv0, v1 = __builtin_convertvector(i1, f32x4) * (sw1 * s) + bv1;
                    u32x4 w; w.x = pk2(v0[0], v0[1]); w.y = pk2(v0[2], v0[3]); w.z = pk2(v1[0], v1[1]); w.w = pk2(v1[2], v1[3]);
                    *(u32x4*)(O + (size_t)row * ldc + col0 + bj * 128) = w; } }
    }
};
__device__ __forceinline__ f32x2 gelu_pk(f32x2 v) {
    f32x2 vc; vc.x = __builtin_amdgcn_fmed3f(v.x, -4.25f, 4.25f); vc.y = __builtin_amdgcn_fmed3f(v.y, -4.25f, 4.25f);
    const f32x2 s = vc * vc;
    f32x2 q = s * (-2.562045892e-12f) + 2.732375520e-10f;
    q = q * s + (-1.309781371e-08f); q = q * s + 3.770278565e-07f; q = q * s + (-7.377925681e-06f); q = q * s + 1.056265650e-04f;
    q = q * s + (-1.158376687e-03f); q = q * s + 9.925602724e-03f; q = q * s + (-6.645352160e-02f); q = q * s + 3.989338899e-01f;
    return v * (vc * q + 0.5f);
}
struct EpiGeluStats {
    static constexpr bool PUBLISH = false;
    bf16* O; const float* bias; float* stats; const float* sx; const float* sw;
    __device__ __forceinline__ void operator()(const f32x4 (&acc)[2][2][4][2], const UnitD& u, int wr, int wc, int fr, int fq) const {
        const int row0 = u.r0 + wr * 64 + fr, col0 = u.c0 + wc * 32 + 8 * fq;
        const bool isv = u.c0 >= SGU_W; const int slot = ((u.c0 - SGU_W) >> 8) * 4 + wc;
        f32x4 bv[2][2], sv[2][2];
#pragma unroll
        for (int bj = 0; bj < 2; ++bj)
#pragma unroll
            for (int n = 0; n < 2; ++n) { bv[bj][n] = *(const f32x4*)(bias + col0 + bj * 128 + 4 * n); sv[bj][n] = *(const f32x4*)(sw + col0 + bj * 128 + 4 * n); }
#pragma unroll
        for (int ai = 0; ai < 2; ++ai)
#pragma unroll
            for (int m = 0; m < 4; ++m) { const int row = row0 + ai * 128 + m * 16; bf16* rowp = O + (size_t)row * (2 * SGU_W) + col0; float s = 0.f, q = 0.f; const float sr = sx[row];
#pragma unroll
                for (int bj = 0; bj < 2; ++bj) {
                    f32x4 v0 = __builtin_convertvector(__builtin_bit_cast(v4i, acc[ai][bj][m][0]), f32x4) * (sv[bj][0] * sr) + bv[bj][0];
                    f32x4 v1 = __builtin_convertvector(__builtin_bit_cast(v4i, acc[ai][bj][m][1]), f32x4) * (sv[bj][1] * sr) + bv[bj][1];
                    { const f32x2 ga = gelu_pk((f32x2){v0[0], v0[1]}), gb = gelu_pk((f32x2){v0[2], v0[3]}), gc = gelu_pk((f32x2){v1[0], v1[1]}), gd = gelu_pk((f32x2){v1[2], v1[3]});
                      v0 = (f32x4){ga.x, ga.y, gb.x, gb.y}; v1 = (f32x4){gc.x, gc.y, gd.x, gd.y}; }
#pragma unroll
                    for (int j = 0; j < 4; ++j) { s += v0[j] + v1[j]; q += v0[j] * v0[j] + v1[j] * v1[j]; }
                    u32x4 w; w.x = pk2(v0[0], v0[1]); w.y = pk2(v0[2], v0[3]); w.z = pk2(v1[0], v1[1]); w.w = pk2(v1[2], v1[3]);
                    *(u32x4*)(rowp + bj * 128) = w; }
                if (isv) { const int ln = fq * 16 + fr; s += shx(s, 16, ln); s += shx(s, 32, ln); q += shx(q, 16, ln); q += shx(q, 32, ln);
                    if (fq == 0) *(f32x2*)(stats + (size_t)row * 64 + slot * 2) = (f32x2){s, q}; } }
    }
};
struct EpiZ {
    static constexpr bool PUBLISH = false;
    bf16* Z; const float* bias; const bf16* X; float sc;
    __device__ __forceinline__ void operator()(const f32x4 (&acc)[2][2][4][2], const UnitD& u, int wr, int wc, int fr, int fq) const {
        const int row0 = u.r0 + wr * 64 + fr, col0 = u.c0 + wc * 32 + 8 * fq;
#pragma unroll
        for (int bj = 0; bj < 2; ++bj) { const f32x4 bv0 = *(const f32x4*)(bias + col0 + bj * 128), bv1 = *(const f32x4*)(bias + col0 + bj * 128 + 4);
#pragma unroll
            for (int ai = 0; ai < 2; ++ai)
#pragma unroll
                for (int m = 0; m < 4; ++m) { const size_t ro = (size_t)(row0 + ai * 128 + m * 16) * DM + col0 + bj * 128;
                    const u32x4 xr = *(const u32x4*)(X + ro);
                    const f32x4 v0 = acc[ai][bj][m][0] * sc + bv0 + DN_ALPHA * (f32x4){bflo(xr.x), bfhi(xr.x), bflo(xr.y), bfhi(xr.y)};
                    const f32x4 v1 = acc[ai][bj][m][1] * sc + bv1 + DN_ALPHA * (f32x4){bflo(xr.z), bfhi(xr.z), bflo(xr.w), bfhi(xr.w)};
                    u32x4 w; w.x = pk2(v0[0], v0[1]); w.y = pk2(v0[2], v0[3]); w.z = pk2(v1[0], v1[1]); w.w = pk2(v1[2], v1[3]);
                    *(u32x4*)(Z + ro) = w; } }
    }
};
struct EpiUp {
    static constexpr bool PUBLISH = true; unsigned* upc;
    __device__ __forceinline__ void publish(int mt) const { (void)__hip_atomic_fetch_add(upc + mt, 1u, __ATOMIC_RELAXED, __HIP_MEMORY_SCOPE_AGENT); }
    unsigned char* H; const LAS float* bl_lds;
    static __device__ __forceinline__ f32x2 act2(f32x2 g, f32x2 l) {
        g = __builtin_elementwise_min(g, (f32x2){7.f, 7.f}); l = __builtin_elementwise_min(__builtin_elementwise_max(l, (f32x2){-7.f, -7.f}), (f32x2){7.f, 7.f});
        const f32x2 t = g * (-1.702f * 1.44269504089f); f32x2 e; e.x = __builtin_amdgcn_exp2f(t.x); e.y = __builtin_amdgcn_exp2f(t.y);
        const f32x2 d = e + 1.0f; f32x2 r; r.x = __builtin_amdgcn_rcpf(d.x); r.y = __builtin_amdgcn_rcpf(d.y);
        return (g * r) * (l * QS_ACT + QS_ACT);
    }
    __device__ __forceinline__ void operator()(const f32x4 (&acc)[2][2][4][2], const UnitD& u, int wr, int wc, int fr, int fq) const {
        const int row0 = u.r0 + wr * 64 + fr, col0 = u.c0 + wc * 32 + 8 * fq;
        const LAS float* bg = bl_lds + u.ui * 256 + wc * 32 + 8 * fq; const LAS float* bl = bg + 128;
        f32x4 bgv[2], blv[2];
#pragma unroll
        for (int n = 0; n < 2; ++n) { bgv[n] = *(const LAS f32x4*)(bg + 4 * n); blv[n] = *(const LAS f32x4*)(bl + 4 * n); }
        constexpr float SC = 1.f / (QS_X1 * QS_WUP);
#pragma unroll
        for (int ai = 0; ai < 2; ++ai)
#pragma unroll
            for (int m = 0; m < 4; ++m) { unsigned char* rowp = H + (size_t)(row0 + ai * 128 + m * 16) * DM + col0; u32x2 w;
#pragma unroll
                for (int n = 0; n < 2; ++n) { const f32x4 g = acc[ai][0][m][n] * SC + bgv[n], l = acc[ai][1][m][n] * SC + blv[n];
                    const f32x2 o0 = act2((f32x2){g[0], g[1]}, (f32x2){l[0], l[1]}), o1 = act2((f32x2){g[2], g[3]}, (f32x2){l[2], l[3]});
                    int r = 0; r = __builtin_amdgcn_cvt_pk_fp8_f32(e2m3q<EMU_DOWN != 0>(o0.x), e2m3q<EMU_DOWN != 0>(o0.y), r, false); r = __builtin_amdgcn_cvt_pk_fp8_f32(e2m3q<EMU_DOWN != 0>(o1.x), e2m3q<EMU_DOWN != 0>(o1.y), r, true);
                    if (n == 0) w.x = (unsigned)r; else w.y = (unsigned)r; }
                __hip_atomic_store((unsigned long long*)rowp, ((unsigned long long)w.y << 32) | (unsigned long long)w.x, __ATOMIC_RELAXED, __HIP_MEMORY_SCOPE_AGENT); }
    }
};
struct EpiDown {
    static constexpr bool PUBLISH = false;
    bf16* Y; const LAS float* bl_lds;
    __device__ __forceinline__ void operator()(const f32x4 (&acc)[2][2][4][2], const UnitD& u, int wr, int wc, int fr, int fq) const {
        const int row0 = u.r0 + wr * 64 + fr, col0 = u.c0 + wc * 32 + 8 * fq;
        const LAS float* bias = bl_lds + u.ui * 256 + wc * 32 + 8 * fq;
#pragma unroll
        for (int bj = 0; bj < 2; ++bj) { const f32x4 bv0 = *(const LAS f32x4*)(bias + bj * 128), bv1 = *(const LAS f32x4*)(bias + bj * 128 + 4);
#pragma unroll
            for (int ai = 0; ai < 2; ++ai)
#pragma unroll
                for (int m = 0; m < 4; ++m) { bf16* rowp = Y + (size_t)(row0 + ai * 128 + m * 16) * DM + col0 + bj * 128;
                    const f32x4 v0 = acc[ai][bj][m][0] * (1.f / (QS_ACT * QS_WDOWN)) + bv0, v1 = acc[ai][bj][m][1] * (1.f / (QS_ACT * QS_WDOWN)) + bv1;
                    u32x4 w; w.x = pk2(v0[0], v0[1]); w.y = pk2(v0[2], v0[3]); w.z = pk2(v1[0], v1[1]); w.w = pk2(v1[2], v1[3]);
                    *(u32x4*)rowp = w; } }
    }
};

struct UpSched {
    static constexpr size_t BHALF = (size_t)1024 * DM; static constexpr bool POLL = false;
    const LAS int* ut; const char* X1B; const char* W;
    __device__ __forceinline__ bool next(int i, UnitD& u) const {
        if (i >= MAXU) return false;
        const int valid = __builtin_amdgcn_readfirstlane(ut[i * 4 + 3]); if (!valid) return false;
        const int e = __builtin_amdgcn_readfirstlane(ut[i * 4 + 0]), mt = __builtin_amdgcn_readfirstlane(ut[i * 4 + 1]), nt = __builtin_amdgcn_readfirstlane(ut[i * 4 + 2]);
        u.A = X1B; u.B = W + ((size_t)e * 2048 + nt * 128) * DM; u.r0 = mt * 256; u.c0 = nt * 128; u.e = e; u.ui = i; return true;
    }
};
struct DownSched {
    static constexpr size_t BHALF = (size_t)128 * DM; static constexpr bool POLL = true;
    const LAS int* ut; const char* H; const char* W; const unsigned* upc; bool w0;
    __device__ __forceinline__ void wait_tile(int mt) const {
        unsigned sp = 0;
        while (__builtin_amdgcn_readfirstlane(__hip_atomic_load(upc + mt, __ATOMIC_RELAXED, __HIP_MEMORY_SCOPE_AGENT)) < 8u) { __builtin_amdgcn_s_sleep(2); if (++sp > (1u << 22)) break; }
    }
    __device__ __forceinline__ bool next(int i, UnitD& u) const {
        if (i >= MAXU) return false;
        const int valid = __builtin_amdgcn_readfirstlane(ut[i * 4 + 3]); if (!valid) return false;
        const int e = __builtin_amdgcn_readfirstlane(ut[i * 4 + 0]), mt = __builtin_amdgcn_readfirstlane(ut[i * 4 + 1]), nt = __builtin_amdgcn_readfirstlane(ut[i * 4 + 2]);
        if (MK_SINGLE && w0) {
            if (i == 0) { wait_tile(mt);
#pragma unroll 1
                for (int j = 1; j < 4; ++j) if (__builtin_amdgcn_readfirstlane(ut[j * 4 + 3])) wait_tile(__builtin_amdgcn_readfirstlane(ut[j * 4 + 1]));
                __builtin_amdgcn_fence(__ATOMIC_ACQUIRE, "agent"); }
            else if (i >= 4) { wait_tile(mt); __builtin_amdgcn_fence(__ATOMIC_ACQUIRE, "agent"); }
        }
        u.A = H + (size_t)mt * 256 * DM; u.B = W + ((size_t)e * 1024 + nt * 256) * DM; u.r0 = mt * 256; u.c0 = nt * 256; u.e = e; u.ui = i; return true;
    }
};
template <int NTN, bool ROWS, bool REUSE = false>
__device__ __forceinline__ void moe_tables(CArgs a, LAS unsigned char* lds, int L, int wv, const float* bias  ) {
    int tid = phase_tid(wv);
    const int G = gridDim.x;
    LAS int* misc = (LAS int*)(lds + MISC_OFF);
    LAS int* ut = (LAS int*)(lds + UT_OFF);
    LAS int* tab = (LAS int*)(lds + TAB_OFF);
    const unsigned* cntw = (const unsigned*)(a->ws + WS_CTL) + CW_CNT + (size_t)L * NEXP * 64;
    __syncthreads();
    if (!(REUSE && MK_SINGLE)) {
        if (tid < 64) { const int ln = tid & 63; int c = 0; if (ln < NEXP) c = (int)__hip_atomic_load(cntw + ln * 64, __ATOMIC_RELAXED, __HIP_MEMORY_SCOPE_AGENT);
            const int n = (c + 255) >> 8; int s = n;
#pragma unroll
            for (int o = 1; o < 32; o <<= 1) { const int t = __builtin_amdgcn_ds_bpermute(((ln - o) & 63) << 2, s); if ((ln & 31) >= o) s += t; }
            if (ln < NEXP) { misc[64 + ln] = c; misc[16 + ln] = s - n; if (ln == NEXP - 1) misc[16 + NEXP] = s; } }
        __syncthreads();
    }
    if (tid < MAXU) {
        const int T = misc[16 + NEXP];
        const int x = blockIdx.x & 7, w = blockIdx.x >> 3, WPX = G >> 3, MPG = WPX / NTN;
        int mt = (tid * 8 + x) * MPG + w / NTN, nt = w % NTN;
        if (NTN == 4 && MK_SINGLE) {
            if (tid == 4) { const int j = (7 - x) * (G >> 3) + w; mt = 256 + (j >> 2); nt = j & 3; }
            else if (tid > 4) mt = 1 << 20; }
        int e = 0; for (int k = 1; k < NEXP; ++k) if (misc[16 + k] <= mt) e = k;
        const int valid = mt < T ? 1 : 0;
        ut[tid * 4 + 0] = e; ut[tid * 4 + 1] = mt; ut[tid * 4 + 2] = nt; ut[tid * 4 + 3] = valid;
    }
    __syncthreads();
    {
        LAS float* bl = (LAS float*)(lds + BIAS_OFF);
        for (int idx = tid; idx < MAXU * 256; idx += NTHR) { const int i = idx >> 8, s = idx & 255; float v = 0.f;
            if (ut[i * 4 + 3]) { const int e = ut[i * 4 + 0], nt = ut[i * 4 + 2];
                v = (NTN == 8) ? bias[(size_t)e * 2048 + (s < 128 ? nt * 128 + s : 1024 + nt * 128 + s - 128)] : bias[(size_t)e * DM + nt * 256 + s]; }
            bl[idx] = v; }
        if (!ROWS) __syncthreads();
    }
    if (ROWS) {
        const int* rowtok = (const int*)(a->ws + WS_ROWTOK);
        for (int idx = tid; idx < MAXU * 256; idx += NTHR) { const int i = idx >> 8, r = idx & 255;
            int tok = 0;
            if (ut[i * 4 + 3]) { const int e = ut[i * 4 + 0], row = (ut[i * 4 + 1] - misc[16 + e]) * 256 + r; if (row < misc[64 + e]) tok = rowtok[(size_t)e * CAPROWS + row]; }
            tab[idx] = tok; }
        __syncthreads();
    }
}

__device__ __forceinline__ void phase_even_mix(CArgs a, LAS unsigned char* lds, int i2, int wv) {
    int tid = phase_tid(wv);
    const int lane = tid & 63, wave = __builtin_amdgcn_readfirstlane(tid >> 6), G = gridDim.x;
    const bf16* HB = (const bf16*)(a->ws + WS_HB); bf16* YB = (bf16*)(a->ws + WS_YB);
    LAS bf16* glu = (LAS bf16*)lds;
    LAS float* ybuf = (LAS float*)(lds + 65536);
    constexpr int PLS = 520;
    LAS bf16* pl = (LAS bf16*)(lds + 65536);
    const int c = tid;
    const float* cw = a->in[I_CONVW] + (size_t)i2 * 31 * 512;
    for (int chunk = blockIdx.x; chunk < NTOK / 32; chunk += G) {
        const int b = chunk >> 6, t0 = (chunk & 63) * 32; const size_t tokbase = (size_t)chunk * 32;
#pragma unroll
        for (int it = 0; it < 8; ++it) { const int item = it * NTHR + tid, tt = item >> 6, cg = item & 63, p = t0 - 32 + tt;
            u32x4 o = (u32x4){0u, 0u, 0u, 0u};
            if (p >= 0) { const bf16* hp = HB + ((size_t)b * SEQ + p) * EVEN_IN + cg * 8; const u32x4 ra = *(const u32x4*)(hp + 512), rg = *(const u32x4*)(hp + 1024);
                o.x = pk2(bflo(ra.x) * sigmoidf_(bflo(rg.x)), bfhi(ra.x) * sigmoidf_(bfhi(rg.x))); o.y = pk2(bflo(ra.y) * sigmoidf_(bflo(rg.y)), bfhi(ra.y) * sigmoidf_(bfhi(rg.y)));
                o.z = pk2(bflo(ra.z) * sigmoidf_(bflo(rg.z)), bfhi(ra.z) * sigmoidf_(bfhi(rg.z))); o.w = pk2(bflo(ra.w) * sigmoidf_(bflo(rg.w)), bfhi(ra.w) * sigmoidf_(bfhi(rg.w))); }
            *(LAS u32x4*)(glu + tt * 512 + cg * 8) = o; }
        __syncthreads();
        {
            float w[31];
#pragma unroll
            for (int k = 0; k < 31; ++k) { unsigned off = (unsigned)c * 4u; asm volatile("" : "+v"(off)); w[k] = *(const float*)((const char*)(cw + k * 512) + off); }
            const float cb = a->in[I_CONVB][i2 * 512 + c];
            float win[34];
#pragma clang loop unroll(full)
            for (int r = 0; r < 64; ++r) {
                win[r % 34] = bf2f(glu[r * 512 + c]);
                if (r >= 32) { float y = cb;
#pragma unroll
                    for (int k = 0; k < 31; ++k) y += w[k] * win[(r - 30 + k) % 34];
                    ybuf[(r - 32) * 512 + c] = y; }
            }
        }
        __syncthreads();
#pragma unroll
        for (int it = 0; it < 6; ++it) { const int item = it * NTHR + tid, tt = item >> 6, cg = item & 63, p = t0 - 16 + tt;
            u32x4 o = (u32x4){0u, 0u, 0u, 0u};
            if (p >= 0) o = *(const u32x4*)(HB + ((size_t)b * SEQ + p) * EVEN_IN + cg * 8);
            *(LAS u32x4*)(glu + tt * 512 + cg * 8) = o; }
        {
            const float* lg = a->in[I_CLNG] + i2 * 512 + lane * 8; const float* lb = a->in[I_CLNB] + i2 * 512 + lane * 8;
            const f32x4 g0 = *(const f32x4*)lg, g1 = *(const f32x4*)(lg + 4), b0 = *(const f32x4*)lb, b1 = *(const f32x4*)(lb + 4);
#pragma unroll
            for (int tt = 0; tt < 4; ++tt) { const int t = wave * 4 + tt;
                f32x4 v0 = *(const LAS f32x4*)(ybuf + t * 512 + lane * 8), v1 = *(const LAS f32x4*)(ybuf + t * 512 + lane * 8 + 4);
                const float mean = wave_sum((v0.x + v0.y) + (v0.z + v0.w) + (v1.x + v1.y) + (v1.z + v1.w), lane) * (1.f / 512.f);
                v0 = v0 - mean; v1 = v1 - mean;
                const float var = wave_sum((v0.x * v0.x + v0.y * v0.y) + (v0.z * v0.z + v0.w * v0.w) + (v1.x * v1.x + v1.y * v1.y) + (v1.z * v1.z + v1.w * v1.w), lane) * (1.f / 512.f);
                const float rstd = 1.0f / sqrtf(var + LN_EPS);
                float o[8];
#pragma unroll
                for (int j = 0; j < 4; ++j) { const float x0 = v0[j] * rstd * g0[j] + b0[j], x1 = v1[j] * rstd * g1[j] + b1[j]; o[j] = x0 * sigmoidf_(x0); o[4 + j] = x1 * sigmoidf_(x1); }
                u32x4 wv4; wv4.x = pk2(o[0], o[1]); wv4.y = pk2(o[2], o[3]); wv4.z = pk2(o[4], o[5]); wv4.w = pk2(o[6], o[7]);
                *(u32x4*)(YB + (tokbase + t) * DM + 512 + lane * 8) = wv4; }
        }
        __syncthreads();
        {
            const int g = wave >> 1, winw = 2 << g;
            float pprev = 0.f, a2r[3] = {0.f, 0.f, 0.f}, a4r[5] = {0.f, 0.f, 0.f, 0.f, 0.f}, a8r[9] = {0.f, 0.f, 0.f, 0.f, 0.f, 0.f, 0.f, 0.f, 0.f};
#pragma clang loop unroll(full)
            for (int r = 0; r < 48; ++r) {
                const float p = bf2f(glu[r * 512 + c]);
                const float a2 = p + pprev, a4 = a2 + a2r[(r + 1) % 3], a8 = a4 + a4r[(r + 1) % 5], a16 = a8 + a8r[(r + 1) % 9];
                a2r[r % 3] = a2; a4r[r % 5] = a4; a8r[r % 9] = a8; pprev = p;
                if (r >= 16) { const float s = g == 0 ? a2 : (g == 1 ? a4 : (g == 2 ? a8 : a16));
                    const int pos = t0 + r - 16; const float cnt = (float)((pos + 1) < winw ? (pos + 1) : winw);
                    pl[(r - 16) * PLS + c] = (bf16)f2bf(s / cnt - p); }
            }
        }
        __syncthreads();
        {
            const int g = wave >> 1, nh = wave & 1, fr = lane & 15, fq = lane >> 4;
            const bf16* wp = (const bf16*)(a->ws + WS_WPOOL) + ((size_t)i2 * 4 + g) * 128 * 128;
            f32x4 acc[2][4];
#pragma unroll
            for (int m = 0; m < 2; ++m)
#pragma unroll
                for (int n = 0; n < 4; ++n) acc[m][n] = (f32x4){0.f, 0.f, 0.f, 0.f};
#pragma unroll
            for (int ks = 0; ks < 4; ++ks) {
                bf16x8 af[2], bfr[4];
#pragma unroll
                for (int m = 0; m < 2; ++m) af[m] = *(const LAS bf16x8*)(pl + (m * 16 + fr) * PLS + g * 128 + ks * 32 + fq * 8);
#pragma unroll
                for (int n = 0; n < 4; ++n) bfr[n] = *(const bf16x8*)(wp + (size_t)(nh * 64 + n * 16 + fr) * 128 + ks * 32 + fq * 8);
#pragma unroll
                for (int m = 0; m < 2; ++m)
#pragma unroll
                    for (int n = 0; n < 4; ++n) acc[m][n] = __builtin_amdgcn_mfma_f32_16x16x32_bf16(bfr[n], af[m], acc[m][n], 0, 0, 0);
            }
#pragma unroll
            for (int n = 0; n < 4; ++n) { const int d = nh * 64 + n * 16 + 4 * fq;
                const f32x4 pb = *(const f32x4*)(a->in[I_POOLB] + ((size_t)i2 * 4 + g) * 128 + d), ps = *(const f32x4*)(a->in[I_POOLS] + (size_t)i2 * 512 + g * 128 + d);
#pragma unroll
                for (int m = 0; m < 2; ++m) { const f32x4 v = (acc[m][n] + pb) * ps; u32x2 wv2; wv2.x = pk2(v.x, v.y); wv2.y = pk2(v.z, v.w);
                    *(u32x2*)(YB + (tokbase + m * 16 + fr) * DM + g * 128 + d) = wv2; } }
        }
        __syncthreads();
    }
}

__device__ __forceinline__ void phase_sgu(CArgs a, LAS unsigned char* lds, int i2, int wv) {
    int tid = phase_tid(wv);
    const int G = gridDim.x;
    const bf16* HB = (const bf16*)(a->ws + WS_HB); unsigned char* YQ = a->ws + WS_YB;
    const float* stats = (const float*)(a->ws + WS_STATS);
    constexpr int VS = 136;
    LAS bf16* vt = (LAS bf16*)lds;
    LAS float* mu = (LAS float*)(lds + 256 * VS * 2), *rs = mu + 128;
    LAS unsigned char* wl = lds + 73728;
    const float* lg = a->in[I_SLNG] + (size_t)i2 * SGU_W; const float* lb = a->in[I_SLNB] + (size_t)i2 * SGU_W;
    for (int u = blockIdx.x; u < (NTOK / 128) * 2; u += G) {
        const int chunk = u >> 1, h0 = (u & 1) * 4; const size_t tok0 = (size_t)chunk * 128;
        int tz = tid; asm volatile("" : "+v"(tz));
        const int lane = tz & 63, wave = __builtin_amdgcn_readfirstlane(tz >> 6), wr = wave >> 2, wc = wave & 3, fr = lane & 15, fq = lane >> 4;
        if (tz < 128) { const float* sp = stats + (tok0 + tz) * 64; float s = 0.f, q = 0.f;
#pragma unroll
            for (int k = 0; k < 16; ++k) { const f32x4 v = *(const f32x4*)(sp + 4 * k); s += v.x + v.z; q += v.y + v.w; }
            const float m = s * (1.f / SGU_W), var = fmaxf(q * (1.f / SGU_W) - m * m, 0.f);
            mu[tz] = m; rs[tz] = 1.0f / sqrtf(var + LN_EPS); }
        u32x4 vraw[8];
#pragma unroll
        for (int it = 0; it < 8; ++it) { const int j = 32 * (it & 3) + (lane & 31), c8 = 2 * (8 * (it >> 2) + wave) + (lane >> 5);
            vraw[it] = *(const u32x4*)(HB + (tok0 + j) * (2 * SGU_W) + SGU_W + h0 * 256 + c8 * 8); }
        __syncthreads();
#pragma unroll 1
        for (int hh = 0; hh < 4; ++hh) {
            const int h = h0 + hh;
            const bf16* wm = (const bf16*)(a->ws + WS_WSGU) + ((size_t)i2 * 8 + h) * 128 * 128;
#pragma unroll
            for (int q = 0; q < 4; ++q) { const int r = 4 * (8 * q + wave) + (lane >> 4);
                __builtin_amdgcn_global_load_lds((const unsigned*)(wm + (size_t)r * 128 + 8 * ((lane & 15) ^ (r & 15))), (LAS unsigned*)(wl + (8 * q + wave) * 1024), 16, 0, 0); }
            {
                const int cA = 2 * wave + (lane >> 5);
                f32x4 gg[2][2], bb[2][2];
#pragma unroll
                for (int q = 0; q < 2; ++q) { const float* gp = lg + h * 256 + (cA + 16 * q) * 8; const float* bp = lb + h * 256 + (cA + 16 * q) * 8;
                    gg[q][0] = *(const f32x4*)gp; gg[q][1] = *(const f32x4*)(gp + 4); bb[q][0] = *(const f32x4*)bp; bb[q][1] = *(const f32x4*)(bp + 4); }
#pragma unroll
                for (int it = 0; it < 8; ++it) { const int j = 32 * (it & 3) + (lane & 31), q = it >> 2, c8 = cA + 16 * q;
                    const float m = mu[j], r = rs[j]; const u32x4 raw = vraw[it];
                    const float v[8] = {bflo(raw.x), bfhi(raw.x), bflo(raw.y), bfhi(raw.y), bflo(raw.z), bfhi(raw.z), bflo(raw.w), bfhi(raw.w)};
#pragma unroll
                    for (int k = 0; k < 8; k += 2) { const unsigned pr = pk2((v[k] - m) * r * gg[q][k >> 2][k & 3] + bb[q][k >> 2][k & 3], (v[k + 1] - m) * r * gg[q][k >> 2][(k + 1) & 3] + bb[q][k >> 2][(k + 1) & 3]);
                        vt[(c8 * 8 + k) * VS + j] = (bf16)(pr & 0xffffu); vt[(c8 * 8 + k + 1) * VS + j] = (bf16)(pr >> 16); } }
            }
            if (hh < 3) {
#pragma unroll
                for (int it = 0; it < 8; ++it) { const int j = 32 * (it & 3) + (lane & 31), c8 = 2 * (8 * (it >> 2) + wave) + (lane >> 5);
                    vraw[it] = *(const u32x4*)(HB + (tok0 + j) * (2 * SGU_W) + SGU_W + (h + 1) * 256 + c8 * 8); } }
            asm volatile("s_waitcnt vmcnt(0)" ::: "memory");
            __syncthreads();
            f32x4 acc[4][4];
#pragma unroll
            for (int m = 0; m < 4; ++m)
#pragma unroll
                for (int n = 0; n < 4; ++n) acc[m][n] = (f32x4){0.f, 0.f, 0.f, 0.f};
#pragma unroll
            for (int ks = 0; ks < 4; ++ks) {
                bf16x8 bfr[4], af[4];
#pragma unroll
                for (int m = 0; m < 4; ++m) { const int i = wr * 64 + m * 16 + fr; af[m] = *(const LAS bf16x8*)(wl + i * 256 + (((ks * 4 + fq) ^ (i & 15)) * 16)); }
#pragma unroll
                for (int n = 0; n < 4; ++n) bfr[n] = *(const LAS bf16x8*)(vt + (wc * 64 + n * 16 + fr) * VS + ks * 32 + fq * 8);
#pragma unroll
                for (int m = 0; m < 4; ++m)
#pragma unroll
                    for (int n = 0; n < 4; ++n) acc[m][n] = __builtin_amdgcn_mfma_f32_16x16x32_bf16(bfr[n], af[m], acc[m][n], 0, 0, 0);
            }
            { int te = tz; asm volatile("" : "+v"(te));
              const int le = te & 63, we = te >> 6, wr = we >> 2, wc = we & 3, fr = le & 15, fq = le >> 4;
#pragma unroll
            for (int m = 0; m < 4; ++m) { const int i = wr * 64 + m * 16 + fr; const float bs = a->in[I_SGUB][((size_t)i2 * 8 + h) * 128 + i];
#pragma unroll
                for (int n = 0; n < 4; ++n) { const int cc = h * 256 + wc * 64 + n * 16 + 4 * fq;
                    const f32x4 sv = acc[m][n] + bs; const u32x2 uv = *(const u32x2*)(HB + (tok0 + i) * (2 * SGU_W) + cc);
                    *(unsigned*)(YQ + (tok0 + i) * SGU_W + cc) = pk4_fp8(bflo(uv.x) * sv.x * QS_GATED, bfhi(uv.x) * sv.y * QS_GATED, bflo(uv.y) * sv.z * QS_GATED, bfhi(uv.y) * sv.w * QS_GATED); } } }
            __syncthreads();
        }
    }
}

__device__ __forceinline__ void phase_ln_route(CArgs a, LAS unsigned char* lds, int L, int wv) {
    int tid = phase_tid(wv);
    const int lane = tid & 63, wave = __builtin_amdgcn_readfirstlane(tid >> 6), G = gridDim.x;
    const int fr = lane & 15, fq = lane >> 4, tg = wave & 1, kq = wave >> 1;
    const bf16* Z = (const bf16*)(a->ws + WS_Z); bf16* X1B = (bf16*)(a->ws + WS_X1F); unsigned char* X1Q = a->ws + WS_X1B;
    LAS float* red = (LAS float*)lds;
    LAS float* plg = (LAS float*)(lds + 4096);
    LAS float* lgt = (LAS float*)(lds + 4096 + 16384);
    LAS int* hist = (LAS int*)(lds + MISC_OFF + 512);
    const bf16* RWH = (const bf16*)(a->ws + WS_RWH) + (size_t)L * NEXP * DM; const bf16* RWL = (const bf16*)(a->ws + WS_RWL) + (size_t)L * NEXP * DM;
    const float* lng = a->in[I_LNG] + ((size_t)L * 2 + 0) * DM; const float* lnb = a->in[I_LNB] + ((size_t)L * 2 + 0) * DM;
    unsigned* cntw = (unsigned*)(a->ws + WS_CTL) + CW_CNT + (size_t)L * NEXP * 64;
    int* rowtok = (int*)(a->ws + WS_ROWTOK); int* EP = (int*)(a->ws + WS_EP); float* GATE = (float*)(a->ws + WS_GATE);
    for (int sc = blockIdx.x; sc < NTOK / 64; sc += G) {
        if (tid < 32) hist[tid] = 0;
#pragma unroll 1
      for (int half = 0; half < 2; ++half) { const int chunk = 2 * sc + half;
        const int tokl = tg * 16 + fr; const size_t tok = (size_t)chunk * 32 + tokl; const int kb = kq * 256 + fq * 8;
        f32x4 v[8][2]; float s = 0.f;
#pragma unroll
        for (int ks = 0; ks < 8; ++ks) { const u32x4 zr = *(const u32x4*)(Z + tok * DM + kb + ks * 32);
            v[ks][0] = (f32x4){bflo(zr.x), bfhi(zr.x), bflo(zr.y), bfhi(zr.y)}; v[ks][1] = (f32x4){bflo(zr.z), bfhi(zr.z), bflo(zr.w), bfhi(zr.w)};
            s += ((v[ks][0].x + v[ks][0].y) + (v[ks][0].z + v[ks][0].w)) + ((v[ks][1].x + v[ks][1].y) + (v[ks][1].z + v[ks][1].w)); }
        s += shx(s, 16, lane); s += shx(s, 32, lane);
        if (fq == 0) red[kq * 32 + tokl] = s;
        __syncthreads();
        const float mean = ((red[tokl] + red[32 + tokl]) + (red[64 + tokl] + red[96 + tokl])) * (1.f / DM); float q = 0.f;
#pragma unroll
        for (int ks = 0; ks < 8; ++ks) { v[ks][0] = v[ks][0] - mean; v[ks][1] = v[ks][1] - mean;
            q += ((v[ks][0].x * v[ks][0].x + v[ks][0].y * v[ks][0].y) + (v[ks][0].z * v[ks][0].z + v[ks][0].w * v[ks][0].w)) + ((v[ks][1].x * v[ks][1].x + v[ks][1].y * v[ks][1].y) + (v[ks][1].z * v[ks][1].z + v[ks][1].w * v[ks][1].w)); }
        q += shx(q, 16, lane); q += shx(q, 32, lane);
        if (fq == 0) red[128 + kq * 32 + tokl] = q;
        __syncthreads();
        const float rstd = 1.0f / sqrtf(((red[128 + tokl] + red[160 + tokl]) + (red[192 + tokl] + red[224 + tokl])) * (1.f / DM) + LN_EPS);
        f32x4 acc[2] = {(f32x4){0.f, 0.f, 0.f, 0.f}, (f32x4){0.f, 0.f, 0.f, 0.f}};
        unsigned sq[8][4];
#pragma unroll
        for (int ks = 0; ks < 8; ++ks) { const int k = kb + ks * 32;
            const f32x4 g0 = *(const f32x4*)(lng + k), g1 = *(const f32x4*)(lng + k + 4), b0 = *(const f32x4*)(lnb + k), b1 = *(const f32x4*)(lnb + k + 4);
            const f32x4 x0 = v[ks][0] * rstd * g0 + b0, x1 = v[ks][1] * rstd * g1 + b1;
            u32x4 hi; hi.x = pk2(x0.x, x0.y); hi.y = pk2(x0.z, x0.w); hi.z = pk2(x1.x, x1.y); hi.w = pk2(x1.z, x1.w);
            *(u32x4*)(X1B + tok * DM + k) = hi;
            if (FP6_UP) { sq[ks][0] = pk2(x0.x * QS_X1, x0.y * QS_X1); sq[ks][1] = pk2(x0.z * QS_X1, x0.w * QS_X1); sq[ks][2] = pk2(x1.x * QS_X1, x1.y * QS_X1); sq[ks][3] = pk2(x1.z * QS_X1, x1.w * QS_X1); }
            else { u32x2 q8; q8.x = pk4_fp8(x0.x * QS_X1, x0.y * QS_X1, x0.z * QS_X1, x0.w * QS_X1); q8.y = pk4_fp8(x1.x * QS_X1, x1.y * QS_X1, x1.z * QS_X1, x1.w * QS_X1); *(u32x2*)(X1Q + tok * DM + k) = q8; }
            u32x4 lo; lo.x = pk2(x0.x - bflo(hi.x), x0.y - bfhi(hi.x)); lo.y = pk2(x0.z - bflo(hi.y), x0.w - bfhi(hi.y)); lo.z = pk2(x1.x - bflo(hi.z), x1.y - bfhi(hi.z)); lo.w = pk2(x1.z - bflo(hi.w), x1.w - bfhi(hi.w));
            const bf16x8 ah = __builtin_bit_cast(bf16x8, hi), al = __builtin_bit_cast(bf16x8, lo);
#pragma unroll
            for (int nn = 0; nn < 2; ++nn) { const bf16x8 bh = *(const bf16x8*)(RWH + (size_t)(nn * 16 + fr) * DM + k), bl = *(const bf16x8*)(RWL + (size_t)(nn * 16 + fr) * DM + k);
                acc[nn] = __builtin_amdgcn_mfma_f32_16x16x32_bf16(ah, bh, acc[nn], 0, 0, 0);
                acc[nn] = __builtin_amdgcn_mfma_f32_16x16x32_bf16(ah, bl, acc[nn], 0, 0, 0);
                acc[nn] = __builtin_amdgcn_mfma_f32_16x16x32_bf16(al, bh, acc[nn], 0, 0, 0); } }
        if (FP6_UP) {
#pragma unroll
            for (int s2 = 0; s2 < 2; ++s2) {
#pragma unroll
                for (int d = 0; d < 4; ++d) xpose4(sq[4 * s2 + 0][d], sq[4 * s2 + 1][d], sq[4 * s2 + 2][d], sq[4 * s2 + 3][d]);
                v16u w;
#pragma unroll
                for (int j = 0; j < 4; ++j)
#pragma unroll
                    for (int d = 0; d < 4; ++d) w[4 * j + d] = sq[4 * s2 + j][d];
                const v6u o = pack32_fp6(w);
                unsigned char* dq = X1Q + tok * DM + (kq * 2 + s2) * 128 + 16 * fq;
                *(u32x4*)dq = (u32x4){o[0], o[1], o[2], o[3]}; *(u32x4*)(dq + 64) = (u32x4){o[4], o[5], o[4], o[5]}; }
        }
#pragma unroll
        for (int nn = 0; nn < 2; ++nn)
#pragma unroll
            for (int j = 0; j < 4; ++j) plg[(kq * 32 + tg * 16 + 4 * fq + j) * 32 + nn * 16 + fr] = acc[nn][j];
        __syncthreads();
#pragma unroll
        for (int i = 0; i < 2; ++i) { const int idx = tid + NTHR * i, t = idx >> 5, e = idx & 31; lgt[(half * 32 + t) * 33 + e] = ((plg[idx] + plg[1024 + idx]) + (plg[2048 + idx] + plg[3072 + idx])) + a->in[I_RB][L * NEXP + e]; }
        __syncthreads();
      }
        int se[4] = {0, 0, 0, 0}, sp[4] = {0, 0, 0, 0}; float sg[4] = {0.f, 0.f, 0.f, 0.f};
        if (tid < 64) {
            float sv[4], lg[NEXP];
#pragma unroll
            for (int e = 0; e < NEXP; ++e) lg[e] = lgt[tid * 33 + e];
#pragma unroll
            for (int k = 0; k < 4; ++k) { float best = lg[0]; int bi = 0;
#pragma unroll
                for (int e = 1; e < NEXP; ++e) { const bool ok = lg[e] > best; best = ok ? lg[e] : best; bi = ok ? e : bi; }
#pragma unroll
                for (int e = 0; e < NEXP; ++e) lg[e] = (e == bi) ? -3.0e38f : lg[e];
                se[k] = bi; sv[k] = best; }
            float den = 0.f;
#pragma unroll
            for (int k = 0; k < 4; ++k) { sg[k] = __expf(sv[k] - sv[0]); den += sg[k]; }
#pragma unroll
            for (int k = 0; k < 4; ++k) { sg[k] = sg[k] / den; sp[k] = __hip_atomic_fetch_add(&hist[se[k]], 1, __ATOMIC_RELAXED, __HIP_MEMORY_SCOPE_WORKGROUP); }
        }
        __syncthreads();
        if (tid < 32) hist[32 + tid] = (int)__hip_atomic_fetch_add(cntw + tid * 64, (unsigned)hist[tid], __ATOMIC_RELAXED, __HIP_MEMORY_SCOPE_AGENT);
        __syncthreads();
        if (tid < 64) { const int tk = sc * 64 + tid;
#pragma unroll
            for (int k = 0; k < 4; ++k) { const int pos = hist[32 + se[k]] + sp[k]; rowtok[(size_t)se[k] * CAPROWS + pos] = tk; EP[tk * 4 + k] = (se[k] << 16) | pos; GATE[tk * 4 + k] = sg[k]; } }
        __syncthreads();
    }
}

__device__ __forceinline__ void phase_combine(CArgs a, LAS unsigned char* lds, int L, int wv) {
    int tid = phase_tid(wv);
    const int lane = tid & 63, wave = __builtin_amdgcn_readfirstlane(tid >> 6), G = gridDim.x;
    LAS int* misc = (LAS int*)(lds + MISC_OFF);
    const unsigned* cntw = (const unsigned*)(a->ws + WS_CTL) + CW_CNT + (size_t)L * NEXP * 64;
    __syncthreads();
#if !MK_SINGLE
    if (tid < NEXP) misc[64 + tid] = (int)__hip_atomic_load(cntw + tid * 64, __ATOMIC_RELAXED, __HIP_MEMORY_SCOPE_AGENT);
    __syncthreads();
    if (tid == 0) { int acc = 0; for (int e = 0; e < NEXP; ++e) { misc[16 + e] = acc; acc += (misc[64 + e] + 255) >> 8; } }
    __syncthreads();
#endif
    const bf16* X1B = (const bf16*)(a->ws + WS_X1F); const bf16* YS = (const bf16*)(a->ws + WS_YS);
    const int* EP = (const int*)(a->ws + WS_EP); const float* GATE = (const float*)(a->ws + WS_GATE);
    float* OUT = a->out; bf16* XB = (bf16*)(a->ws + WS_XB); unsigned char* XQ = a->ws + WS_XQ; float* SX = (float*)(a->ws + WS_SX); const bool last = (L == DEPTH - 1);
    const float* lng = a->in[I_LNG] + ((size_t)L * 2 + 1) * DM; const float* lnb = a->in[I_LNB] + ((size_t)L * 2 + 1) * DM;
    for (int tk = blockIdx.x * NWAVES + wave; tk < NTOK / 2; tk += G * NWAVES) {
        f32x4 v[2][2][2]; int4 ep4[2]; f32x4 g4[2];
#pragma unroll
        for (int h = 0; h < 2; ++h) { const int tok = tk + h * (NTOK / 2); ep4[h] = *(const int4*)(EP + tok * 4); g4[h] = *(const f32x4*)(GATE + tok * 4);
#pragma unroll
            for (int j = 0; j < 2; ++j) { const u32x4 xr = *(const u32x4*)(X1B + (size_t)tok * DM + lane * 8 + 512 * j);
                v[h][j][0] = DN_ALPHA * (f32x4){bflo(xr.x), bfhi(xr.x), bflo(xr.y), bfhi(xr.y)}; v[h][j][1] = DN_ALPHA * (f32x4){bflo(xr.z), bfhi(xr.z), bflo(xr.w), bfhi(xr.w)}; } }
#pragma unroll
        for (int k = 0; k < 4; ++k)
#pragma unroll
            for (int h = 0; h < 2; ++h) { const int ep = k == 0 ? ep4[h].x : k == 1 ? ep4[h].y : k == 2 ? ep4[h].z : ep4[h].w; const float g = g4[h][k];
                const size_t row = (size_t)misc[16 + (ep >> 16)] * 256 + (ep & 0xffff);
#pragma unroll
                for (int j = 0; j < 2; ++j) { const u32x4 y = *(const u32x4*)(YS + row * DM + lane * 8 + 512 * j);
                    v[h][j][0] += g * (f32x4){bflo(y.x), bfhi(y.x), bflo(y.y), bfhi(y.y)}; v[h][j][1] += g * (f32x4){bflo(y.z), bfhi(y.z), bflo(y.w), bfhi(y.w)}; } }
#pragma unroll
        for (int h = 0; h < 2; ++h) { const int tok = tk + h * (NTOK / 2);
            float s = 0.f;
#pragma unroll
            for (int j = 0; j < 2; ++j) s += ((v[h][j][0].x + v[h][j][0].y) + (v[h][j][0].z + v[h][j][0].w)) + ((v[h][j][1].x + v[h][j][1].y) + (v[h][j][1].z + v[h][j][1].w));
            const float mean = wave_sum(s, lane) * (1.f / DM); float s2 = 0.f;
#pragma unroll
            for (int j = 0; j < 2; ++j) { v[h][j][0] = v[h][j][0] - mean; v[h][j][1] = v[h][j][1] - mean;
                s2 += ((v[h][j][0].x * v[h][j][0].x + v[h][j][0].y * v[h][j][0].y) + (v[h][j][0].z * v[h][j][0].z + v[h][j][0].w * v[h][j][0].w)) + ((v[h][j][1].x * v[h][j][1].x + v[h][j][1].y * v[h][j][1].y) + (v[h][j][1].z * v[h][j][1].z + v[h][j][1].w * v[h][j][1].w)); }
            const float rstd = 1.0f / sqrtf(wave_sum(s2, lane) * (1.f / DM) + LN_EPS);
            float am = 0.f;
#pragma unroll
            for (int j = 0; j < 2; ++j) { const int c0 = lane * 8 + 512 * j;
                v[h][j][0] = v[h][j][0] * rstd * *(const f32x4*)(lng + c0) + *(const f32x4*)(lnb + c0); v[h][j][1] = v[h][j][1] * rstd * *(const f32x4*)(lng + c0 + 4) + *(const f32x4*)(lnb + c0 + 4);
                const f32x4 a0 = __builtin_elementwise_abs(v[h][j][0]), a1 = __builtin_elementwise_abs(v[h][j][1]); am = fmaxf(am, fmaxf(fmaxf(fmaxf(a0.x, a0.y), fmaxf(a0.z, a0.w)), fmaxf(fmaxf(a1.x, a1.y), fmaxf(a1.z, a1.w)))); }
            if (last) {
#pragma unroll
                for (int j = 0; j < 2; ++j) { const int c0 = lane * 8 + 512 * j; *(f32x4*)(OUT + (size_t)tok * DM + c0) = v[h][j][0]; *(f32x4*)(OUT + (size_t)tok * DM + c0 + 4) = v[h][j][1]; } }
            else {
                am = fmaxf(wave_max(am, lane), 1e-20f); const float inv = 127.f / am; if (lane == 0) SX[tok] = am * (1.f / 127.f);
#pragma unroll
                for (int j = 0; j < 2; ++j) { const int c0 = lane * 8 + 512 * j; const f32x4 x0 = v[h][j][0], x1 = v[h][j][1];
                    u32x4 w; w.x = pk2(x0.x, x0.y); w.y = pk2(x0.z, x0.w); w.z = pk2(x1.x, x1.y); w.w = pk2(x1.z, x1.w); *(u32x4*)(XB + (size_t)tok * DM + c0) = w;
                    u32x2 q; q.x = pk4_i8(x0.x, x0.y, x0.z, x0.w, inv); q.y = pk4_i8(x1.x, x1.y, x1.z, x1.w, inv); *(u32x2*)(XQ + (size_t)tok * DM + c0) = q; } } }
    }
}

constexpr int NPHASE = 2 + DEPTH * 7;
__global__ void __launch_bounds__(NTHR, 2) mk_fwd(Args a) {
    extern __shared__ __attribute__((aligned(16))) unsigned char smem[];
    LAS unsigned char* lds = (LAS unsigned char*)smem;
    const int tid = threadIdx.x, G = gridDim.x;
    const int wv = __builtin_amdgcn_readfirstlane(tid >> 6);
    for (int u = tid; u < MISC_BYTES / 4; u += NTHR) ((LAS unsigned*)(lds + MISC_OFF))[u] = 0u;
    __syncthreads();
#if MK_SINGLE
    (void)xcd_barrier_post((unsigned*)(a.ws + WS_CTL) + CW_BAR, (volatile LAS unsigned*)(lds + MISC_OFF), tid == 0);
#define GRID_BAR_T(FIRST) do { XcdBarrier bb; bb.bar = (unsigned*)(cargs()->ws + WS_CTL) + CW_BAR; bb.x = xb_xcc_id(); bb.st = (volatile LAS unsigned*)(lds + MISC_OFF); \
        xcd_barrier<FIRST>(bb, phase_tid(wv) == 0); } while (0)
#else
#define GRID_BAR_T(FIRST) do {} while (0)
#endif
    const int lo = a.ph_lo, hi = a.ph_hi;
#define IN(k) (lo <= (k) && (k) < hi)
#define SEAM(k) do { if (IN(k) && IN((k) + 1)) GRID_BAR_T(false); } while (0)
#if FIXED_WIN_SCALE
    if (PM(0) && IN(0)) { phase_convert(cargs(), lds, wv); phase_convert_b(cargs(), lds, wv); }
    if (IN(0) && IN(2)) GRID_BAR_T(true);
#else
    if (PM(0) && IN(0)) { phase_convert(cargs(), lds, wv); }
    if (IN(0) && IN(1)) GRID_BAR_T(true);
    if (PM(0) && IN(1)) { phase_convert_b(cargs(), lds, wv); }
    SEAM(1);
#endif
    for (int Lc = 0; Lc < DEPTH; ++Lc) {
        int L = Lc; asm volatile("" : "+s"(L));
        int bid = blockIdx.x; asm volatile("" : "+s"(bid));
        const int pb = 2 + L * 7, i2 = L >> 1;
        if ((L & 1) == 0) {
            if (PM(1) && IN(pb + 0)) {
                CArgs ap = cargs(); unsigned char* ws = ap->ws;
                pg8::DenseSched<DM, 1> S{(const char*)(ws + WS_XQ), (const char*)(ws + WS_WEVIN) + (size_t)i2 * EVEN_IN * DM, NTOK / 256, EVEN_IN / 256, (NTOK / 256) * (EVEN_IN / 256), G, bid};
                EpiBiasBf16 E{(bf16*)(ws + WS_HB), EVEN_IN, ap->in[I_EVBIN] + (size_t)i2 * EVEN_IN, (const float*)(ws + WS_SX), (const float*)(ws + WS_SWEV) + (size_t)i2 * EVEN_IN};
                pg8::gemm_phase<DM, true, false, 2>(lds, S, E, (const LAS int*)(lds + TAB_OFF), wv);
            }
            SEAM(pb + 0);
            if (PM(2) && IN(pb + 1)) phase_even_mix(cargs(), lds, i2, wv);
            SEAM(pb + 1);
            if (PM(3) && IN(pb + 2)) {
                CArgs ap = cargs(); unsigned char* ws = ap->ws;
                pg8::DenseSched<DM> S{(const char*)(ws + WS_YB), (const char*)(ws + WS_WEVOUT) + (size_t)i2 * DM * DM * 2, NTOK / 256, DM / 256, (NTOK / 256) * (DM / 256), G, bid};
                EpiZ E{(bf16*)(ws + WS_Z), ap->in[I_EVBOUT] + (size_t)i2 * DM, (const bf16*)(ws + WS_XB), 1.f};
                pg8::gemm_phase<DM, true, false, 0>(lds, S, E, (const LAS int*)(lds + TAB_OFF), wv);
            }
            SEAM(pb + 2);
        } else {
            if (PM(4) && IN(pb + 0)) {
                CArgs ap = cargs(); unsigned char* ws = ap->ws;
                pg8::DenseSched<DM, 1> S{(const char*)(ws + WS_XQ), (const char*)(ws + WS_WODIN) + (size_t)i2 * 2 * SGU_W * DM, NTOK / 256, 2 * SGU_W / 256, (NTOK / 256) * (2 * SGU_W / 256), G, bid};
                EpiGeluStats E{(bf16*)(ws + WS_HB), ap->in[I_ODBIN] + (size_t)i2 * 2 * SGU_W, (float*)(ws + WS_STATS), (const float*)(ws + WS_SX), (const float*)(ws + WS_SWOD) + (size_t)i2 * 2 * SGU_W};
                pg8::gemm_phase<DM, true, false, 2>(lds, S, E, (const LAS int*)(lds + TAB_OFF), wv);
            }
            SEAM(pb + 0);
            if (PM(5) && IN(pb + 1)) phase_sgu(cargs(), lds, i2, wv);
            SEAM(pb + 1);
            if (PM(6) && IN(pb + 2)) {
                CArgs ap = cargs(); unsigned char* ws = ap->ws;
                pg8::DenseSched<SGU_W, 1> S{(const char*)(ws + WS_YB), (const char*)(ws + WS_WODOUT) + (size_t)i2 * DM * SGU_W, NTOK / 256, DM / 256, (NTOK / 256) * (DM / 256), G, bid};
                EpiZ E{(bf16*)(ws + WS_Z), ap->in[I_ODBOUT] + (size_t)i2 * DM, (const bf16*)(ws + WS_XB), 1.f / (QS_GATED * QS_WODOUT)};
                pg8::gemm_phase<SGU_W, true, false, 1>(lds, S, E, (const LAS int*)(lds + TAB_OFF), wv);
            }
            SEAM(pb + 2);
        }
        if (PM(7) && IN(pb + 3)) phase_ln_route(cargs(), lds, L, wv);
        SEAM(pb + 3);
        if (PM(8) && IN(pb + 4)) {
                CArgs ap = cargs(); unsigned char* ws = ap->ws;
            moe_tables<8, true>(ap, lds, L, wv, ap->in[I_BUP] + (size_t)L * NEXP * 2048);
            UpSched S{(const LAS int*)(lds + UT_OFF), (const char*)(ws + WS_X1B), (const char*)(ws + WS_WUP) + (size_t)L * NEXP * 2048 * DM};
            EpiUp E{(unsigned*)(ws + WS_CTL) + CW_UPC + L * UPC_STRIDE, ws + WS_HACT, (const LAS float*)(lds + BIAS_OFF)};
            pg8::gemm_phase<DM, true, true, FP6_UP ? 3 : 1>(lds, S, E, (const LAS int*)(lds + TAB_OFF), wv);
        }
#if !MK_SINGLE
        SEAM(pb + 4);
#endif
        if (PM(9) && IN(pb + 5)) {
                CArgs ap = cargs(); unsigned char* ws = ap->ws;
            moe_tables<4, false, true>(ap, lds, L, wv, ap->in[I_BDOWN] + (size_t)L * NEXP * DM);
            DownSched S{(const LAS int*)(lds + UT_OFF), (const char*)(ws + WS_HACT), (const char*)(ws + WS_WDOWN) + (size_t)L * NEXP * DM * DM, (const unsigned*)(ws + WS_CTL) + CW_UPC + L * UPC_STRIDE, wv == 0};
            EpiDown E{(bf16*)(ws + WS_YS), (const LAS float*)(lds + BIAS_OFF)};
            pg8::gemm_phase<DM, true, false, 1>(lds, S, E, (const LAS int*)(lds + TAB_OFF), wv);
        }
        SEAM(pb + 5);
        if (PM(10) && IN(pb + 6)) phase_combine(cargs(), lds, L, wv);
        SEAM(pb + 6);
    }
#undef IN
#undef SEAM
}

extern "C" void kernel_launch(void* const* d_in, const int* in_sizes, int n_in, void* d_out, int out_size, void* d_ws, size_t ws_size, hipStream_t stream) {
    static int grid = 0;
    if (grid == 0) {
        if (n_in != 28 || in_sizes[0] != NTOK * DM || out_size != NTOK * DM || ws_size < WS_END) { fprintf(stderr, "kernel_launch: unexpected shapes (n_in %d, ws %zu)\n", n_in, ws_size); grid = -1; return; }
        int dev = 0, cus = 0, per_cu = 0;
        if (hipGetDevice(&dev) != hipSuccess || hipDeviceGetAttribute(&cus, hipDeviceAttributeMultiprocessorCount, dev) != hipSuccess) { grid = -1; return; }
        if (hipFuncSetAttribute((const void*)mk_fwd, hipFuncAttributeMaxDynamicSharedMemorySize, LDS_BYTES) != hipSuccess) { fprintf(stderr, "kernel_launch: hipFuncSetAttribute failed\n"); grid = -1; return; }
        if (hipOccupancyMaxActiveBlocksPerMultiprocessor(&per_cu, (const void*)mk_fwd, NTHR, LDS_BYTES) != hipSuccess || per_cu < 1) { fprintf(stderr, "kernel_launch: occupancy query reports %d\n", per_cu); }
        (void)hipGetLastError();
        grid = cus - (cus % 8);
    }
    if (grid < 0) return;
    (void)hipMemsetAsync((char*)d_ws + WS_CTL, 0, CTL_ZERO_BYTES, stream);
    Args a{};
    for (int i = 0; i < 28; ++i) a.in[i] = (const float*)d_in[i];
    a.out = (float*)d_out; a.ws = (unsigned char*)d_ws;
#if MK_SINGLE
    a.ph_lo = 0; a.ph_hi = NPHASE;
    hipLaunchKernelGGL(mk_fwd, dim3(grid), dim3(NTHR), LDS_BYTES, stream, a);
#else
    for (int p = 0; p < NPHASE; ++p) { a.ph_lo = p; a.ph_hi = p + 1;
        int type = 0; if (p == 1) type = 11; else if (p > 1) { const int k = (p - 2) % 7, Lh = (p - 2) / 7; type = k < 3 ? ((Lh & 1) ? 4 + k : 1 + k) : 4 + k; }
        const int reps = ((PROBE_DUP_MASK >> type) & 1) ? 2 : 1;
        for (int r = 0; r < reps; ++r) hipLaunchKernelGGL(mk_fwd, dim3(grid), dim3(NTHR), LDS_BYTES, stream, a); }
#endif
}
```

```cpp
#include <hip/hip_runtime.h>
#include <cstdio>
#include <cstdint>

#ifndef PH_MASK
#define PH_MASK 0x7ff
#endif
#define PM(b) ((PH_MASK >> (b)) & 1)
#ifndef PROBE_DUP_MASK
#define PROBE_DUP_MASK 0
#endif
#ifndef FIXED_WIN_SCALE
#define FIXED_WIN_SCALE 1
#endif
#ifndef MK_SINGLE
#define MK_SINGLE 1
#endif

#define GAS __attribute__((address_space(1)))
#define LAS __attribute__((address_space(3)))
typedef unsigned short bf16;
typedef float f32x4 __attribute__((ext_vector_type(4)));
typedef float f32x2 __attribute__((ext_vector_type(2)));
typedef short bf16x8 __attribute__((ext_vector_type(8)));
typedef unsigned u32x4 __attribute__((ext_vector_type(4)));
typedef unsigned u32x2 __attribute__((ext_vector_type(2)));
typedef int v4i __attribute__((ext_vector_type(4)));
typedef int v8i __attribute__((ext_vector_type(8)));
typedef int v2i __attribute__((ext_vector_type(2)));
typedef unsigned v6u __attribute__((ext_vector_type(6)));
typedef unsigned v16u __attribute__((ext_vector_type(16)));
typedef __bf16 v32bf __attribute__((ext_vector_type(32)));

constexpr int NTOK = 16384, DM = 1024, SEQ = 2048, DEPTH = 4;
constexpr int EVEN_IN = 1536, SGU_W = 2048, NEXP = 32, TOPK = 4;
constexpr float DN_ALPHA = 1.681792830507429f;
constexpr float LN_EPS = 1e-5f;
#ifndef FP6_UP
#define FP6_UP 1
#endif
#define EMU_UP 0
#define EMU_DOWN 0
constexpr float QS_YS = 32.f;
constexpr float QS_X1 = FP6_UP ? 1.75f : 8.f, QS_WUP = FP6_UP ? 60.f : 32.f, QS_ACT = EMU_DOWN ? 1.5f : 4.f, QS_WDOWN = EMU_DOWN ? 144.f : 64.f, QS_GATED = 8.f, QS_WODOUT = 64.f;
constexpr int NWAVES = 8, NTHR = 512;
constexpr int MAXU = 12;
constexpr int CAPROWS = 16384;
constexpr int HROWS = 65536 + 32 * 256;

constexpr size_t MiB = 1u << 20;
constexpr size_t WS_CTL = 0, CTL_ZERO_BYTES = 128 * 1024;
constexpr size_t WS_WEVIN = 1 * MiB, WS_WEVOUT = 7 * MiB, WS_WODIN = 11 * MiB, WS_WODOUT = 27 * MiB, WS_WPOOL = 35 * MiB, WS_WSGU = 36 * MiB, WS_RWH = 37 * MiB, WS_RWL = 38 * MiB;
constexpr size_t WS_WUP = 64 * MiB, WS_WDOWN = 576 * MiB;
constexpr size_t WS_XF = 832 * MiB, WS_XB = 896 * MiB, WS_HB = 928 * MiB, WS_YB = 1056 * MiB, WS_Z = 1120 * MiB, WS_X1F = 1184 * MiB, WS_X1B = 1248 * MiB;
constexpr size_t WS_XQ = WS_XF, WS_SX = WS_XF + 32 * MiB;
constexpr size_t WS_SWEV = WS_WEVIN + 4 * MiB, WS_SWOD = WS_WODIN + 12 * MiB;
constexpr size_t WS_STATS = 1280 * MiB, WS_EP = 1284 * MiB, WS_GATE = 1285 * MiB, WS_ROWTOK = 1286 * MiB, WS_HACT = 1288 * MiB, WS_YS = 1432 * MiB, WS_END = 1576 * MiB;
constexpr int CW_BAR = 4096;
constexpr int CW_CNT = 8192;
constexpr int CW_CMAX = CW_CNT + DEPTH * NEXP * 64;
constexpr int NCMAX = 2 * EVEN_IN + 2 * 2 * SGU_W;
constexpr int CW_UPC = 28672, UPC_STRIDE = 320;
static_assert(CW_UPC >= CW_CMAX + NCMAX && (CW_UPC + DEPTH * UPC_STRIDE) * 4 <= (int)CTL_ZERO_BYTES, "ctl upc");
static_assert((CW_CMAX + NCMAX) * 4 <= (int)CTL_ZERO_BYTES, "ctl");

constexpr int RING_BYTES = 131072;
constexpr int TAB_OFF = RING_BYTES, TAB_BYTES = MAXU * 256 * 4;
constexpr int UT_OFF = TAB_OFF + TAB_BYTES, UT_BYTES = MAXU * 16;
constexpr int BIAS_OFF = UT_OFF + 256, BIAS_BYTES = MAXU * 1024;
constexpr int MISC_OFF = BIAS_OFF + BIAS_BYTES, MISC_BYTES = 1024;
constexpr int LDS_BYTES = 157696;
static_assert(MISC_OFF + MISC_BYTES <= LDS_BYTES, "lds");

__device__ __forceinline__ unsigned f2bf(float f) { unsigned u = __builtin_bit_cast(unsigned, f); return (u + 0x7fffu + ((u >> 16) & 1u)) >> 16; }
__device__ __forceinline__ unsigned pk2(float lo, float hi) { unsigned r; asm("v_cvt_pk_bf16_f32 %0, %1, %2" : "=v"(r) : "v"(lo), "v"(hi)); return r; }
__device__ __forceinline__ float bflo(unsigned w) { return __builtin_bit_cast(float, w << 16); }
__device__ __forceinline__ float bfhi(unsigned w) { return __builtin_bit_cast(float, w & 0xffff0000u); }
__device__ __forceinline__ float bf2f(bf16 b) { return __builtin_bit_cast(float, (unsigned)b << 16); }
__device__ __forceinline__ float shx(float v, int m, int lane) { return __builtin_bit_cast(float, __builtin_amdgcn_ds_bpermute((lane ^ m) << 2, __builtin_bit_cast(int, v))); }
__device__ __forceinline__ float wave_sum(float v, int lane) {
#pragma unroll
    for (int o = 1; o < 64; o <<= 1) v += shx(v, o, lane);
    return v;
}
__device__ __forceinline__ float sigmoidf_(float x) { return __builtin_amdgcn_rcpf(1.0f + __builtin_amdgcn_exp2f(x * -1.44269504089f)); }
__device__ __forceinline__ int phase_tid(int wv) { unsigned z = 0u; asm volatile("" : "+v"(z));
    int t = (wv << 6) | (int)__builtin_amdgcn_mbcnt_hi(~0u, __builtin_amdgcn_mbcnt_lo(~0u, z)); asm volatile("" : "+v"(t)); return t; }
__device__ __forceinline__ float wave_max(float v, int lane) {
#pragma unroll
    for (int o = 1; o < 64; o <<= 1) v = fmaxf(v, shx(v, o, lane));
    return v;
}
__device__ __forceinline__ unsigned pk4_i8(float a, float b, float c, float d, float inv) {
    const int ia = (int)fminf(fmaxf(rintf(a * inv), -127.f), 127.f), ib = (int)fminf(fmaxf(rintf(b * inv), -127.f), 127.f);
    const int ic = (int)fminf(fmaxf(rintf(c * inv), -127.f), 127.f), id = (int)fminf(fmaxf(rintf(d * inv), -127.f), 127.f);
    return (unsigned)(ia & 0xff) | ((unsigned)(ib & 0xff) << 8) | ((unsigned)(ic & 0xff) << 16) | ((unsigned)id << 24);
}
#define LDS_WAIT() asm volatile("s_waitcnt lgkmcnt(0)" ::: "memory")

#define XB_TMO      128
#define XB_XCNT(j)  (256  + 64 * (j))
#define XB_XSUB(j)  (1280 + 64 * (j))
#define XB_XGEN(j)  (2304 + 64 * (j))
#define XB_TOP      3328
#define XB_TOPGEN   3392
#define XCD_BAR_WORDS 3456
#define XB_SPIN_CAP (1u << 18)
__device__ __forceinline__ unsigned xb_ld(unsigned* p)              { return __hip_atomic_load(p, __ATOMIC_RELAXED, __HIP_MEMORY_SCOPE_AGENT); }
__device__ __forceinline__ unsigned xb_add(unsigned* p, unsigned v) { return __hip_atomic_fetch_add(p, v, __ATOMIC_RELAXED, __HIP_MEMORY_SCOPE_AGENT); }
__device__ __forceinline__ unsigned xb_xcc_id() { return (unsigned)__builtin_amdgcn_s_getreg((3 << 11) | 20) & 0xFu; }
#define XB_SPIN(cond, bar) do { unsigned _sp = 0; while (cond) { __builtin_amdgcn_s_sleep(1); \
    if ((++_sp & 255u) == 0u) { if (xb_ld(&(bar)[XB_TMO])) break; if (_sp > XB_SPIN_CAP) { atomicAdd(&(bar)[XB_TMO], 1u); break; } } } } while (0)
struct XcdBarrier { unsigned* bar; unsigned x; volatile LAS unsigned* st; };
__device__ __forceinline__ XcdBarrier xcd_barrier_post(unsigned* bar, volatile LAS unsigned* st, bool t0) {
    XcdBarrier b; b.bar = bar; b.x = xb_xcc_id(); b.st = st;
    if (t0) (void)xb_add(&bar[XB_XCNT(b.x)], 1u);
    return b;
}
__device__ __forceinline__ void xcd_barrier_complete(unsigned* bar, unsigned x, unsigned& nloc, unsigned& nx) {
    const unsigned G = gridDim.x * gridDim.y * gridDim.z;
    unsigned sum, cnt, mine, sp = 0u;
    for (;;) {
        sum = 0u; cnt = 0u; mine = 0u;
#pragma unroll
        for (unsigned j = 0; j < 16; ++j) { const unsigned c = xb_ld(&bar[XB_XCNT(j)]); sum += c; cnt += (c > 0u) ? 1u : 0u; mine = (j == x) ? c : mine; }
        if (sum == G) break;
        __builtin_amdgcn_s_sleep(1);
        if ((++sp & 255u) == 0u) { if (xb_ld(&bar[XB_TMO])) break; if (sp > XB_SPIN_CAP) { atomicAdd(&bar[XB_TMO], 1u); break; } }
    }
    nloc = mine > 0u ? mine : 1u; nx = cnt > 0u ? cnt : 1u;
}
template <bool FIRST> __device__ __forceinline__ void xcd_barrier(const XcdBarrier& b, bool t0) {
    asm volatile("s_waitcnt vmcnt(0)" ::: "memory");
    __syncthreads();
    if (t0) {
        unsigned* bar = b.bar;
        __builtin_amdgcn_s_waitcnt(0);
        unsigned nloc = b.st[0], nx = b.st[1];
        if constexpr (FIRST) { if (nloc == 0u) { xcd_barrier_complete(bar, b.x, nloc, nx); b.st[0] = nloc; b.st[1] = nx; } }
        const unsigned old = xb_add(&bar[XB_XSUB(b.x)], 1u);
        const unsigned gen = old / nloc;
        if (old + 1u == (gen + 1u) * nloc) {
            __builtin_amdgcn_fence(__ATOMIC_RELEASE, "agent");
            asm volatile("s_waitcnt vmcnt(0)" ::: "memory");
            const unsigned og = xb_add(&bar[XB_TOP], 1u);
            const unsigned tg = og / nx;
            if (og + 1u == (tg + 1u) * nx) xb_add(&bar[XB_TOPGEN], 1u);
            else XB_SPIN(xb_ld(&bar[XB_TOPGEN]) == tg, bar);
            __builtin_amdgcn_fence(__ATOMIC_ACQUIRE, "agent");
            xb_add(&bar[XB_XGEN(b.x)], 1u);
            asm volatile("s_waitcnt vmcnt(0)" ::: "memory");
        } else {
            XB_SPIN(xb_ld(&bar[XB_XGEN(b.x)]) == gen, bar);
            __builtin_amdgcn_fence(__ATOMIC_ACQUIRE, "agent");
            asm volatile("s_waitcnt vmcnt(0)" ::: "memory");
        }
    }
    __syncthreads();
}

namespace pg8 {
constexpr int BM = 256, BK = 64, HALF = 128, HTB = HALF * BK * 2, NXCD = 8, WGM = 8;
__device__ __forceinline__ int lds_byte(int r, int c) { const int st = (r >> 4) * 2 + (c >> 5), rr = r & 15, cc = c & 31, ob = rr * 64 + cc * 2; return st * 1024 + (ob ^ (((ob >> 9) & 1) << 5)); }
__device__ __forceinline__ void stage_rc(int b, int& R, int& C) { const int st = b / 1024, sb = b % 1024, swz = sb ^ (((sb >> 9) & 1) << 5); R = (st >> 1) * 16 + swz / 64; C = (st & 1) * 32 + (swz % 64) / 2; }
__device__ __forceinline__ int perm32(int rho) { const int n = rho >> 4, i = rho & 15; return 8 * (i >> 2) + 4 * n + (i & 3); }

struct UnitD { const char* A; const char* B; int r0; int c0; int e; int ui; };

template <int K, bool PERM, bool GATHER, int MODE  , class Sched, class Epi>
__device__ __forceinline__ void gemm_phase(LAS unsigned char* lds, const Sched& S, const Epi& E, const LAS int* gtab, int wv) {
    int tid = phase_tid(wv);
    const int wid = __builtin_amdgcn_readfirstlane(tid >> 6), lane = tid & 63, wr = wid >> 2, wc = wid & 3, fr = lane & 15, fq = lane >> 4;
    constexpr bool F8 = (MODE != 0);
    constexpr int ES = F8 ? 1 : 2;
    constexpr int nt = K * ES / (BK * 2);
    constexpr size_t BH = Sched::BHALF;
    unsigned voffA[2], voffB[2]; unsigned aoffs[2][2];
#pragma unroll
    for (int i = 0; i < 2; ++i) { int R, C; stage_rc(tid * 16 + i * 8192, R, C); const int Rb = PERM ? ((R & ~31) + perm32(R & 31)) : R;
        voffA[i] = GATHER ? 0u : (unsigned)(R * K * ES + C * 2); voffB[i] = (unsigned)(Rb * K * ES + C * 2); aoffs[0][i] = 0u; aoffs[1][i] = 0u; }
    constexpr size_t kstep = (size_t)(BK * 2);
    constexpr size_t hstep = GATHER ? (size_t)0 : (size_t)HALF * K * ES;
    const unsigned ldsw = (unsigned)wid * 1024u;
    const int aoff = lds_byte(wr * 64 + fr, fq * 8), boff = lds_byte(wc * 32 + fr, fq * 8);
    const int hsel = (MODE == 3) ? 8 * ((fr >> 2) & 1) : 0;
#define PG8_SA(b, h) (((b) * 2 + (h)) * HTB)
#define PG8_SB(b, h) ((4 + (b) * 2 + (h)) * HTB)
#define PG8_STAGE_B(bufoff, gbase) do { _Pragma("unroll") for (int _i = 0; _i < 2; ++_i) { unsigned _o = voffB[_i]; asm volatile("" : "+v"(_o)); \
        __builtin_amdgcn_global_load_lds((const unsigned*)((const char*)(gbase) + _o), (LAS unsigned*)(lds + (bufoff) + ldsw + _i * 8192), 16, 0, 0); } } while (0)
#define PG8_STAGE_A(bufoff, gbase, h) do { _Pragma("unroll") for (int _i = 0; _i < 2; ++_i) { unsigned _o = (GATHER ? aoffs[h][_i] : voffA[_i]); asm volatile("" : "+v"(_o)); \
        __builtin_amdgcn_global_load_lds((const unsigned*)((const char*)(gbase) + _o), (LAS unsigned*)(lds + (bufoff) + ldsw + _i * 8192), 16, 0, 0); } } while (0)
#define PG8_GOFFS(u) do { if constexpr (GATHER) { _Pragma("unroll") for (int _i = 0; _i < 2; ++_i) { int _R, _C; stage_rc(tid * 16 + _i * 8192, _R, _C); \
        aoffs[0][_i] = (unsigned)gtab[(u) * 256 + _R] * (unsigned)(K * ES) + (unsigned)(_C * 2); aoffs[1][_i] = (unsigned)gtab[(u) * 256 + 128 + _R] * (unsigned)(K * ES) + (unsigned)(_C * 2); } } } while (0)
#define PG8_LDA(dst, b, h) do { _Pragma("unroll") for (int m = 0; m < 4; ++m) { if constexpr (MODE == 3) { const v4i _l = *(const LAS v4i*)(lds + PG8_SA(b, h) + aoff + m * 2048); const v2i _h = *(const volatile LAS v2i*)(lds + PG8_SA(b, h) + aoff + hsel + m * 2048 + 1024); \
            dst##8[m] = (v8i){_l.x, _l.y, _l.z, _l.w, _h.x, _h.y, 0, 0}; } \
        else if constexpr (F8) { dst##8[m].lo = *(const LAS v4i*)(lds + PG8_SA(b, h) + aoff + m * 2048); dst##8[m].hi = *(const LAS v4i*)(lds + PG8_SA(b, h) + aoff + m * 2048 + 1024); } \
        else { _Pragma("unroll") for (int k = 0; k < 2; ++k) dst[m][k] = *(const LAS bf16x8*)(lds + PG8_SA(b, h) + aoff + m * 2048 + k * 1024); } } } while (0)
#define PG8_LDB(dst, b, h) do { _Pragma("unroll") for (int n = 0; n < 2; ++n) { if constexpr (MODE == 3) { const v4i _l = *(const LAS v4i*)(lds + PG8_SB(b, h) + boff + n * 2048); const v2i _h = *(const volatile LAS v2i*)(lds + PG8_SB(b, h) + boff + hsel + n * 2048 + 1024); \
            dst##8[n] = (v8i){_l.x, _l.y, _l.z, _l.w, _h.x, _h.y, 0, 0}; } \
        else if constexpr (F8) { dst##8[n].lo = *(const LAS v4i*)(lds + PG8_SB(b, h) + boff + n * 2048); dst##8[n].hi = *(const LAS v4i*)(lds + PG8_SB(b, h) + boff + n * 2048 + 1024); } \
        else { _Pragma("unroll") for (int k = 0; k < 2; ++k) dst[n][k] = *(const LAS bf16x8*)(lds + PG8_SB(b, h) + boff + n * 2048 + k * 1024); } } } while (0)
#define PG8_MMA(ai, bj, At, Bt) do { __builtin_amdgcn_s_setprio(1); _Pragma("unroll") for (int m = 0; m < 4; ++m) _Pragma("unroll") for (int n = 0; n < 2; ++n) { \
        if constexpr (MODE == 1) acc[ai][bj][m][n] = __builtin_amdgcn_mfma_scale_f32_16x16x128_f8f6f4(Bt##8[n], At##8[m], acc[ai][bj][m][n], 0, 0, 0, 0, 0, 0); \
        else if constexpr (MODE == 3) acc[ai][bj][m][n] = __builtin_amdgcn_mfma_scale_f32_16x16x128_f8f6f4(Bt##8[n], At##8[m], acc[ai][bj][m][n], 2, 2, 0, 0, 0, 0); \
        else if constexpr (MODE == 2) { v4i _c = __builtin_bit_cast(v4i, acc[ai][bj][m][n]); _c = __builtin_amdgcn_mfma_i32_16x16x64_i8(Bt##8[n].lo, At##8[m].lo, _c, 0, 0, 0); \
            _c = __builtin_amdgcn_mfma_i32_16x16x64_i8(Bt##8[n].hi, At##8[m].hi, _c, 0, 0, 0); acc[ai][bj][m][n] = __builtin_bit_cast(f32x4, _c); } \
        else { _Pragma("unroll") for (int k = 0; k < 2; ++k) acc[ai][bj][m][n] = __builtin_amdgcn_mfma_f32_16x16x32_bf16(Bt[n][k], At[m][k], acc[ai][bj][m][n], 0, 0, 0); } } \
        __builtin_amdgcn_s_setprio(0); } while (0)
#define PG8_WAIT_V(n) asm volatile("s_waitcnt vmcnt(" #n ")" ::: "memory")
#define PG8_WAIT_L(n) asm volatile("s_waitcnt lgkmcnt(" #n ")" ::: "memory")
#define PG8_BAR __builtin_amdgcn_s_barrier()
#define PG8_SCHED __builtin_amdgcn_sched_barrier(0)
    UnitD cur, nxt; int ui = 0;
    if (!S.next(0, cur)) return;
    if constexpr (Sched::POLL) __syncthreads();
    int pmt = -1;
    f32x4 acc[2][2][4][2];
#pragma unroll
    for (int a = 0; a < 2; ++a)
#pragma unroll
        for (int b = 0; b < 2; ++b)
#pragma unroll
            for (int m = 0; m < 4; ++m)
#pragma unroll
                for (int n = 0; n < 2; ++n) acc[a][b][m][n] = (f32x4){0.f, 0.f, 0.f, 0.f};
    bf16x8 At[4][2], B0[2][2], B1[2][2]; v8i At8[4], B08[2], B18[2];
    const char* cA = cur.A; const char* cB = cur.B;
    PG8_GOFFS(0);
    PG8_STAGE_B(PG8_SB(0, 0), cB); PG8_STAGE_B(PG8_SB(0, 1), cB + BH); PG8_STAGE_A(PG8_SA(0, 0), cA, 0); PG8_STAGE_A(PG8_SA(0, 1), cA + hstep, 1);
    if (wr == 1) PG8_BAR;
    PG8_WAIT_V(2); PG8_BAR;
    PG8_STAGE_B(PG8_SB(1, 0), cB + kstep); PG8_STAGE_A(PG8_SA(1, 0), cA + kstep, 0); PG8_STAGE_B(PG8_SB(1, 1), cB + BH + kstep);
    PG8_WAIT_V(6); PG8_BAR;
    for (;;) {
        const bool has_next = S.next(ui + 1, nxt);
        const char* nA = has_next ? nxt.A : cA; const char* nB = has_next ? nxt.B : cB;
#pragma clang loop unroll(disable)
        for (int t = 0; t < nt; t += 2) {
            const bool last = (t == nt - 2);
            const char* a1 = cA + (size_t)(t + 1) * kstep;
            const char* a2 = last ? nA : cA + (size_t)(t + 2) * kstep;
            const char* b2 = last ? nB : cB + (size_t)(t + 2) * kstep;
            const char* a3 = a2 + kstep; const char* b3 = b2 + kstep;
            PG8_LDB(B0, 0, 0); PG8_LDB(B1, 0, 1); PG8_SCHED; PG8_LDA(At, 0, 0); PG8_STAGE_A(PG8_SA(1, 1), a1 + hstep, 1);
            PG8_WAIT_V(8); PG8_WAIT_L(0); PG8_BAR; PG8_MMA(0, 0, At, B0); PG8_MMA(0, 1, At, B1); PG8_BAR; PG8_SCHED;
            if (last && has_next) PG8_GOFFS(ui + 1);
            PG8_LDA(At, 0, 1); PG8_STAGE_B(PG8_SB(0, 0), b2); PG8_STAGE_B(PG8_SB(0, 1), b2 + BH); PG8_STAGE_A(PG8_SA(0, 0), a2, 0);
            PG8_WAIT_V(8); PG8_WAIT_L(0); PG8_BAR; PG8_MMA(1, 0, At, B0); PG8_MMA(1, 1, At, B1); PG8_BAR; PG8_SCHED;
            PG8_LDB(B0, 1, 0); PG8_LDB(B1, 1, 1); PG8_SCHED; PG8_LDA(At, 1, 0); PG8_STAGE_A(PG8_SA(0, 1), a2 + hstep, 1);
            PG8_WAIT_V(8); PG8_WAIT_L(0); PG8_BAR; PG8_MMA(0, 0, At, B0); PG8_MMA(0, 1, At, B1); PG8_BAR; PG8_SCHED;
            if constexpr (Epi::PUBLISH) {
                if (t == 0 && pmt >= 0) { int tp = tid; asm volatile("" : "+v"(tp)); if (tp == 0) E.publish(pmt); } }
            PG8_LDA(At, 1, 1); PG8_STAGE_B(PG8_SB(1, 0), b3); PG8_STAGE_B(PG8_SB(1, 1), b3 + BH); PG8_STAGE_A(PG8_SA(1, 0), a3, 0);
            PG8_WAIT_V(8); PG8_WAIT_L(0); PG8_BAR; PG8_MMA(1, 0, At, B0); PG8_MMA(1, 1, At, B1); PG8_BAR; PG8_SCHED;
        }
        if (wr == 0) PG8_BAR;
        { int tz = tid; asm volatile("" : "+v"(tz));
          const int wz = tz >> 6, lz = tz & 63; E(acc, cur, wz >> 2, wz & 3, lz & 15, lz >> 4); }
        if (!has_next) break;
#pragma unroll
        for (int a = 0; a < 2; ++a)
#pragma unroll
            for (int b = 0; b < 2; ++b)
#pragma unroll
                for (int m = 0; m < 4; ++m)
#pragma unroll
                    for (int n = 0; n < 2; ++n) acc[a][b][m][n] = (f32x4){0.f, 0.f, 0.f, 0.f};
        pmt = cur.r0 >> 8; cur = nxt; cA = nA; cB = nB; ++ui;
        if (wr == 1) PG8_BAR;
    }
    PG8_WAIT_V(0);
    PG8_BAR;
    if constexpr (Epi::PUBLISH) { int tp = tid; asm volatile("" : "+v"(tp)); if (tp == 0) E.publish(cur.r0 >> 8); }
#undef PG8_SA
#undef PG8_SB
#undef PG8_STAGE_A
#undef PG8_STAGE_B
#undef PG8_GOFFS
#undef PG8_LDA
#undef PG8_LDB
#undef PG8_MMA
#undef PG8_WAIT_V
#undef PG8_WAIT_L
#undef PG8_BAR
#undef PG8_SCHED
}

template <int K, int ES = 2> struct DenseSched {
    static constexpr size_t BHALF = (size_t)128 * K * ES, tstep = (size_t)256 * K * ES; static constexpr bool POLL = false;
    const char* A; const char* Bt; int nM, nN, nwg, G, c;
    __device__ __forceinline__ bool next(int i, UnitD& u) const {
        const long L = (long)i * G + c; if (L >= nwg) return false;
        int wgid = (int)L; { const int q = nwg / NXCD, r = nwg % NXCD, xcd = wgid % NXCD, off = wgid / NXCD; wgid = (xcd < r ? xcd * (q + 1) : r * (q + 1) + (xcd - r) * q) + off; }
        const int nig = WGM * nN, gid = wgid / nig, fm = gid * WGM, gsz = (nM - fm) < WGM ? (nM - fm) : WGM;
        const int pm = fm + ((wgid % nig) % gsz), pn = (wgid % nig) / gsz;
        u.A = A + (size_t)pm * tstep; u.B = Bt + (size_t)pn * tstep; u.r0 = pm * 256; u.c0 = pn * 256; u.e = 0; u.ui = i; return true;
    }
};
}

struct Args { const float* in[28]; float* out; unsigned char* ws; int ph_lo, ph_hi; };
typedef const __attribute__((address_space(4))) Args* CArgs;
__device__ __forceinline__ CArgs cargs() { CArgs p = (CArgs)__builtin_amdgcn_kernarg_segment_ptr(); asm volatile("" : "+s"(p)); return p; }
enum { I_X = 0, I_EVWIN, I_EVBIN, I_POOLW, I_POOLB, I_POOLS, I_CONVW, I_CONVB, I_CLNG, I_CLNB, I_EVWOUT, I_EVBOUT, I_ODWIN, I_ODBIN, I_SLNG, I_SLNB, I_SGUW, I_SGUB, I_ODWOUT, I_ODBOUT,
       I_RW, I_RB, I_WUP, I_BUP, I_WDOWN, I_BDOWN, I_LNG, I_LNB };

__device__ __forceinline__ void transpose_item(const float* W, int K, int N, bf16* WT, LAS float* scr, int item, int lane) {
    const int nblk = N / 32, kb = item / nblk, nb = item % nblk, k0 = 64 * kb, n0 = 32 * nb;
#pragma unroll 8
    for (int i = 0; i < 32; ++i) { const int kk = 2 * i + (lane >> 5); scr[kk * 33 + (lane & 31)] = W[(size_t)(k0 + kk) * N + n0 + (lane & 31)]; }
    LDS_WAIT(); asm volatile("" ::: "memory");
    const int c = lane & 7;
#pragma unroll
    for (int j = 0; j < 4; ++j) { const int n = (lane >> 3) + 8 * j; const LAS float* s = scr + (8 * c) * 33 + n;
        u32x4 o; o.x = pk2(s[0 * 33], s[1 * 33]); o.y = pk2(s[2 * 33], s[3 * 33]); o.z = pk2(s[4 * 33], s[5 * 33]); o.w = pk2(s[6 * 33], s[7 * 33]);
        *(u32x4*)(WT + (size_t)(n0 + n) * K + k0 + 8 * c) = o; }
    LDS_WAIT(); asm volatile("" ::: "memory");
}
__device__ __forceinline__ unsigned pk4_fp8(float a, float b, float c, float d) {
    a = fminf(fmaxf(a, -448.f), 448.f); b = fminf(fmaxf(b, -448.f), 448.f); c = fminf(fmaxf(c, -448.f), 448.f); d = fminf(fmaxf(d, -448.f), 448.f);
    int r = 0; r = __builtin_amdgcn_cvt_pk_fp8_f32(a, b, r, false); r = __builtin_amdgcn_cvt_pk_fp8_f32(c, d, r, true); return (unsigned)r;
}
template <bool EMU> __device__ __forceinline__ float e2m3q(float y) { if constexpr (EMU) { y = fminf(fmaxf(y, -7.5f), 7.5f); return fabsf(y) < 1.f ? rintf(y * 8.f) * 0.125f : y; } else return y; }
__device__ __forceinline__ void transpose_item8(const float* W, int K, int N, unsigned char* WT, LAS float* scr, int item, int lane, float qs) {
    const int nblk = N / 32, kb = item / nblk, nb = item % nblk, k0 = 64 * kb, n0 = 32 * nb;
#pragma unroll 8
    for (int i = 0; i < 32; ++i) { const int kk = 2 * i + (lane >> 5); scr[kk * 33 + (lane & 31)] = W[(size_t)(k0 + kk) * N + n0 + (lane & 31)] * qs; }
    LDS_WAIT(); asm volatile("" ::: "memory");
    const int c = lane & 7;
#pragma unroll
    for (int j = 0; j < 4; ++j) { const int n = (lane >> 3) + 8 * j; const LAS float* s = scr + (8 * c) * 33 + n;
        u32x2 o; o.x = pk4_fp8(s[0 * 33], s[1 * 33], s[2 * 33], s[3 * 33]); o.y = pk4_fp8(s[4 * 33], s[5 * 33], s[6 * 33], s[7 * 33]);
        *(u32x2*)(WT + (size_t)(n0 + n) * K + k0 + 8 * c) = o; }
    LDS_WAIT(); asm volatile("" ::: "memory");
}
__device__ __forceinline__ void conv_group8(const float* W, int K, int N, int nmat, unsigned char* WT, LAS float* scr, int gw, int NGW, int lane, float qs) {
    const int per = (K / 64) * (N / 32); const long total = (long)per * nmat;
    for (long it = gw; it < total; it += NGW) { const int mi = (int)(it / per), r = (int)(it % per);
        transpose_item8(W + (size_t)mi * K * N, K, N, WT + (size_t)mi * K * N, scr, r, lane, qs); }
}
__device__ __forceinline__ void conv_issue(const float* W, int K, int N, long it, long per, int nblk, LAS unsigned char* tile, int lane) {
    const int mi = (int)(it / per), r = (int)(it % per), nb = r % nblk, kb = r / nblk, k0 = kb * 128, n0 = nb * 32;
    const float* src = W + (size_t)mi * K * N + (size_t)(k0 + (lane >> 3)) * N + n0;
#pragma unroll
    for (int j = 0; j < 16; ++j)
        __builtin_amdgcn_global_load_lds((const unsigned*)(src + (size_t)(8 * j) * N + 4 * ((lane & 7) ^ (j >> 1))), (LAS unsigned*)(tile + j * 1024), 16, 0, 2);
}
template <bool EMU = false> __device__ __forceinline__ void conv_dma8(const float* W, int K, int N, int nmat, unsigned char* WT, LAS unsigned char* tile, int gw, int NGW, int lane, float qs) {
    const int nblk = N / 32; const long per = (long)(K / 128) * nblk, total = per * nmat;
    long it = gw;
    if (it < total) conv_issue(W, K, N, it, per, nblk, tile, lane);
    const int c = lane & 7, nn = lane >> 3;
#pragma unroll 1
    for (; it < total; it += NGW) {
        if (it == gw) asm volatile("s_waitcnt vmcnt(0)" ::: "memory");
        else asm volatile("s_waitcnt vmcnt(4)" ::: "memory");
        const int mi = (int)(it / per), r = (int)(it % per), nb = r % nblk, kb = r / nblk, k0 = kb * 128, n0 = nb * 32;
        float v[4][16];
#pragma unroll
        for (int jj = 0; jj < 4; ++jj) { const int n = nn + 8 * jj;
#pragma unroll
            for (int i = 0; i < 16; ++i) v[jj][i] = *(const LAS float*)(tile + (16 * c + i) * 128 + (((n >> 2) ^ c) * 16) + (n & 3) * 4); }
        asm volatile("s_waitcnt lgkmcnt(0)" ::: "memory");
        const long nx = it + NGW;
        if (nx < total) conv_issue(W, K, N, nx, per, nblk, tile, lane);
        unsigned char* dst = WT + (size_t)mi * K * N + (size_t)n0 * K + k0 + 16 * c;
#pragma unroll
        for (int jj = 0; jj < 4; ++jj) { const int n = nn + 8 * jj; u32x4 o;
#define QE(x) e2m3q<EMU>((x) * qs)
            o.x = pk4_fp8(QE(v[jj][0]), QE(v[jj][1]), QE(v[jj][2]), QE(v[jj][3])); o.y = pk4_fp8(QE(v[jj][4]), QE(v[jj][5]), QE(v[jj][6]), QE(v[jj][7]));
            o.z = pk4_fp8(QE(v[jj][8]), QE(v[jj][9]), QE(v[jj][10]), QE(v[jj][11])); o.w = pk4_fp8(QE(v[jj][12]), QE(v[jj][13]), QE(v[jj][14]), QE(v[jj][15]));
#undef QE
            __builtin_nontemporal_store(o, (u32x4*)(dst + (size_t)n * K)); }
        if (nx >= total) asm volatile("s_waitcnt vmcnt(0)" ::: "memory");
    }
}
__device__ __forceinline__ v6u pack32_fp6(const v16u w) { return __builtin_amdgcn_cvt_scalef32_pk32_fp6_bf16(__builtin_bit_cast(v32bf, w), 1.0f); }
__device__ __forceinline__ void xpose4(unsigned& r0, unsigned& r1, unsigned& r2, unsigned& r3) {
    u32x2 t;
    t = __builtin_amdgcn_permlane16_swap(r0, r1, false, false); r0 = t.x; r1 = t.y;
    t = __builtin_amdgcn_permlane16_swap(r2, r3, false, false); r2 = t.x; r3 = t.y;
    t = __builtin_amdgcn_permlane32_swap(r0, r2, false, false); r0 = t.x; r2 = t.y;
    t = __builtin_amdgcn_permlane32_swap(r1, r3, false, false); r1 = t.x; r3 = t.y;
}
__device__ __forceinline__ void conv_issue6(const float* W, int K, int N, long it, long per, int nblk, LAS unsigned char* tile, int lane) {
    const int mi = (int)(it / per), r = (int)(it % per), nb = r % nblk, kb = r / nblk, k0 = kb * 128, n0 = nb * 32;
    const float* src = W + (size_t)mi * K * N + (size_t)k0 * N + n0;
#pragma unroll
    for (int j = 0; j < 16; ++j)
        __builtin_amdgcn_global_load_lds((const unsigned*)(src + (size_t)(8 * j + ((lane >> 3) ^ (j >> 3))) * N + 4 * ((lane & 7) ^ (4 * ((j >> 2) & 1)))), (LAS unsigned*)(tile + j * 1024), 16, 0, 2);
}
__device__ __forceinline__ void conv_dma6(const float* W, int K, int N, int nmat, unsigned char* WT, LAS unsigned char* tile, int gw, int NGW, int lane, float qs) {
    const int nblk = N / 32; const long per = (long)(K / 128) * nblk, total = per * nmat;
    long it = gw;
    if (it < total) conv_issue6(W, K, N, it, per, nblk, tile, lane);
    const int c = lane & 3, nn = lane >> 2;
#pragma unroll 1
    for (; it < total; it += NGW) {
        if (it == gw) asm volatile("s_waitcnt vmcnt(0)" ::: "memory");
        else asm volatile("s_waitcnt vmcnt(4)" ::: "memory");
        const int mi = (int)(it / per), r = (int)(it % per), nb = r % nblk, kb = r / nblk, k0 = kb * 128, n0 = nb * 32;
        float v[2][32];
#pragma unroll
        for (int jj = 0; jj < 2; ++jj) { const int n = nn + 16 * jj;
#pragma unroll
            for (int i = 0; i < 32; ++i) v[jj][i] = *(const LAS float*)(tile + ((32 * c + i) ^ (c >> 1)) * 128 + (((n >> 2) ^ (4 * (c & 1))) * 16) + (n & 3) * 4); }
        asm volatile("s_waitcnt lgkmcnt(0)" ::: "memory");
        const long nx = it + NGW;
        if (nx < total) conv_issue6(W, K, N, nx, per, nblk, tile, lane);
        unsigned char* dst = WT + (size_t)mi * K * N + (size_t)n0 * K + k0 + 16 * c;
#pragma unroll
        for (int jj = 0; jj < 2; ++jj) { const int n = nn + 16 * jj; v16u w;
#pragma unroll
            for (int p = 0; p < 16; ++p) w[p] = pk2(v[jj][2 * p] * qs, v[jj][2 * p + 1] * qs);
            const v6u o = pack32_fp6(w);
            __builtin_nontemporal_store((u32x4){o[0], o[1], o[2], o[3]}, (u32x4*)(dst + (size_t)n * K));
            __builtin_nontemporal_store((u32x4){o[4], o[5], o[4], o[5]}, (u32x4*)(dst + (size_t)n * K + 64)); }
        if (nx >= total) asm volatile("s_waitcnt vmcnt(0)" ::: "memory");
    }
}
__device__ __forceinline__ void conv_group(const float* W, int K, int N, int nmat, bf16* WT, LAS float* scr, int gw, int NGW, int lane) {
    const int per = (K / 64) * (N / 32); const long total = (long)per * nmat;
    for (long it = gw; it < total; it += NGW) { const int mi = (int)(it / per), r = (int)(it % per);
        transpose_item(W + (size_t)mi * K * N, K, N, WT + (size_t)mi * K * N, scr, r, lane); }
}
__device__ __forceinline__ void phase_convert(CArgs a, LAS unsigned char* lds, int wv) {
    int tid = phase_tid(wv);
    const int lane = tid & 63, wave = __builtin_amdgcn_readfirstlane(tid >> 6), G = gridDim.x;
    LAS float* scr = (LAS float*)(lds + wave * 16384);
    const int gw = blockIdx.x * NWAVES + wave, NGW = G * NWAVES;
    unsigned char* ws = a->ws;
    conv_group(a->in[I_EVWOUT], DM, DM, 2, (bf16*)(ws + WS_WEVOUT), scr, gw, NGW, lane);
    conv_dma8(a->in[I_ODWOUT], SGU_W, DM, 2, ws + WS_WODOUT, lds + wave * 16384, gw, NGW, lane, QS_WODOUT);
    conv_group(a->in[I_POOLW], 128, 128, 8, (bf16*)(ws + WS_WPOOL), scr, gw, NGW, lane);
    if (FP6_UP) conv_dma6(a->in[I_WUP], DM, 2 * DM, DEPTH * NEXP, ws + WS_WUP, lds + wave * 16384, gw, NGW, lane, QS_WUP);
    else conv_dma8(a->in[I_WUP], DM, 2 * DM, DEPTH * NEXP, ws + WS_WUP, lds + wave * 16384, gw, NGW, lane, QS_WUP);
    conv_dma8<EMU_DOWN != 0>(a->in[I_WDOWN], DM, DM, DEPTH * NEXP, ws + WS_WDOWN, lds + wave * 16384, gw, NGW, lane, QS_WDOWN);
    const long gt = (long)blockIdx.x * NTHR + tid, GT = (long)G * NTHR;
    { bf16* rh = (bf16*)(ws + WS_RWH); bf16* rl = (bf16*)(ws + WS_RWL); const float* rw = a->in[I_RW];
      for (long i = gt; i < (long)DEPTH * DM * NEXP; i += GT) { const int L = (int)(i / (DM * NEXP)), r = (int)(i % (DM * NEXP)), e = r / DM, k = r % DM;
          const float w = rw[(size_t)L * DM * NEXP + (size_t)k * NEXP + e]; const unsigned h = f2bf(w); rh[i] = (bf16)h; rl[i] = (bf16)f2bf(w - bflo(h)); } }
    { bf16* o = (bf16*)(ws + WS_WSGU); const float* w = a->in[I_SGUW];
      for (long i = gt; i < 2L * 8 * 128 * 128; i += GT) { const int ii = (int)((i >> 7) & 127), jj = (int)(i & 127); const float v = ((ii >> 6) >= (jj >> 6)) ? w[i] : 0.f; o[i] = (bf16)f2bf(v); } }
    { const float* x = a->in[I_X]; bf16* XB = (bf16*)(ws + WS_XB); unsigned char* XQ = ws + WS_XQ; float* SX = (float*)(ws + WS_SX);
      for (int tok = gw; tok < NTOK; tok += NGW) { f32x4 v[2][2]; float am = 0.f;
#pragma unroll
          for (int j = 0; j < 2; ++j) { v[j][0] = *(const f32x4*)(x + (size_t)tok * DM + lane * 8 + 512 * j); v[j][1] = *(const f32x4*)(x + (size_t)tok * DM + lane * 8 + 512 * j + 4);
              const f32x4 a0 = __builtin_elementwise_abs(v[j][0]), a1 = __builtin_elementwise_abs(v[j][1]); am = fmaxf(am, fmaxf(fmaxf(fmaxf(a0.x, a0.y), fmaxf(a0.z, a0.w)), fmaxf(fmaxf(a1.x, a1.y), fmaxf(a1.z, a1.w)))); }
          am = fmaxf(wave_max(am, lane), 1e-20f); const float inv = 127.f / am; if (lane == 0) SX[tok] = am * (1.f / 127.f);
#pragma unroll
          for (int j = 0; j < 2; ++j) { const int c0 = lane * 8 + 512 * j;
              u32x4 w; w.x = pk2(v[j][0].x, v[j][0].y); w.y = pk2(v[j][0].z, v[j][0].w); w.z = pk2(v[j][1].x, v[j][1].y); w.w = pk2(v[j][1].z, v[j][1].w); *(u32x4*)(XB + (size_t)tok * DM + c0) = w;
              u32x2 q; q.x = pk4_i8(v[j][0].x, v[j][0].y, v[j][0].z, v[j][0].w, inv); q.y = pk4_i8(v[j][1].x, v[j][1].y, v[j][1].z, v[j][1].w, inv); *(u32x2*)(XQ + (size_t)tok * DM + c0) = q; } } }
    if (!FIXED_WIN_SCALE) { unsigned* cmax = (unsigned*)(ws + WS_CTL) + CW_CMAX;
      constexpr int IT_EV = 2 * 8 * (EVEN_IN / 64), IT_OD = 2 * 8 * (2 * SGU_W / 64);
      for (int it = gw; it < IT_EV + IT_OD; it += NGW) { const bool od = it >= IT_EV; const int r = od ? it - IT_EV : it, N = od ? 2 * SGU_W : EVEN_IN, nblk = N / 64;
          const int mat = r / (8 * nblk), r2 = r % (8 * nblk), kc = r2 / nblk, nb = r2 % nblk, n = nb * 64 + lane;
          const float* W = (od ? a->in[I_ODWIN] : a->in[I_EVWIN]) + (size_t)mat * DM * N + (size_t)(kc * 128) * N + n; float m = 0.f;
#pragma unroll 16
          for (int i = 0; i < 128; ++i) m = fmaxf(m, fabsf(W[(size_t)i * N]));
          __hip_atomic_fetch_max(cmax + (od ? 2 * EVEN_IN : 0) + mat * N + n, __builtin_bit_cast(unsigned, m), __ATOMIC_RELAXED, __HIP_MEMORY_SCOPE_AGENT); } }
}
__device__ __forceinline__ void transpose_item_i8(const float* W, int K, int N, unsigned char* WT, const unsigned* cmax, float* sw, LAS float* scr, int item, int lane) {
    const int nblk = N / 32, kb = item / nblk, nb = item % nblk, k0 = 64 * kb, n0 = 32 * nb;
#pragma unroll 8
    for (int i = 0; i < 32; ++i) { const int kk = 2 * i + (lane >> 5); scr[kk * 33 + (lane & 31)] = W[(size_t)(k0 + kk) * N + n0 + (lane & 31)]; }
    LDS_WAIT(); asm volatile("" ::: "memory");
    const int c = lane & 7;
#pragma unroll
    for (int j = 0; j < 4; ++j) { const int n = (lane >> 3) + 8 * j; const LAS float* s = scr + (8 * c) * 33 + n;
        const float am = FIXED_WIN_SCALE ? 0.15625f : fmaxf(__builtin_bit_cast(float, cmax[n0 + n]), 1e-20f), inv = 127.f / am;
        u32x2 o; o.x = pk4_i8(s[0 * 33], s[1 * 33], s[2 * 33], s[3 * 33], inv); o.y = pk4_i8(s[4 * 33], s[5 * 33], s[6 * 33], s[7 * 33], inv);
        *(u32x2*)(WT + (size_t)(n0 + n) * K + k0 + 8 * c) = o;
        if (k0 == 0 && c == 0) sw[n0 + n] = am * (1.f / 127.f); }
    LDS_WAIT(); asm volatile("" ::: "memory");
}
__device__ __forceinline__ void phase_convert_b(CArgs a, LAS unsigned char* lds, int wv) {
    const int tid = phase_tid(wv), lane = tid & 63, wave = __builtin_amdgcn_readfirstlane(tid >> 6), G = gridDim.x;
    LAS float* scr = (LAS float*)(lds + wave * 16384);
    const int gw = blockIdx.x * NWAVES + wave, NGW = G * NWAVES;
    unsigned char* ws = a->ws; const unsigned* cmax = (const unsigned*)(ws + WS_CTL) + CW_CMAX;
    constexpr int PER_EV = (DM / 64) * (EVEN_IN / 32), PER_OD = (DM / 64) * (2 * SGU_W / 32);
    for (int it = gw; it < 2 * PER_EV + 2 * PER_OD; it += NGW) {
        if (it < 2 * PER_EV) { const int mat = it / PER_EV, r = it % PER_EV;
            transpose_item_i8(a->in[I_EVWIN] + (size_t)mat * DM * EVEN_IN, DM, EVEN_IN, ws + WS_WEVIN + (size_t)mat * DM * EVEN_IN, cmax + mat * EVEN_IN, (float*)(ws + WS_SWEV) + mat * EVEN_IN, scr, r, lane); }
        else { const int it2 = it - 2 * PER_EV, mat = it2 / PER_OD, r = it2 % PER_OD;
            transpose_item_i8(a->in[I_ODWIN] + (size_t)mat * DM * 2 * SGU_W, DM, 2 * SGU_W, ws + WS_WODIN + (size_t)mat * DM * 2 * SGU_W, cmax + 2 * EVEN_IN + mat * 2 * SGU_W, (float*)(ws + WS_SWOD) + mat * 2 * SGU_W, scr, r, lane); }
    }
}

using pg8::UnitD;
struct EpiBiasBf16 {
    static constexpr bool PUBLISH = false;
    bf16* O; int ldc; const float* bias; const float* sx; const float* sw;
    __device__ __forceinline__ void operator()(const f32x4 (&acc)[2][2][4][2], const UnitD& u, int wr, int wc, int fr, int fq) const {
        const int row0 = u.r0 + wr * 64 + fr, col0 = u.c0 + wc * 32 + 8 * fq;
#pragma unroll
        for (int bj = 0; bj < 2; ++bj) { const f32x4 bv0 = *(const f32x4*)(bias + col0 + bj * 128), bv1 = *(const f32x4*)(bias + col0 + bj * 128 + 4);
            const f32x4 sw0 = *(const f32x4*)(sw + col0 + bj * 128), sw1 = *(const f32x4*)(sw + col0 + bj * 128 + 4);
#pragma unroll
            for (int ai = 0; ai < 2; ++ai)
#pragma unroll
                for (int m = 0; m < 4; ++m) { const int row = row0 + ai * 128 + m * 16; const float s = sx[row];
                    const v4i i0 = __builtin_bit_cast(v4i, acc[ai][bj][m][0]), i1 = __builtin_bit_cast(v4i, acc[ai][bj][m][1]);
                    const f32x4 v0 = __builtin_convertvector(i0, f32x4) * (sw0 * s) + bv0, v1 = __builtin_convertvector(i1, f32x4) * (sw1 * s) + bv1;
                    u32x4 w; w.x = pk2(v0[0], v0[1]); w.y = pk2(v0[2], v0[3]); w.z = pk2(v1[0], v1[1]); w.w = pk2(v1[2], v1[3]);
                    *(u32x4*)(O + (size_t)row * ldc + col0 + bj * 128) = w; } }
    }
};
__device__ __forceinline__ f32x2 gelu_pk(f32x2 v) {
    f32x2 vc; vc.x = __builtin_amdgcn_fmed3f(v.x, -4.25f, 4.25f); vc.y = __builtin_amdgcn_fmed3f(v.y, -4.25f, 4.25f);
    const f32x2 s = vc * vc;
    f32x2 q = s * (-2.562045892e-12f) + 2.732375520e-10f;
    q = q * s + (-1.309781371e-08f); q = q * s + 3.770278565e-07f; q = q * s + (-7.377925681e-06f); q = q * s + 1.056265650e-04f;
    q = q * s + (-1.158376687e-03f); q = q * s + 9.925602724e-03f; q = q * s + (-6.645352160e-02f); q = q * s + 3.989338899e-01f;
    return v * (vc * q + 0.5f);
}
struct EpiGeluStats {
    static constexpr bool PUBLISH = false;
    bf16* O; const float* bias; float* stats; const float* sx; const float* sw;
    __device__ __forceinline__ void operator()(const f32x4 (&acc)[2][2][4][2], const UnitD& u, int wr, int wc, int fr, int fq) const {
        const int row0 = u.r0 + wr * 64 + fr, col0 = u.c0 + wc * 32 + 8 * fq;
        const bool isv = u.c0 >= SGU_W; const int slot = ((u.c0 - SGU_W) >> 8) * 4 + wc;
        f32x4 bv[2][2], sv[2][2];
#pragma unroll
        for (int bj = 0; bj < 2; ++bj)
#pragma unroll
            for (int n = 0; n < 2; ++n) { bv[bj][n] = *(const f32x4*)(bias + col0 + bj * 128 + 4 * n); sv[bj][n] = *(const f32x4*)(sw + col0 + bj * 128 + 4 * n); }
#pragma unroll
        for (int ai = 0; ai < 2; ++ai)
#pragma unroll
            for (int m = 0; m < 4; ++m) { const int row = row0 + ai * 128 + m * 16; bf16* rowp = O + (size_t)row * (2 * SGU_W) + col0; float s = 0.f, q = 0.f; const float sr = sx[row];
#pragma unroll
                for (int bj = 0; bj < 2; ++bj) {
                    f32x4 v0 = __builtin_convertvector(__builtin_bit_cast(v4i, acc[ai][bj][m][0]), f32x4) * (sv[bj][0] * sr) + bv[bj][0];
                    f32x4 v1 = __builtin_convertvector(__builtin_bit_cast(v4i, acc[ai][bj][m][1]), f32x4) * (sv[bj][1] * sr) + bv[bj][1];
                    { const f32x2 ga = gelu_pk((f32x2){v0[0], v0[1]}), gb = gelu_pk((f32x2){v0[2], v0[3]}), gc = gelu_pk((f32x2){v1[0], v1[1]}), gd = gelu_pk((f32x2){v1[2], v1[3]});
                      v0 = (f32x4){ga.x, ga.y, gb.x, gb.y}; v1 = (f32x4){gc.x, gc.y, gd.x, gd.y}; }
#pragma unroll
                    for (int j = 0; j < 4; ++j) { s += v0[j] + v1[j]; q += v0[j] * v0[j] + v1[j] * v1[j]; }
                    u32x4 w; w.x = pk2(v0[0], v0[1]); w.y = pk2(v0[2], v0[3]); w.z = pk2(v1[0], v1[1]); w.w = pk2(v1[2], v1[3]);
                    *(u32x4*)(rowp + bj * 128) = w; }
                if (isv) { const int ln = fq * 16 + fr; s += shx(s, 16, ln); s += shx(s, 32, ln); q += shx(q, 16, ln); q += shx(q, 32, ln);
                    if (fq == 0) *(f32x2*)(stats + (size_t)row * 64 + slot * 2) = (f32x2){s, q}; } }
    }
};
struct EpiZ {
    static constexpr bool PUBLISH = false;
    bf16* Z; const float* bias; const bf16* X; float sc;
    __device__ __forceinline__ void operator()(const f32x4 (&acc)[2][2][4][2], const UnitD& u, int wr, int wc, int fr, int fq) const {
        const int row0 = u.r0 + wr * 64 + fr, col0 = u.c0 + wc * 32 + 8 * fq;
#pragma unroll
        for (int bj = 0; bj < 2; ++bj) { const f32x4 bv0 = *(const f32x4*)(bias + col0 + bj * 128), bv1 = *(const f32x4*)(bias + col0 + bj * 128 + 4);
#pragma unroll
            for (int ai = 0; ai < 2; ++ai)
#pragma unroll
                for (int m = 0; m < 4; ++m) { const size_t ro = (size_t)(row0 + ai * 128 + m * 16) * DM + col0 + bj * 128;
                    const u32x4 xr = *(const u32x4*)(X + ro);
                    const f32x4 v0 = acc[ai][bj][m][0] * sc + bv0 + DN_ALPHA * (f32x4){bflo(xr.x), bfhi(xr.x), bflo(xr.y), bfhi(xr.y)};
                    const f32x4 v1 = acc[ai][bj][m][1] * sc + bv1 + DN_ALPHA * (f32x4){bflo(xr.z), bfhi(xr.z), bflo(xr.w), bfhi(xr.w)};
                    u32x4 w; w.x = pk2(v0[0], v0[1]); w.y = pk2(v0[2], v0[3]); w.z = pk2(v1[0], v1[1]); w.w = pk2(v1[2], v1[3]);
                    *(u32x4*)(Z + ro) = w; } }
    }
};
struct EpiUp {
    static constexpr bool PUBLISH = true; unsigned* upc;
    __device__ __forceinline__ void publish(int mt) const { (void)__hip_atomic_fetch_add(upc + mt, 1u, __ATOMIC_RELAXED, __HIP_MEMORY_SCOPE_AGENT); }
    unsigned char* H; const LAS float* bl_lds;
    static __device__ __forceinline__ f32x2 act2(f32x2 g, f32x2 l) {
        g = __builtin_elementwise_min(g, (f32x2){7.f, 7.f}); l = __builtin_elementwise_min(__builtin_elementwise_max(l, (f32x2){-7.f, -7.f}), (f32x2){7.f, 7.f});
        const f32x2 t = g * (-1.702f * 1.44269504089f); f32x2 e; e.x = __builtin_amdgcn_exp2f(t.x); e.y = __builtin_amdgcn_exp2f(t.y);
        const f32x2 d = e + 1.0f; f32x2 r; r.x = __builtin_amdgcn_rcpf(d.x); r.y = __builtin_amdgcn_rcpf(d.y);
        return (g * r) * (l * QS_ACT + QS_ACT);
    }
    __device__ __forceinline__ void operator()(const f32x4 (&acc)[2][2][4][2], const UnitD& u, int wr, int wc, int fr, int fq) const {
        const int row0 = u.r0 + wr * 64 + fr, col0 = u.c0 + wc * 32 + 8 * fq;
        const LAS float* bg = bl_lds + u.ui * 256 + wc * 32 + 8 * fq; const LAS float* bl = bg + 128;
        f32x4 bgv[2], blv[2];
#pragma unroll
        for (int n = 0; n < 2; ++n) { bgv[n] = *(const LAS f32x4*)(bg + 4 * n); blv[n] = *(const LAS f32x4*)(bl + 4 * n); }
        constexpr float SC = 1.f / (QS_X1 * QS_WUP);
#pragma unroll
        for (int ai = 0; ai < 2; ++ai)
#pragma unroll
            for (int m = 0; m < 4; ++m) { unsigned char* rowp = H + (size_t)(row0 + ai * 128 + m * 16) * DM + col0; u32x2 w;
#pragma unroll
                for (int n = 0; n < 2; ++n) { const f32x4 g = acc[ai][0][m][n] * SC + bgv[n], l = acc[ai][1][m][n] * SC + blv[n];
                    const f32x2 o0 = act2((f32x2){g[0], g[1]}, (f32x2){l[0], l[1]}), o1 = act2((f32x2){g[2], g[3]}, (f32x2){l[2], l[3]});
                    int r = 0; r = __builtin_amdgcn_cvt_pk_fp8_f32(e2m3q<EMU_DOWN != 0>(o0.x), e2m3q<EMU_DOWN != 0>(o0.y), r, false); r = __builtin_amdgcn_cvt_pk_fp8_f32(e2m3q<EMU_DOWN != 0>(o1.x), e2m3q<EMU_DOWN != 0>(o1.y), r, true);
                    if (n == 0) w.x = (unsigned)r; else w.y = (unsigned)r; }
                __hip_atomic_store((unsigned long long*)rowp, ((unsigned long long)w.y << 32) | (unsigned long long)w.x, __ATOMIC_RELAXED, __HIP_MEMORY_SCOPE_AGENT); }
    }
};
struct EpiDown {
    static constexpr bool PUBLISH = false;
    unsigned char* Y; const LAS float* bl_lds;
    __device__ __forceinline__ void operator()(const f32x4 (&acc)[2][2][4][2], const UnitD& u, int wr, int wc, int fr, int fq) const {
        const int row0 = u.r0 + wr * 64 + fr, col0 = u.c0 + wc * 32 + 8 * fq;
        const LAS float* bias = bl_lds + u.ui * 256 + wc * 32 + 8 * fq;
#pragma unroll
        for (int bj = 0; bj < 2; ++bj) { const f32x4 bv0 = *(const LAS f32x4*)(bias + bj * 128) * QS_YS, bv1 = *(const LAS f32x4*)(bias + bj * 128 + 4) * QS_YS;
#pragma unroll
            for (int ai = 0; ai < 2; ++ai)
#pragma unroll
                for (int m = 0; m < 4; ++m) { unsigned char* rowp = Y + (size_t)(row0 + ai * 128 + m * 16) * DM + col0 + bj * 128;
                    const f32x4 v0 = acc[ai][bj][m][0] * (QS_YS / (QS_ACT * QS_WDOWN)) + bv0, v1 = acc[ai][bj][m][1] * (QS_YS / (QS_ACT * QS_WDOWN)) + bv1;
                    u32x2 w; w.x = pk4_fp8(v0[0], v0[1], v0[2], v0[3]); w.y = pk4_fp8(v1[0], v1[1], v1[2], v1[3]);
                    *(u32x2*)rowp = w; } }
    }
};

struct UpSched {
    static constexpr size_t BHALF = (size_t)1024 * DM; static constexpr bool POLL = false;
    const LAS int* ut; const char* X1B; const char* W;
    __device__ __forceinline__ bool next(int i, UnitD& u) const {
        if (i >= MAXU) return false;
        const int valid = __builtin_amdgcn_readfirstlane(ut[i * 4 + 3]); if (!valid) return false;
        const int e = __builtin_amdgcn_readfirstlane(ut[i * 4 + 0]), mt = __builtin_amdgcn_readfirstlane(ut[i * 4 + 1]), nt = __builtin_amdgcn_readfirstlane(ut[i * 4 + 2]);
        u.A = X1B; u.B = W + ((size_t)e * 2048 + nt * 128) * DM; u.r0 = mt * 256; u.c0 = nt * 128; u.e = e; u.ui = i; return true;
    }
};
struct DownSched {
    static constexpr size_t BHALF = (size_t)128 * DM; static constexpr bool POLL = true;
    const LAS int* ut; const char* H; const char* W; const unsigned* upc; bool w0;
    __device__ __forceinline__ void wait_tile(int mt) const {
        unsigned sp = 0;
        while (__builtin_amdgcn_readfirstlane(__hip_atomic_load(upc + mt, __ATOMIC_RELAXED, __HIP_MEMORY_SCOPE_AGENT)) < 8u) { __builtin_amdgcn_s_sleep(2); if (++sp > (1u << 22)) break; }
    }
    __device__ __forceinline__ bool next(int i, UnitD& u) const {
        if (i >= MAXU) return false;
        const int valid = __builtin_amdgcn_readfirstlane(ut[i * 4 + 3]); if (!valid) return false;
        const int e = __builtin_amdgcn_readfirstlane(ut[i * 4 + 0]), mt = __builtin_amdgcn_readfirstlane(ut[i * 4 + 1]), nt = __builtin_amdgcn_readfirstlane(ut[i * 4 + 2]);
        if (MK_SINGLE && w0) {
            if (i == 0) { wait_tile(mt);
#pragma unroll 1
                for (int j = 1; j < 4; ++j) if (__builtin_amdgcn_readfirstlane(ut[j * 4 + 3])) wait_tile(__builtin_amdgcn_readfirstlane(ut[j * 4 + 1]));
                __builtin_amdgcn_fence(__ATOMIC_ACQUIRE, "agent"); }
            else if (i >= 4) { wait_tile(mt); __builtin_amdgcn_fence(__ATOMIC_ACQUIRE, "agent"); }
        }
        u.A = H + (size_t)mt * 256 * DM; u.B = W + ((size_t)e * 1024 + nt * 256) * DM; u.r0 = mt * 256; u.c0 = nt * 256; u.e = e; u.ui = i; return true;
    }
};
template <int NTN, bool ROWS, bool REUSE = false>
__device__ __forceinline__ void moe_tables(CArgs a, LAS unsigned char* lds, int L, int wv, const float* bias  ) {
    int tid = phase_tid(wv);
    const int G = gridDim.x;
    LAS int* misc = (LAS int*)(lds + MISC_OFF);
    LAS int* ut = (LAS int*)(lds + UT_OFF);
    LAS int* tab = (LAS int*)(lds + TAB_OFF);
    const unsigned* cntw = (const unsigned*)(a->ws + WS_CTL) + CW_CNT + (size_t)L * NEXP * 64;
    __syncthreads();
    if (!(REUSE && MK_SINGLE)) {
        if (tid < 64) { const int ln = tid & 63; int c = 0; if (ln < NEXP) c = (int)__hip_atomic_load(cntw + ln * 64, __ATOMIC_RELAXED, __HIP_MEMORY_SCOPE_AGENT);
            const int n = (c + 255) >> 8; int s = n;
#pragma unroll
            for (int o = 1; o < 32; o <<= 1) { const int t = __builtin_amdgcn_ds_bpermute(((ln - o) & 63) << 2, s); if ((ln & 31) >= o) s += t; }
            if (ln < NEXP) { misc[64 + ln] = c; misc[16 + ln] = s - n; if (ln == NEXP - 1) misc[16 + NEXP] = s; } }
        __syncthreads();
    }
    if (tid < MAXU) {
        const int T = misc[16 + NEXP];
        const int x = blockIdx.x & 7, w = blockIdx.x >> 3, WPX = G >> 3, MPG = WPX / NTN;
        int mt = (tid * 8 + x) * MPG + w / NTN, nt = w % NTN;
        if (NTN == 4 && MK_SINGLE) {
            if (tid == 4) { const int j = (7 - x) * (G >> 3) + w; mt = 256 + (j >> 2); nt = j & 3; }
            else if (tid > 4) mt = 1 << 20; }
        int e = 0; for (int k = 1; k < NEXP; ++k) if (misc[16 + k] <= mt) e = k;
        const int valid = mt < T ? 1 : 0;
        ut[tid * 4 + 0] = e; ut[tid * 4 + 1] = mt; ut[tid * 4 + 2] = nt; ut[tid * 4 + 3] = valid;
    }
    __syncthreads();
    {
        LAS float* bl = (LAS float*)(lds + BIAS_OFF);
        for (int idx = tid; idx < MAXU * 256; idx += NTHR) { const int i = idx >> 8, s = idx & 255; float v = 0.f;
            if (ut[i * 4 + 3]) { const int e = ut[i * 4 + 0], nt = ut[i * 4 + 2];
                v = (NTN == 8) ? bias[(size_t)e * 2048 + (s < 128 ? nt * 128 + s : 1024 + nt * 128 + s - 128)] : bias[(size_t)e * DM + nt * 256 + s]; }
            bl[idx] = v; }
        if (!ROWS) __syncthreads();
    }
    if (ROWS) {
        const int* rowtok = (const int*)(a->ws + WS_ROWTOK);
        for (int idx = tid; idx < MAXU * 256; idx += NTHR) { const int i = idx >> 8, r = idx & 255;
            int tok = 0;
            if (ut[i * 4 + 3]) { const int e = ut[i * 4 + 0], row = (ut[i * 4 + 1] - misc[16 + e]) * 256 + r; if (row < misc[64 + e]) tok = rowtok[(size_t)e * CAPROWS + row]; }
            tab[idx] = tok; }
        __syncthreads();
    }
}

__device__ __forceinline__ void phase_even_mix(CArgs a, LAS unsigned char* lds, int i2, int wv) {
    int tid = phase_tid(wv);
    const int lane = tid & 63, wave = __builtin_amdgcn_readfirstlane(tid >> 6), G = gridDim.x;
    const bf16* HB = (const bf16*)(a->ws + WS_HB); bf16* YB = (bf16*)(a->ws + WS_YB);
    LAS bf16* glu = (LAS bf16*)lds;
    LAS float* ybuf = (LAS float*)(lds + 65536);
    constexpr int PLS = 520;
    LAS bf16* pl = (LAS bf16*)(lds + 65536);
    const int c = tid;
    const float* cw = a->in[I_CONVW] + (size_t)i2 * 31 * 512;
    for (int chunk = blockIdx.x; chunk < NTOK / 32; chunk += G) {
        const int b = chunk >> 6, t0 = (chunk & 63) * 32; const size_t tokbase = (size_t)chunk * 32;
#pragma unroll
        for (int it = 0; it < 8; ++it) { const int item = it * NTHR + tid, tt = item >> 6, cg = item & 63, p = t0 - 32 + tt;
            u32x4 o = (u32x4){0u, 0u, 0u, 0u};
            if (p >= 0) { const bf16* hp = HB + ((size_t)b * SEQ + p) * EVEN_IN + cg * 8; const u32x4 ra = *(const u32x4*)(hp + 512), rg = *(const u32x4*)(hp + 1024);
                o.x = pk2(bflo(ra.x) * sigmoidf_(bflo(rg.x)), bfhi(ra.x) * sigmoidf_(bfhi(rg.x))); o.y = pk2(bflo(ra.y) * sigmoidf_(bflo(rg.y)), bfhi(ra.y) * sigmoidf_(bfhi(rg.y)));
                o.z = pk2(bflo(ra.z) * sigmoidf_(bflo(rg.z)), bfhi(ra.z) * sigmoidf_(bfhi(rg.z))); o.w = pk2(bflo(ra.w) * sigmoidf_(bflo(rg.w)), bfhi(ra.w) * sigmoidf_(bfhi(rg.w))); }
            *(LAS u32x4*)(glu + tt * 512 + cg * 8) = o; }
        __syncthreads();
        {
            float w[31];
#pragma unroll
            for (int k = 0; k < 31; ++k) { unsigned off = (unsigned)c * 4u; asm volatile("" : "+v"(off)); w[k] = *(const float*)((const char*)(cw + k * 512) + off); }
            const float cb = a->in[I_CONVB][i2 * 512 + c];
            float win[34];
#pragma clang loop unroll(full)
            for (int r = 0; r < 64; ++r) {
                win[r % 34] = bf2f(glu[r * 512 + c]);
                if (r >= 32) { float y = cb;
#pragma unroll
                    for (int k = 0; k < 31; ++k) y += w[k] * win[(r - 30 + k) % 34];
                    ybuf[(r - 32) * 512 + c] = y; }
            }
        }
        __syncthreads();
#pragma unroll
        for (int it = 0; it < 6; ++it) { const int item = it * NTHR + tid, tt = item >> 6, cg = item & 63, p = t0 - 16 + tt;
            u32x4 o = (u32x4){0u, 0u, 0u, 0u};
            if (p >= 0) o = *(const u32x4*)(HB + ((size_t)b * SEQ + p) * EVEN_IN + cg * 8);
            *(LAS u32x4*)(glu + tt * 512 + cg * 8) = o; }
        {
            const float* lg = a->in[I_CLNG] + i2 * 512 + lane * 8; const float* lb = a->in[I_CLNB] + i2 * 512 + lane * 8;
            const f32x4 g0 = *(const f32x4*)lg, g1 = *(const f32x4*)(lg + 4), b0 = *(const f32x4*)lb, b1 = *(const f32x4*)(lb + 4);
#pragma unroll
            for (int tt = 0; tt < 4; ++tt) { const int t = wave * 4 + tt;
                f32x4 v0 = *(const LAS f32x4*)(ybuf + t * 512 + lane * 8), v1 = *(const LAS f32x4*)(ybuf + t * 512 + lane * 8 + 4);
                const float mean = wave_sum((v0.x + v0.y) + (v0.z + v0.w) + (v1.x + v1.y) + (v1.z + v1.w), lane) * (1.f / 512.f);
                v0 = v0 - mean; v1 = v1 - mean;
                const float var = wave_sum((v0.x * v0.x + v0.y * v0.y) + (v0.z * v0.z + v0.w * v0.w) + (v1.x * v1.x + v1.y * v1.y) + (v1.z * v1.z + v1.w * v1.w), lane) * (1.f / 512.f);
                const float rstd = 1.0f / sqrtf(var + LN_EPS);
                float o[8];
#pragma unroll
                for (int j = 0; j < 4; ++j) { const float x0 = v0[j] * rstd * g0[j] + b0[j], x1 = v1[j] * rstd * g1[j] + b1[j]; o[j] = x0 * sigmoidf_(x0); o[4 + j] = x1 * sigmoidf_(x1); }
                u32x4 wv4; wv4.x = pk2(o[0], o[1]); wv4.y = pk2(o[2], o[3]); wv4.z = pk2(o[4], o[5]); wv4.w = pk2(o[6], o[7]);
                *(u32x4*)(YB + (tokbase + t) * DM + 512 + lane * 8) = wv4; }
        }
        __syncthreads();
        {
            const int g = wave >> 1, winw = 2 << g;
            float pprev = 0.f, a2r[3] = {0.f, 0.f, 0.f}, a4r[5] = {0.f, 0.f, 0.f, 0.f, 0.f}, a8r[9] = {0.f, 0.f, 0.f, 0.f, 0.f, 0.f, 0.f, 0.f, 0.f};
#pragma clang loop unroll(full)
            for (int r = 0; r < 48; ++r) {
                const float p = bf2f(glu[r * 512 + c]);
                const float a2 = p + pprev, a4 = a2 + a2r[(r + 1) % 3], a8 = a4 + a4r[(r + 1) % 5], a16 = a8 + a8r[(r + 1) % 9];
                a2r[r % 3] = a2; a4r[r % 5] = a4; a8r[r % 9] = a8; pprev = p;
                if (r >= 16) { const float s = g == 0 ? a2 : (g == 1 ? a4 : (g == 2 ? a8 : a16));
                    const int pos = t0 + r - 16; const float cnt = (float)((pos + 1) < winw ? (pos + 1) : winw);
                    pl[(r - 16) * PLS + c] = (bf16)f2bf(s / cnt - p); }
            }
        }
        __syncthreads();
        {
            const int g = wave >> 1, nh = wave & 1, fr = lane & 15, fq = lane >> 4;
            const bf16* wp = (const bf16*)(a->ws + WS_WPOOL) + ((size_t)i2 * 4 + g) * 128 * 128;
            f32x4 acc[2][4];
#pragma unroll
            for (int m = 0; m < 2; ++m)
#pragma unroll
                for (int n = 0; n < 4; ++n) acc[m][n] = (f32x4){0.f, 0.f, 0.f, 0.f};
#pragma unroll
            for (int ks = 0; ks < 4; ++ks) {
                bf16x8 af[2], bfr[4];
#pragma unroll
                for (int m = 0; m < 2; ++m) af[m] = *(const LAS bf16x8*)(pl + (m * 16 + fr) * PLS + g * 128 + ks * 32 + fq * 8);
#pragma unroll
                for (int n = 0; n < 4; ++n) bfr[n] = *(const bf16x8*)(wp + (size_t)(nh * 64 + n * 16 + fr) * 128 + ks * 32 + fq * 8);
#pragma unroll
                for (int m = 0; m < 2; ++m)
#pragma unroll
                    for (int n = 0; n < 4; ++n) acc[m][n] = __builtin_amdgcn_mfma_f32_16x16x32_bf16(bfr[n], af[m], acc[m][n], 0, 0, 0);
            }
#pragma unroll
            for (int n = 0; n < 4; ++n) { const int d = nh * 64 + n * 16 + 4 * fq;
                const f32x4 pb = *(const f32x4*)(a->in[I_POOLB] + ((size_t)i2 * 4 + g) * 128 + d), ps = *(const f32x4*)(a->in[I_POOLS] + (size_t)i2 * 512 + g * 128 + d);
#pragma unroll
                for (int m = 0; m < 2; ++m) { const f32x4 v = (acc[m][n] + pb) * ps; u32x2 wv2; wv2.x = pk2(v.x, v.y); wv2.y = pk2(v.z, v.w);
                    *(u32x2*)(YB + (tokbase + m * 16 + fr) * DM + g * 128 + d) = wv2; } }
        }
        __syncthreads();
    }
}

__device__ __forceinline__ void phase_sgu(CArgs a, LAS unsigned char* lds, int i2, int wv) {
    int tid = phase_tid(wv);
    const int G = gridDim.x;
    const bf16* HB = (const bf16*)(a->ws + WS_HB); unsigned char* YQ = a->ws + WS_YB;
    const float* stats = (const float*)(a->ws + WS_STATS);
    constexpr int VS = 136;
    LAS bf16* vt = (LAS bf16*)lds;
    LAS float* mu = (LAS float*)(lds + 256 * VS * 2), *rs = mu + 128;
    LAS unsigned char* wl = lds + 73728;
    const float* lg = a->in[I_SLNG] + (size_t)i2 * SGU_W; const float* lb = a->in[I_SLNB] + (size_t)i2 * SGU_W;
    for (int u = blockIdx.x; u < (NTOK / 128) * 2; u += G) {
        const int chunk = u >> 1, h0 = (u & 1) * 4; const size_t tok0 = (size_t)chunk * 128;
        int tz = tid; asm volatile("" : "+v"(tz));
        const int lane = tz & 63, wave = __builtin_amdgcn_readfirstlane(tz >> 6), wr = wave >> 2, wc = wave & 3, fr = lane & 15, fq = lane >> 4;
        if (tz < 128) { const float* sp = stats + (tok0 + tz) * 64; float s = 0.f, q = 0.f;
#pragma unroll
            for (int k = 0; k < 16; ++k) { const f32x4 v = *(const f32x4*)(sp + 4 * k); s += v.x + v.z; q += v.y + v.w; }
            const float m = s * (1.f / SGU_W), var = fmaxf(q * (1.f / SGU_W) - m * m, 0.f);
            mu[tz] = m; rs[tz] = 1.0f / sqrtf(var + LN_EPS); }
        u32x4 vraw[8];
#pragma unroll
        for (int it = 0; it < 8; ++it) { const int j = 32 * (it & 3) + (lane & 31), c8 = 2 * (8 * (it >> 2) + wave) + (lane >> 5);
            vraw[it] = *(const u32x4*)(HB + (tok0 + j) * (2 * SGU_W) + SGU_W + h0 * 256 + c8 * 8); }
        __syncthreads();
#pragma unroll 1
        for (int hh = 0; hh < 4; ++hh) {
            const int h = h0 + hh;
            const bf16* wm = (const bf16*)(a->ws + WS_WSGU) + ((size_t)i2 * 8 + h) * 128 * 128;
#pragma unroll
            for (int q = 0; q < 4; ++q) { const int r = 4 * (8 * q + wave) + (lane >> 4);
                __builtin_amdgcn_global_load_lds((const unsigned*)(wm + (size_t)r * 128 + 8 * ((lane & 15) ^ (r & 15))), (LAS unsigned*)(wl + (8 * q + wave) * 1024), 16, 0, 0); }
            {
                const int cA = 2 * wave + (lane >> 5);
                f32x4 gg[2][2], bb[2][2];
#pragma unroll
                for (int q = 0; q < 2; ++q) { const float* gp = lg + h * 256 + (cA + 16 * q) * 8; const float* bp = lb + h * 256 + (cA + 16 * q) * 8;
                    gg[q][0] = *(const f32x4*)gp; gg[q][1] = *(const f32x4*)(gp + 4); bb[q][0] = *(const f32x4*)bp; bb[q][1] = *(const f32x4*)(bp + 4); }
#pragma unroll
                for (int it = 0; it < 8; ++it) { const int j = 32 * (it & 3) + (lane & 31), q = it >> 2, c8 = cA + 16 * q;
                    const float m = mu[j], r = rs[j]; const u32x4 raw = vraw[it];
                    const float v[8] = {bflo(raw.x), bfhi(raw.x), bflo(raw.y), bfhi(raw.y), bflo(raw.z), bfhi(raw.z), bflo(raw.w), bfhi(raw.w)};
#pragma unroll
                    for (int k = 0; k < 8; k += 2) { const unsigned pr = pk2((v[k] - m) * r * gg[q][k >> 2][k & 3] + bb[q][k >> 2][k & 3], (v[k + 1] - m) * r * gg[q][k >> 2][(k + 1) & 3] + bb[q][k >> 2][(k + 1) & 3]);
                        vt[(c8 * 8 + k) * VS + j] = (bf16)(pr & 0xffffu); vt[(c8 * 8 + k + 1) * VS + j] = (bf16)(pr >> 16); } }
            }
            if (hh < 3) {
#pragma unroll
                for (int it = 0; it < 8; ++it) { const int j = 32 * (it & 3) + (lane & 31), c8 = 2 * (8 * (it >> 2) + wave) + (lane >> 5);
                    vraw[it] = *(const u32x4*)(HB + (tok0 + j) * (2 * SGU_W) + SGU_W + (h + 1) * 256 + c8 * 8); } }
            asm volatile("s_waitcnt vmcnt(0)" ::: "memory");
            __syncthreads();
            f32x4 acc[4][4];
#pragma unroll
            for (int m = 0; m < 4; ++m)
#pragma unroll
                for (int n = 0; n < 4; ++n) acc[m][n] = (f32x4){0.f, 0.f, 0.f, 0.f};
#pragma unroll
            for (int ks = 0; ks < 4; ++ks) {
                bf16x8 bfr[4], af[4];
#pragma unroll
                for (int m = 0; m < 4; ++m) { const int i = wr * 64 + m * 16 + fr; af[m] = *(const LAS bf16x8*)(wl + i * 256 + (((ks * 4 + fq) ^ (i & 15)) * 16)); }
#pragma unroll
                for (int n = 0; n < 4; ++n) bfr[n] = *(const LAS bf16x8*)(vt + (wc * 64 + n * 16 + fr) * VS + ks * 32 + fq * 8);
#pragma unroll
                for (int m = 0; m < 4; ++m)
#pragma unroll
                    for (int n = 0; n < 4; ++n) acc[m][n] = __builtin_amdgcn_mfma_f32_16x16x32_bf16(bfr[n], af[m], acc[m][n], 0, 0, 0);
            }
            { int te = tz; asm volatile("" : "+v"(te));
              const int le = te & 63, we = te >> 6, wr = we >> 2, wc = we & 3, fr = le & 15, fq = le >> 4;
#pragma unroll
            for (int m = 0; m < 4; ++m) { const int i = wr * 64 + m * 16 + fr; const float bs = a->in[I_SGUB][((size_t)i2 * 8 + h) * 128 + i];
#pragma unroll
                for (int n = 0; n < 4; ++n) { const int cc = h * 256 + wc * 64 + n * 16 + 4 * fq;
                    const f32x4 sv = acc[m][n] + bs; const u32x2 uv = *(const u32x2*)(HB + (tok0 + i) * (2 * SGU_W) + cc);
                    *(unsigned*)(YQ + (tok0 + i) * SGU_W + cc) = pk4_fp8(bflo(uv.x) * sv.x * QS_GATED, bfhi(uv.x) * sv.y * QS_GATED, bflo(uv.y) * sv.z * QS_GATED, bfhi(uv.y) * sv.w * QS_GATED); } } }
            __syncthreads();
        }
    }
}

__device__ __forceinline__ void phase_ln_route(CArgs a, LAS unsigned char* lds, int L, int wv) {
    int tid = phase_tid(wv);
    const int lane = tid & 63, wave = __builtin_amdgcn_readfirstlane(tid >> 6), G = gridDim.x;
    const int fr = lane & 15, fq = lane >> 4, tg = wave & 1, kq = wave >> 1;
    const bf16* Z = (const bf16*)(a->ws + WS_Z); bf16* X1B = (bf16*)(a->ws + WS_X1F); unsigned char* X1Q = a->ws + WS_X1B;
    LAS float* red = (LAS float*)lds;
    LAS float* plg = (LAS float*)(lds + 4096);
    LAS float* lgt = (LAS float*)(lds + 4096 + 16384);
    LAS int* hist = (LAS int*)(lds + MISC_OFF + 512);
    const bf16* RWH = (const bf16*)(a->ws + WS_RWH) + (size_t)L * NEXP * DM; const bf16* RWL = (const bf16*)(a->ws + WS_RWL) + (size_t)L * NEXP * DM;
    const float* lng = a->in[I_LNG] + ((size_t)L * 2 + 0) * DM; const float* lnb = a->in[I_LNB] + ((size_t)L * 2 + 0) * DM;
    unsigned* cntw = (unsigned*)(a->ws + WS_CTL) + CW_CNT + (size_t)L * NEXP * 64;
    int* rowtok = (int*)(a->ws + WS_ROWTOK); int* EP = (int*)(a->ws + WS_EP); float* GATE = (float*)(a->ws + WS_GATE);
    for (int sc = blockIdx.x; sc < NTOK / 64; sc += G) {
        if (tid < 32) hist[tid] = 0;
#pragma unroll 1
      for (int half = 0; half < 2; ++half) { const int chunk = 2 * sc + half;
        const int tokl = tg * 16 + fr; const size_t tok = (size_t)chunk * 32 + tokl; const int kb = kq * 256 + fq * 8;
        f32x4 v[8][2]; float s = 0.f;
#pragma unroll
        for (int ks = 0; ks < 8; ++ks) { const u32x4 zr = *(const u32x4*)(Z + tok * DM + kb + ks * 32);
            v[ks][0] = (f32x4){bflo(zr.x), bfhi(zr.x), bflo(zr.y), bfhi(zr.y)}; v[ks][1] = (f32x4){bflo(zr.z), bfhi(zr.z), bflo(zr.w), bfhi(zr.w)};
            s += ((v[ks][0].x + v[ks][0].y) + (v[ks][0].z + v[ks][0].w)) + ((v[ks][1].x + v[ks][1].y) + (v[ks][1].z + v[ks][1].w)); }
        s += shx(s, 16, lane); s += shx(s, 32, lane);
        if (fq == 0) red[kq * 32 + tokl] = s;
        __syncthreads();
        const float mean = ((red[tokl] + red[32 + tokl]) + (red[64 + tokl] + red[96 + tokl])) * (1.f / DM); float q = 0.f;
#pragma unroll
        for (int ks = 0; ks < 8; ++ks) { v[ks][0] = v[ks][0] - mean; v[ks][1] = v[ks][1] - mean;
            q += ((v[ks][0].x * v[ks][0].x + v[ks][0].y * v[ks][0].y) + (v[ks][0].z * v[ks][0].z + v[ks][0].w * v[ks][0].w)) + ((v[ks][1].x * v[ks][1].x + v[ks][1].y * v[ks][1].y) + (v[ks][1].z * v[ks][1].z + v[ks][1].w * v[ks][1].w)); }
        q += shx(q, 16, lane); q += shx(q, 32, lane);
        if (fq == 0) red[128 + kq * 32 + tokl] = q;
        __syncthreads();
        const float rstd = 1.0f / sqrtf(((red[128 + tokl] + red[160 + tokl]) + (red[192 + tokl] + red[224 + tokl])) * (1.f / DM) + LN_EPS);
        f32x4 acc[2] = {(f32x4){0.f, 0.f, 0.f, 0.f}, (f32x4){0.f, 0.f, 0.f, 0.f}};
        unsigned sq[8][4];
#pragma unroll
        for (int ks = 0; ks < 8; ++ks) { const int k = kb + ks * 32;
            const f32x4 g0 = *(const f32x4*)(lng + k), g1 = *(const f32x4*)(lng + k + 4), b0 = *(const f32x4*)(lnb + k), b1 = *(const f32x4*)(lnb + k + 4);
            const f32x4 x0 = v[ks][0] * rstd * g0 + b0, x1 = v[ks][1] * rstd * g1 + b1;
            u32x4 hi; hi.x = pk2(x0.x, x0.y); hi.y = pk2(x0.z, x0.w); hi.z = pk2(x1.x, x1.y); hi.w = pk2(x1.z, x1.w);
            *(u32x4*)(X1B + tok * DM + k) = hi;
            if (FP6_UP) { sq[ks][0] = pk2(x0.x * QS_X1, x0.y * QS_X1); sq[ks][1] = pk2(x0.z * QS_X1, x0.w * QS_X1); sq[ks][2] = pk2(x1.x * QS_X1, x1.y * QS_X1); sq[ks][3] = pk2(x1.z * QS_X1, x1.w * QS_X1); }
            else { u32x2 q8; q8.x = pk4_fp8(x0.x * QS_X1, x0.y * QS_X1, x0.z * QS_X1, x0.w * QS_X1); q8.y = pk4_fp8(x1.x * QS_X1, x1.y * QS_X1, x1.z * QS_X1, x1.w * QS_X1); *(u32x2*)(X1Q + tok * DM + k) = q8; }
            u32x4 lo; lo.x = pk2(x0.x - bflo(hi.x), x0.y - bfhi(hi.x)); lo.y = pk2(x0.z - bflo(hi.y), x0.w - bfhi(hi.y)); lo.z = pk2(x1.x - bflo(hi.z), x1.y - bfhi(hi.z)); lo.w = pk2(x1.z - bflo(hi.w), x1.w - bfhi(hi.w));
            const bf16x8 ah = __builtin_bit_cast(bf16x8, hi), al = __builtin_bit_cast(bf16x8, lo);
#pragma unroll
            for (int nn = 0; nn < 2; ++nn) { const bf16x8 bh = *(const bf16x8*)(RWH + (size_t)(nn * 16 + fr) * DM + k), bl = *(const bf16x8*)(RWL + (size_t)(nn * 16 + fr) * DM + k);
                acc[nn] = __builtin_amdgcn_mfma_f32_16x16x32_bf16(ah, bh, acc[nn], 0, 0, 0);
                acc[nn] = __builtin_amdgcn_mfma_f32_16x16x32_bf16(ah, bl, acc[nn], 0, 0, 0);
                acc[nn] = __builtin_amdgcn_mfma_f32_16x16x32_bf16(al, bh, acc[nn], 0, 0, 0); } }
        if (FP6_UP) {
#pragma unroll
            for (int s2 = 0; s2 < 2; ++s2) {
#pragma unroll
                for (int d = 0; d < 4; ++d) xpose4(sq[4 * s2 + 0][d], sq[4 * s2 + 1][d], sq[4 * s2 + 2][d], sq[4 * s2 + 3][d]);
                v16u w;
#pragma unroll
                for (int j = 0; j < 4; ++j)
#pragma unroll
                    for (int d = 0; d < 4; ++d) w[4 * j + d] = sq[4 * s2 + j][d];
                const v6u o = pack32_fp6(w);
                unsigned char* dq = X1Q + tok * DM + (kq * 2 + s2) * 128 + 16 * fq;
                *(u32x4*)dq = (u32x4){o[0], o[1], o[2], o[3]}; *(u32x4*)(dq + 64) = (u32x4){o[4], o[5], o[4], o[5]}; }
        }
#pragma unroll
        for (int nn = 0; nn < 2; ++nn)
#pragma unroll
            for (int j = 0; j < 4; ++j) plg[(kq * 32 + tg * 16 + 4 * fq + j) * 32 + nn * 16 + fr] = acc[nn][j];
        __syncthreads();
#pragma unroll
        for (int i = 0; i < 2; ++i) { const int idx = tid + NTHR * i, t = idx >> 5, e = idx & 31; lgt[(half * 32 + t) * 33 + e] = ((plg[idx] + plg[1024 + idx]) + (plg[2048 + idx] + plg[3072 + idx])) + a->in[I_RB][L * NEXP + e]; }
        __syncthreads();
      }
        int se[4] = {0, 0, 0, 0}, sp[4] = {0, 0, 0, 0}; float sg[4] = {0.f, 0.f, 0.f, 0.f};
        if (tid < 64) {
            float sv[4], lg[NEXP];
#pragma unroll
            for (int e = 0; e < NEXP; ++e) lg[e] = lgt[tid * 33 + e];
#pragma unroll
            for (int k = 0; k < 4; ++k) { float best = lg[0]; int bi = 0;
#pragma unroll
                for (int e = 1; e < NEXP; ++e) { const bool ok = lg[e] > best; best = ok ? lg[e] : best; bi = ok ? e : bi; }
#pragma unroll
                for (int e = 0; e < NEXP; ++e) lg[e] = (e == bi) ? -3.0e38f : lg[e];
                se[k] = bi; sv[k] = best; }
            float den = 0.f;
#pragma unroll
            for (int k = 0; k < 4; ++k) { sg[k] = __expf(sv[k] - sv[0]); den += sg[k]; }
#pragma unroll
            for (int k = 0; k < 4; ++k) { sg[k] = sg[k] / den; sp[k] = __hip_atomic_fetch_add(&hist[se[k]], 1, __ATOMIC_RELAXED, __HIP_MEMORY_SCOPE_WORKGROUP); }
        }
        __syncthreads();
        if (tid < 32) hist[32 + tid] = (int)__hip_atomic_fetch_add(cntw + tid * 64, (unsigned)hist[tid], __ATOMIC_RELAXED, __HIP_MEMORY_SCOPE_AGENT);
        __syncthreads();
        if (tid < 64) { const int tk = sc * 64 + tid;
#pragma unroll
            for (int k = 0; k < 4; ++k) { const int pos = hist[32 + se[k]] + sp[k]; rowtok[(size_t)se[k] * CAPROWS + pos] = tk; EP[tk * 4 + k] = (se[k] << 16) | pos; GATE[tk * 4 + k] = sg[k]; } }
        __syncthreads();
    }
}

__device__ __forceinline__ void phase_combine(CArgs a, LAS unsigned char* lds, int L, int wv) {
    int tid = phase_tid(wv);
    const int lane = tid & 63, wave = __builtin_amdgcn_readfirstlane(tid >> 6), G = gridDim.x;
    LAS int* misc = (LAS int*)(lds + MISC_OFF);
    const unsigned* cntw = (const unsigned*)(a->ws + WS_CTL) + CW_CNT + (size_t)L * NEXP * 64;
    __syncthreads();
#if !MK_SINGLE
    if (tid < NEXP) misc[64 + tid] = (int)__hip_atomic_load(cntw + tid * 64, __ATOMIC_RELAXED, __HIP_MEMORY_SCOPE_AGENT);
    __syncthreads();
    if (tid == 0) { int acc = 0; for (int e = 0; e < NEXP; ++e) { misc[16 + e] = acc; acc += (misc[64 + e] + 255) >> 8; } }
    __syncthreads();
#endif
    const bf16* X1B = (const bf16*)(a->ws + WS_X1F); const unsigned char* YS = a->ws + WS_YS;
    const int* EP = (const int*)(a->ws + WS_EP); const float* GATE = (const float*)(a->ws + WS_GATE);
    float* OUT = a->out; bf16* XB = (bf16*)(a->ws + WS_XB); unsigned char* XQ = a->ws + WS_XQ; float* SX = (float*)(a->ws + WS_SX); const bool last = (L == DEPTH - 1);
    const float* lng = a->in[I_LNG] + ((size_t)L * 2 + 1) * DM; const float* lnb = a->in[I_LNB] + ((size_t)L * 2 + 1) * DM;
    for (int tk = blockIdx.x * NWAVES + wave; tk < NTOK / 2; tk += G * NWAVES) {
        f32x4 v[2][2][2]; int4 ep4[2]; f32x4 g4[2];
#pragma unroll
        for (int h = 0; h < 2; ++h) { const int tok = tk + h * (NTOK / 2); ep4[h] = *(const int4*)(EP + tok * 4); g4[h] = *(const f32x4*)(GATE + tok * 4);
#pragma unroll
            for (int j = 0; j < 2; ++j) { const u32x4 xr = *(const u32x4*)(X1B + (size_t)tok * DM + lane * 8 + 512 * j);
                v[h][j][0] = DN_ALPHA * (f32x4){bflo(xr.x), bfhi(xr.x), bflo(xr.y), bfhi(xr.y)}; v[h][j][1] = DN_ALPHA * (f32x4){bflo(xr.z), bfhi(xr.z), bflo(xr.w), bfhi(xr.w)}; } }
#pragma unroll
        for (int k = 0; k < 4; ++k)
#pragma unroll
            for (int h = 0; h < 2; ++h) { const int ep = k == 0 ? ep4[h].x : k == 1 ? ep4[h].y : k == 2 ? ep4[h].z : ep4[h].w; const float g = g4[h][k];
                const size_t row = (size_t)misc[16 + (ep >> 16)] * 256 + (ep & 0xffff);
#pragma unroll
                for (int j = 0; j < 2; ++j) { const u32x2 y = *(const u32x2*)(YS + row * DM + lane * 8 + 512 * j); const float gs = g * (1.f / QS_YS);
                    const f32x2 y0 = __builtin_amdgcn_cvt_pk_f32_fp8((int)y.x, false), y1 = __builtin_amdgcn_cvt_pk_f32_fp8((int)y.x, true), y2 = __builtin_amdgcn_cvt_pk_f32_fp8((int)y.y, false), y3 = __builtin_amdgcn_cvt_pk_f32_fp8((int)y.y, true);
                    v[h][j][0] += gs * (f32x4){y0.x, y0.y, y1.x, y1.y}; v[h][j][1] += gs * (f32x4){y2.x, y2.y, y3.x, y3.y}; } }
#pragma unroll
        for (int h = 0; h < 2; ++h) { const int tok = tk + h * (NTOK / 2);
            float s = 0.f;
#pragma unroll
            for (int j = 0; j < 2; ++j) s += ((v[h][j][0].x + v[h][j][0].y) + (v[h][j][0].z + v[h][j][0].w)) + ((v[h][j][1].x + v[h][j][1].y) + (v[h][j][1].z + v[h][j][1].w));
            const float mean = wave_sum(s, lane) * (1.f / DM); float s2 = 0.f;
#pragma unroll
            for (int j = 0; j < 2; ++j) { v[h][j][0] = v[h][j][0] - mean; v[h][j][1] = v[h][j][1] - mean;
                s2 += ((v[h][j][0].x * v[h][j][0].x + v[h][j][0].y * v[h][j][0].y) + (v[h][j][0].z * v[h][j][0].z + v[h][j][0].w * v[h][j][0].w)) + ((v[h][j][1].x * v[h][j][1].x + v[h][j][1].y * v[h][j][1].y) + (v[h][j][1].z * v[h][j][1].z + v[h][j][1].w * v[h][j][1].w)); }
            const float rstd = 1.0f / sqrtf(wave_sum(s2, lane) * (1.f / DM) + LN_EPS);
            float am = 0.f;
#pragma unroll
            for (int j = 0; j < 2; ++j) { const int c0 = lane * 8 + 512 * j;
                v[h][j][0] = v[h][j][0] * rstd * *(const f32x4*)(lng + c0) + *(const f32x4*)(lnb + c0); v[h][j][1] = v[h][j][1] * rstd * *(const f32x4*)(lng + c0 + 4) + *(const f32x4*)(lnb + c0 + 4);
                const f32x4 a0 = __builtin_elementwise_abs(v[h][j][0]), a1 = __builtin_elementwise_abs(v[h][j][1]); am = fmaxf(am, fmaxf(fmaxf(fmaxf(a0.x, a0.y), fmaxf(a0.z, a0.w)), fmaxf(fmaxf(a1.x, a1.y), fmaxf(a1.z, a1.w)))); }
            if (last) {
#pragma unroll
                for (int j = 0; j < 2; ++j) { const int c0 = lane * 8 + 512 * j; *(f32x4*)(OUT + (size_t)tok * DM + c0) = v[h][j][0]; *(f32x4*)(OUT + (size_t)tok * DM + c0 + 4) = v[h][j][1]; } }
            else {
                am = fmaxf(wave_max(am, lane), 1e-20f); const float inv = 127.f / am; if (lane == 0) SX[tok] = am * (1.f / 127.f);
#pragma unroll
                for (int j = 0; j < 2; ++j) { const int c0 = lane * 8 + 512 * j; const f32x4 x0 = v[h][j][0], x1 = v[h][j][1];
                    u32x4 w; w.x = pk2(x0.x, x0.y); w.y = pk2(x0.z, x0.w); w.z = pk2(x1.x, x1.y); w.w = pk2(x1.z, x1.w); *(u32x4*)(XB + (size_t)tok * DM + c0) = w;
                    u32x2 q; q.x = pk4_i8(x0.x, x0.y, x0.z, x0.w, inv); q.y = pk4_i8(x1.x, x1.y, x1.z, x1.w, inv); *(u32x2*)(XQ + (size_t)tok * DM + c0) = q; } } }
    }
}

constexpr int NPHASE = 2 + DEPTH * 7;
__global__ void __launch_bounds__(NTHR, 2) mk_fwd(Args a) {
    extern __shared__ __attribute__((aligned(16))) unsigned char smem[];
    LAS unsigned char* lds = (LAS unsigned char*)smem;
    const int tid = threadIdx.x, G = gridDim.x;
    const int wv = __builtin_amdgcn_readfirstlane(tid >> 6);
    for (int u = tid; u < MISC_BYTES / 4; u += NTHR) ((LAS unsigned*)(lds + MISC_OFF))[u] = 0u;
    __syncthreads();
#if MK_SINGLE
    (void)xcd_barrier_post((unsigned*)(a.ws + WS_CTL) + CW_BAR, (volatile LAS unsigned*)(lds + MISC_OFF), tid == 0);
#define GRID_BAR_T(FIRST) do { XcdBarrier bb; bb.bar = (unsigned*)(cargs()->ws + WS_CTL) + CW_BAR; bb.x = xb_xcc_id(); bb.st = (volatile LAS unsigned*)(lds + MISC_OFF); \
        xcd_barrier<FIRST>(bb, phase_tid(wv) == 0); } while (0)
#else
#define GRID_BAR_T(FIRST) do {} while (0)
#endif
    const int lo = a.ph_lo, hi = a.ph_hi;
#define IN(k) (lo <= (k) && (k) < hi)
#define SEAM(k) do { if (IN(k) && IN((k) + 1)) GRID_BAR_T(false); } while (0)
#if FIXED_WIN_SCALE
    if (PM(0) && IN(0)) { phase_convert(cargs(), lds, wv); phase_convert_b(cargs(), lds, wv); }
    if (IN(0) && IN(2)) GRID_BAR_T(true);
#else
    if (PM(0) && IN(0)) { phase_convert(cargs(), lds, wv); }
    if (IN(0) && IN(1)) GRID_BAR_T(true);
    if (PM(0) && IN(1)) { phase_convert_b(cargs(), lds, wv); }
    SEAM(1);
#endif
    for (int Lc = 0; Lc < DEPTH; ++Lc) {
        int L = Lc; asm volatile("" : "+s"(L));
        int bid = blockIdx.x; asm volatile("" : "+s"(bid));
        const int pb = 2 + L * 7, i2 = L >> 1;
        if ((L & 1) == 0) {
            if (PM(1) && IN(pb + 0)) {
                CArgs ap = cargs(); unsigned char* ws = ap->ws;
                pg8::DenseSched<DM, 1> S{(const char*)(ws + WS_XQ), (const char*)(ws + WS_WEVIN) + (size_t)i2 * EVEN_IN * DM, NTOK / 256, EVEN_IN / 256, (NTOK / 256) * (EVEN_IN / 256), G, bid};
                EpiBiasBf16 E{(bf16*)(ws + WS_HB), EVEN_IN, ap->in[I_EVBIN] + (size_t)i2 * EVEN_IN, (const float*)(ws + WS_SX), (const float*)(ws + WS_SWEV) + (size_t)i2 * EVEN_IN};
                pg8::gemm_phase<DM, true, false, 2>(lds, S, E, (const LAS int*)(lds + TAB_OFF), wv);
            }
            SEAM(pb + 0);
            if (PM(2) && IN(pb + 1)) phase_even_mix(cargs(), lds, i2, wv);
            SEAM(pb + 1);
            if (PM(3) && IN(pb + 2)) {
                CArgs ap = cargs(); unsigned char* ws = ap->ws;
                pg8::DenseSched<DM> S{(const char*)(ws + WS_YB), (const char*)(ws + WS_WEVOUT) + (size_t)i2 * DM * DM * 2, NTOK / 256, DM / 256, (NTOK / 256) * (DM / 256), G, bid};
                EpiZ E{(bf16*)(ws + WS_Z), ap->in[I_EVBOUT] + (size_t)i2 * DM, (const bf16*)(ws + WS_XB), 1.f};
                pg8::gemm_phase<DM, true, false, 0>(lds, S, E, (const LAS int*)(lds + TAB_OFF), wv);
            }
            SEAM(pb + 2);
        } else {
            if (PM(4) && IN(pb + 0)) {
                CArgs ap = cargs(); unsigned char* ws = ap->ws;
                pg8::DenseSched<DM, 1> S{(const char*)(ws + WS_XQ), (const char*)(ws + WS_WODIN) + (size_t)i2 * 2 * SGU_W * DM, NTOK / 256, 2 * SGU_W / 256, (NTOK / 256) * (2 * SGU_W / 256), G, bid};
                EpiGeluStats E{(bf16*)(ws + WS_HB), ap->in[I_ODBIN] + (size_t)i2 * 2 * SGU_W, (float*)(ws + WS_STATS), (const float*)(ws + WS_SX), (const float*)(ws + WS_SWOD) + (size_t)i2 * 2 * SGU_W};
                pg8::gemm_phase<DM, true, false, 2>(lds, S, E, (const LAS int*)(lds + TAB_OFF), wv);
            }
            SEAM(pb + 0);
            if (PM(5) && IN(pb + 1)) phase_sgu(cargs(), lds, i2, wv);
            SEAM(pb + 1);
            if (PM(6) && IN(pb + 2)) {
                CArgs ap = cargs(); unsigned char* ws = ap->ws;
                pg8::DenseSched<SGU_W, 1> S{(const char*)(ws + WS_YB), (const char*)(ws + WS_WODOUT) + (size_t)i2 * DM * SGU_W, NTOK / 256, DM / 256, (NTOK / 256) * (DM / 256), G, bid};
                EpiZ E{(bf16*)(ws + WS_Z), ap->in[I_ODBOUT] + (size_t)i2 * DM, (const bf16*)(ws + WS_XB), 1.f / (QS_GATED * QS_WODOUT)};
                pg8::gemm_phase<SGU_W, true, false, 1>(lds, S, E, (const LAS int*)(lds + TAB_OFF), wv);
            }
            SEAM(pb + 2);
        }
        if (PM(7) && IN(pb + 3)) phase_ln_route(cargs(), lds, L, wv);
        SEAM(pb + 3);
        if (PM(8) && IN(pb + 4)) {
                CArgs ap = cargs(); unsigned char* ws = ap->ws;
            moe_tables<8, true>(ap, lds, L, wv, ap->in[I_BUP] + (size_t)L * NEXP * 2048);
            UpSched S{(const LAS int*)(lds + UT_OFF), (const char*)(ws + WS_X1B), (const char*)(ws + WS_WUP) + (size_t)L * NEXP * 2048 * DM};
            EpiUp E{(unsigned*)(ws + WS_CTL) + CW_UPC + L * UPC_STRIDE, ws + WS_HACT, (const LAS float*)(lds + BIAS_OFF)};
            pg8::gemm_phase<DM, true, true, FP6_UP ? 3 : 1>(lds, S, E, (const LAS int*)(lds + TAB_OFF), wv);
        }
#if !MK_SINGLE
        SEAM(pb + 4);
#endif
        if (PM(9) && IN(pb + 5)) {
                CArgs ap = cargs(); unsigned char* ws = ap->ws;
            moe_tables<4, false, true>(ap, lds, L, wv, ap->in[I_BDOWN] + (size_t)L * NEXP * DM);
            DownSched S{(const LAS int*)(lds + UT_OFF), (const char*)(ws + WS_HACT), (const char*)(ws + WS_WDOWN) + (size_t)L * NEXP * DM * DM, (const unsigned*)(ws + WS_CTL) + CW_UPC + L * UPC_STRIDE, wv == 0};
            EpiDown E{ws + WS_YS, (const LAS float*)(lds + BIAS_OFF)};
            pg8::gemm_phase<DM, true, false, 1>(lds, S, E, (const LAS int*)(lds + TAB_OFF), wv);
        }
        SEAM(pb + 5);
        if (PM(10) && IN(pb + 6)) phase_combine(cargs(), lds, L, wv);
        SEAM(pb + 6);
    }
#undef IN
#undef SEAM
}

extern "C" void kernel_launch(void* const* d_in, const int* in_sizes, int n_in, void* d_out, int out_size, void* d_ws, size_t ws_size, hipStream_t stream) {
    static int grid = 0;
    if (grid == 0) {
        if (n_in != 28 || in_sizes[0] != NTOK * DM || out_size != NTOK * DM || ws_size < WS_END) { fprintf(stderr, "kernel_launch: unexpected shapes (n_in %d, ws %zu)\n", n_in, ws_size); grid = -1; return; }
        int dev = 0, cus = 0, per_cu = 0;
        if (hipGetDevice(&dev) != hipSuccess || hipDeviceGetAttribute(&cus, hipDeviceAttributeMultiprocessorCount, dev) != hipSuccess) { grid = -1; return; }
        if (hipFuncSetAttribute((const void*)mk_fwd, hipFuncAttributeMaxDynamicSharedMemorySize, LDS_BYTES) != hipSuccess) { fprintf(stderr, "kernel_launch: hipFuncSetAttribute failed\n"); grid = -1; return; }
        if (hipOccupancyMaxActiveBlocksPerMultiprocessor(&per_cu, (const void*)mk_fwd, NTHR, LDS_BYTES) != hipSuccess || per_cu < 1) { fprintf(stderr, "kernel_launch: occupancy query reports %d\n", per_cu); }
        (void)hipGetLastError();
        grid = cus - (cus % 8);
    }
    if (grid < 0) return;
    (void)hipMemsetAsync((char*)d_ws + WS_CTL, 0, CTL_ZERO_BYTES, stream);
    Args a{};
    for (int i = 0; i < 28; ++i) a.in[i] = (const float*)d_in[i];
    a.out = (float*)d_out; a.ws = (unsigned char*)d_ws;
#if MK_SINGLE
    a.ph_lo = 0; a.ph_hi = NPHASE;
    hipLaunchKernelGGL(mk_fwd, dim3(grid), dim3(NTHR), LDS_BYTES, stream, a);
#else
    for (int p = 0; p < NPHASE; ++p) { a.ph_lo = p; a.ph_hi = p + 1;
        int type = 0; if (p == 1) type = 11; else if (p > 1) { const int k = (p - 2) % 7, Lh = (p - 2) / 7; type = k < 3 ? ((Lh & 1) ? 4 + k : 1 + k) : 4 + k; }
        const int reps = ((PROBE_DUP_MASK >> type) & 1) ? 2 : 1;
        for (int r = 0; r < reps; ++r) hipLaunchKernelGGL(mk_fwd, dim3(grid), dim3(NTHR), LDS_BYTES, stream, a); }
#endif
}
```
